# Optimizing an MI355X kernel written in HIP

```python
import jax, jax.numpy as jnp
from jax import lax
import numpy as np

D_MODEL = 1024
BATCH = 2
SEQ = 8192
DEPTH = 2

GRID_W = 64
CTX_LEN = 256
HEAD_DIM = 64
GROUP_W = D_MODEL // 4
A_HEADS = GROUP_W // HEAD_DIM
A_KV = A_HEADS // 2
B_HEADS = GROUP_W // HEAD_DIM
B_KV = B_HEADS // 2
F_CH = 64
F_GROUPS = GROUP_W // F_CH
R_HEADS = GROUP_W // HEAD_DIM
MIX_W = 4 * GROUP_W
Q_BLOCK = 128
WINDOW = 128
RET_CHUNK = 128
ROPE_THETA = 10000.0
FF_DIM = -(-8 * D_MODEL // (3 * 256)) * 256
ALPHA = (2.0 * DEPTH) ** 0.25
BETA = (8.0 * DEPTH) ** -0.25
NORM_EPS = 1e-6
NEG_INF = -1e30
F32 = jnp.float32
SPLITS = (A_HEADS * HEAD_DIM, A_KV * HEAD_DIM, A_KV * HEAD_DIM,
          B_HEADS * HEAD_DIM, B_KV * HEAD_DIM, B_KV * HEAD_DIM,
          F_GROUPS * F_CH,
          GROUP_W, GROUP_W, GROUP_W, GROUP_W)
SPLIT_IDX = tuple(int(i) for i in np.cumsum(SPLITS)[:-1])
IN_W = sum(SPLITS)

kernel_name = 'hybrid_parallel_group_dit_block'


def layer_norm(x, w=None, b=None):
    xf = x.astype(F32)
    mu = jnp.mean(xf, -1, keepdims=True)
    var = jnp.mean(jnp.square(xf - mu), -1, keepdims=True)
    y = (xf - mu) * lax.rsqrt(var + NORM_EPS)
    if w is not None:
        y = y * w.astype(F32) + b.astype(F32)
    return y.astype(x.dtype)


def rms_norm(x, w):
    xf = x.astype(F32)
    y = xf * lax.rsqrt(jnp.mean(jnp.square(xf), -1, keepdims=True) + NORM_EPS) * w.astype(F32)
    return y.astype(x.dtype)


def modulate(x, shift, scale):
    return layer_norm(x) * (1.0 + scale) + shift


def post_norm(x, y, w, b):
    return layer_norm(ALPHA * x + y, w, b)


def heads(t):
    return t.reshape(t.shape[:-1] + (t.shape[-1] // HEAD_DIM, HEAD_DIM))


def group_q(q, n_kv):
    return q.reshape(q.shape[:2] + (n_kv, q.shape[2] // n_kv, q.shape[3]))


def rope_tables(pos, n_freq):
    inv = ROPE_THETA ** (-jnp.arange(n_freq, dtype=F32) / n_freq)
    ang = pos[:, None] * inv[None, :]
    return jnp.cos(ang), jnp.sin(ang)


def rotate(x, cos, sin):
    f = cos.shape[-1]
    c = cos[None, :, None, :].astype(x.dtype)
    s = sin[None, :, None, :].astype(x.dtype)
    x1, x2 = x[..., :f], x[..., f:]
    return jnp.concatenate([x1 * c - x2 * s, x2 * c + x1 * s], -1)


def rope_2d(x, tab):
    cos_r, sin_r, cos_c, sin_c = tab
    h = x.shape[-1] // 2
    return jnp.concatenate([rotate(x[..., :h], cos_r, sin_r), rotate(x[..., h:], cos_c, sin_c)], -1)


def gqa_attend(q, k, v, sink):
    s = jnp.einsum('bqkgd,bskd->bkgqs', q, k).astype(F32) * (q.shape[-1] ** -0.5)
    if sink is not None:
        snk = jnp.broadcast_to(sink.astype(F32)[None, :, :, None, None], s.shape[:-1] + (1,))
        p = jax.nn.softmax(jnp.concatenate([s, snk], -1), axis=-1)[..., :-1]
    else:
        p = jax.nn.softmax(s, axis=-1)
    o = jnp.einsum('bkgqs,bskd->bqkgd', p.astype(v.dtype), v)
    return o.reshape(o.shape[:2] + (-1,))


def global_attention(q, k, v):
    B, S, KV, G, d = q.shape
    nb = S // Q_BLOCK
    qb = jnp.moveaxis(q.reshape(B, nb, Q_BLOCK, KV, G, d), 1, 0)
    o = lax.map(lambda blk: gqa_attend(blk, k, v, None), qb)
    return jnp.moveaxis(o, 0, 1).reshape(B, S, -1)


def window_attention(q, k, v, k_c, v_c, sink):
    B, S, KV, G, d = q.shape
    nb = S // Q_BLOCK
    w3 = 3 * Q_BLOCK
    lc = k_c.shape[1]
    qb = q.reshape(B, nb, Q_BLOCK, KV, G, d)

    def band(t):
        tp = jnp.pad(t, ((0, 0), (Q_BLOCK, Q_BLOCK), (0, 0), (0, 0))).reshape(B, nb + 2, Q_BLOCK, KV, d)
        return jnp.concatenate([tp[:, :-2], tp[:, 1:-1], tp[:, 2:]], axis=2)

    kw, vw = band(k), band(v)
    scale = d ** -0.5
    s_loc = jnp.einsum('bnqkgd,bnskd->bnkgqs', qb, kw).astype(F32) * scale
    blk = jnp.arange(nb, dtype=jnp.int32)[:, None]
    qpos = blk * Q_BLOCK + jnp.arange(Q_BLOCK, dtype=jnp.int32)[None, :]
    kpos = (blk - 1) * Q_BLOCK + jnp.arange(w3, dtype=jnp.int32)[None, :]
    kp = kpos[:, None, :]
    valid = (jnp.abs(kp - qpos[:, :, None]) <= WINDOW) & (kp >= 0) & (kp < S)
    s_loc = jnp.where(valid[None, :, None, None], s_loc, NEG_INF)
    s_ctx = jnp.einsum('bnqkgd,bskd->bnkgqs', qb, k_c).astype(F32) * scale
    s_snk = jnp.broadcast_to(sink.astype(F32)[None, None, :, :, None, None], s_loc.shape[:-1] + (1,))
    p = jax.nn.softmax(jnp.concatenate([s_loc, s_ctx, s_snk], -1), axis=-1)
    p_loc = p[..., :w3].astype(v.dtype)
    p_ctx = p[..., w3:w3 + lc].astype(v.dtype)
    o = (jnp.einsum('bnkgqs,bnskd->bnqkgd', p_loc, vw)
         + jnp.einsum('bnkgqs,bskd->bnqkgd', p_ctx, v_c))
    return o.reshape(B, S, -1)


def fourier_mix(u, f_mix):
    B, L, _ = u.shape
    ug = u.astype(F32).reshape(B, L, F_GROUPS, F_CH)
    z = jnp.fft.fft2(ug, axes=(1, 3), norm='ortho').real.astype(u.dtype)
    return jnp.einsum('blgc,gce->blge', z, f_mix).reshape(B, L, -1)


def retention_scan(q, k, v, log_g, state0):
    Bn, L, H, _ = q.shape
    n = L // RET_CHUNK

    def chunks(t):
        return t.reshape(Bn, n, RET_CHUNK, H, t.shape[-1]).transpose(1, 0, 3, 2, 4)

    idx = jnp.arange(RET_CHUNK, dtype=F32)
    diff = idx[:, None] - idx[None, :]
    decay_in = jnp.where(diff >= 0, jnp.exp(log_g[:, None, None] * jnp.maximum(diff, 0.0)), 0.0)
    xi = jnp.exp(log_g[:, None] * (idx + 1.0))[None, :, :, None]
    zeta = jnp.exp(log_g[:, None] * (RET_CHUNK - 1.0 - idx))[None, :, :, None]
    g_chunk = jnp.exp(log_g * RET_CHUNK)[None, :, None, None]

    def step(state, blk):
        qi, ki, vi = blk
        inner = jnp.einsum('bhqd,bhsd->bhqs', qi, ki) * decay_in
        o = jnp.einsum('bhqs,bhsv->bhqv', inner, vi) + jnp.einsum('bhqd,bhdv->bhqv', qi, state) * xi
        state = state * g_chunk + jnp.einsum('bhsd,bhsv->bhdv', ki * zeta, vi)
        return state, o

    state, o = lax.scan(step, state0, (chunks(q), chunks(k), chunks(v)))
    return o.transpose(1, 0, 3, 2, 4).reshape(Bn, L, H, v.shape[-1]), state


def retention_state(k, v, log_g):
    L = k.shape[1]
    w = jnp.exp(log_g[:, None] * (L - 1.0 - jnp.arange(L, dtype=F32))[None, :])
    return jnp.einsum('blhd,blhv,hl->bhdv', k, v, w)


def bidir_retention(ql, kl, vl, qc, kc, vc, log_g, need_ctx):
    Bn, _, H, dk = ql.shape
    zeros = jnp.zeros((Bn, H, dk, vl.shape[-1]), F32)
    o_l = 0.0
    o_c = 0.0
    for direction in range(2):
        f = (lambda t: t[:, ::-1]) if direction == 1 else (lambda t: t)
        lg = log_g[direction]
        if need_ctx:
            oc, s_ctx = retention_scan(f(qc), f(kc), f(vc), lg, zeros)
            o_c = o_c + f(oc)
        else:
            s_ctx = retention_state(f(kc), f(vc), lg)
        ol, _ = retention_scan(f(ql), f(kl), f(vl), lg, s_ctx)
        o_l = o_l + f(ol)
    return o_l, (o_c if need_ctx else None)


def retention_out(o, g, gn_w):
    mu = jnp.mean(o, -1, keepdims=True)
    var = jnp.mean(jnp.square(o - mu), -1, keepdims=True)
    on = ((o - mu) * lax.rsqrt(var + NORM_EPS)).reshape(o.shape[:2] + (-1,)) * gn_w.astype(F32)
    return (jax.nn.silu(g.astype(F32)) * on).astype(g.dtype)


def swiglu(h, w_gu, w_dn):
    g, u = jnp.split(h @ w_gu, 2, axis=-1)
    return (jax.nn.silu(g) * u) @ w_dn


def mixer(hl, hc, w_in, a_qn, a_kn, b_sink, f_mix, r_decay, r_gn, w_out, grid_tab, seq_tab, need_ctx):
    pl = jnp.split(hl @ w_in, SPLIT_IDX, axis=-1)
    pc = jnp.split(hc @ w_in, SPLIT_IDX, axis=-1)
    qa = rope_2d(rms_norm(heads(pl[0]), a_qn), grid_tab)
    ka = rope_2d(rms_norm(heads(pl[1]), a_kn), grid_tab)
    ka_c = rms_norm(heads(pc[1]), a_kn)
    va, va_c = heads(pl[2]), heads(pc[2])
    a_l = global_attention(group_q(qa, A_KV), jnp.concatenate([ka, ka_c], 1), jnp.concatenate([va, va_c], 1))
    sink = b_sink.reshape(B_KV, B_HEADS // B_KV)
    qb = rope_2d(heads(pl[3]), grid_tab)
    kb = rope_2d(heads(pl[4]), grid_tab)
    kb_c, vb, vb_c = heads(pc[4]), heads(pl[5]), heads(pc[5])
    b_l = window_attention(group_q(qb, B_KV), kb, vb, kb_c, vb_c, sink)
    f_l = fourier_mix(pl[6], f_mix)
    log_g = jax.nn.log_sigmoid(r_decay.astype(F32))
    cos_t, sin_t = seq_tab
    kscale = HEAD_DIM ** -0.5
    qr = rotate(heads(pl[7]), cos_t, sin_t).astype(F32)
    kr = rotate(heads(pl[8]), cos_t, sin_t).astype(F32) * kscale
    o_l, o_c = bidir_retention(qr, kr, heads(pl[9]).astype(F32),
                               heads(pc[7]).astype(F32), heads(pc[8]).astype(F32) * kscale,
                               heads(pc[9]).astype(F32), log_g, need_ctx)
    r_l = retention_out(o_l, pl[10], r_gn)
    y_l = jnp.concatenate([a_l, b_l, f_l, r_l], -1) @ w_out
    if not need_ctx:
        return y_l, None
    a_c = gqa_attend(group_q(rms_norm(heads(pc[0]), a_qn), A_KV), ka_c, va_c, None)
    b_c = gqa_attend(group_q(heads(pc[3]), B_KV), kb_c, vb_c, sink)
    f_c = fourier_mix(pc[6], f_mix)
    r_c = retention_out(o_c, pc[10], r_gn)
    y_c = jnp.concatenate([a_c, b_c, f_c, r_c], -1) @ w_out
    return y_l, y_c


def setup_inputs(seed: int = 0) -> dict:
    key = jax.random.key(seed)
    ks = jax.random.split(key, 20)
    D = D_MODEL

    def nrm(k, shape, s):
        return jax.random.normal(k, shape, F32) * s

    gamma0 = 1.0 - 2.0 ** (-5.0 - jnp.arange(R_HEADS, dtype=F32))
    decay_logit = jnp.log(gamma0 / (1.0 - gamma0))
    return {
        'x': nrm(ks[0], (BATCH, SEQ, D), 1.0),
        'c': nrm(ks[1], (BATCH, D), 1.0),
        'ctx': nrm(ks[2], (BATCH, CTX_LEN, D), 1.0),
        'c_ctx': nrm(ks[3], (D,), 1.0),
        'w_mod': nrm(ks[4], (DEPTH, D, 6 * D), 0.5 * D ** -0.5),
        'b_mod': nrm(ks[5], (DEPTH, 6 * D), 0.02),
        'w_in': nrm(ks[6], (DEPTH, D, IN_W), D ** -0.5),
        'a_q_norm': 1.0 + nrm(ks[7], (DEPTH, HEAD_DIM), 0.02),
        'a_k_norm': 1.0 + nrm(ks[8], (DEPTH, HEAD_DIM), 0.02),
        'b_sink': nrm(ks[9], (DEPTH, B_HEADS), 0.5),
        'f_mix': nrm(ks[10], (DEPTH, F_GROUPS, F_CH, F_CH), F_CH ** -0.5),
        'r_decay': decay_logit[None, None, :] + nrm(ks[11], (DEPTH, 2, R_HEADS), 0.05),
        'r_gn_w': 1.0 + nrm(ks[12], (DEPTH, GROUP_W), 0.02),
        'w_out': nrm(ks[13], (DEPTH, MIX_W, D), BETA * MIX_W ** -0.5),
        'ln1_w': 1.0 + nrm(ks[14], (DEPTH, D), 0.02),
        'ln1_b': nrm(ks[15], (DEPTH, D), 0.02),
        'w_gate_up': nrm(ks[16], (DEPTH, D, 2 * FF_DIM), D ** -0.5),
        'w_down': nrm(ks[17], (DEPTH, FF_DIM, D), BETA * FF_DIM ** -0.5),
        'ln2_w': 1.0 + nrm(ks[18], (DEPTH, D), 0.02),
        'ln2_b': nrm(ks[19], (DEPTH, D), 0.02),
    }


def reference(x, c, ctx, c_ctx, w_mod, b_mod, w_in, a_q_norm, a_k_norm, b_sink, f_mix, r_decay,
              r_gn_w, w_out, ln1_w, ln1_b, w_gate_up, w_down, ln2_w, ln2_b):
    S = x.shape[1]
    rows = S // GRID_W
    t = jnp.arange(rows * GRID_W, dtype=jnp.int32)
    row = (t // GRID_W).astype(F32)
    col = (t % GRID_W).astype(F32)
    axis_freq = HEAD_DIM // 4
    grid_tab = rope_tables(row, axis_freq) + rope_tables(col, axis_freq)
    seq_tab = rope_tables(t.astype(F32), HEAD_DIM // 2)
    for layer in range(DEPTH):
        need_ctx = layer < DEPTH - 1
        mod_l = jax.nn.silu(c) @ w_mod[layer] + b_mod[layer]
        sh1, sc1, g1, sh2, sc2, g2 = [m[:, None, :] for m in jnp.split(mod_l, 6, axis=-1)]
        mod_c = jax.nn.silu(c_ctx) @ w_mod[layer] + b_mod[layer]
        csh1, csc1, cg1, csh2, csc2, cg2 = jnp.split(mod_c, 6, axis=-1)
        y_l, y_c = mixer(modulate(x, sh1, sc1), modulate(ctx, csh1, csc1), w_in[layer],
                         a_q_norm[layer], a_k_norm[layer], b_sink[layer], f_mix[layer], r_decay[layer],
                         r_gn_w[layer], w_out[layer], grid_tab, seq_tab, need_ctx)
        x = post_norm(x, g1 * y_l, ln1_w[layer], ln1_b[layer])
        x = post_norm(x, g2 * swiglu(modulate(x, sh2, sc2), w_gate_up[layer], w_down[layer]),
                      ln2_w[layer], ln2_b[layer])
        if need_ctx:
            ctx = post_norm(ctx, cg1 * y_c, ln1_w[layer], ln1_b[layer])
            ctx = post_norm(ctx, cg2 * swiglu(modulate(ctx, csh2, csc2), w_gate_up[layer], w_down[layer]),
                            ln2_w[layer], ln2_b[layer])
    return x
```

```cpp
#include <hip/hip_runtime.h>
#include <hip/hip_cooperative_groups.h>
#include <cstdio>
#include <cstdint>
namespace cg = cooperative_groups;
namespace pg8 {
#define PG8_LAS __attribute__((address_space(3)))
typedef unsigned short bf16_t;
typedef short bf16x8 __attribute__((ext_vector_type(8)));
typedef float f32x4 __attribute__((ext_vector_type(4)));
typedef unsigned u32x4 __attribute__((ext_vector_type(4)));
constexpr int BM = 256, BK = 64, HALF = 128, HTB = HALF * BK * 2  , STAGE_BYTES = 8 * HTB, NXCD = 8, WGM = 8;

__host__ __device__ __forceinline__ int lds_byte(int r, int c) { const int st = (r >> 4) * 2 + (c >> 5), rr = r & 15, cc = c & 31, ob = rr * 64 + cc * 2; return st * 1024 + (ob ^ (((ob >> 9) & 1) << 5)); }
__host__ __device__ __forceinline__ void stage_rc(int b, int& R, int& C) { const int st = b / 1024, sb = b % 1024, swz = sb ^ (((sb >> 9) & 1) << 5); R = (st >> 1) * 16 + swz / 64; C = (st & 1) * 32 + (swz % 64) / 2; }
__host__ __device__ __forceinline__ int perm32(int rho) { const int n = rho >> 4, i = rho & 15; return 8 * (i >> 2) + 4 * n + (i & 3); }

struct Unit { int pm, pn; };
struct Gemm { const bf16_t* A; const bf16_t* Bt; int M, N, K; };

struct StaticOrder {
    int nM, nN, nwg, G, c;
    __host__ __device__ void init(int M, int N, int G_, int c_) { nM = M / BM; nN = N / BM; nwg = nM * nN; G = G_; c = c_; }
    __host__ __device__ bool next(int i, Unit& u) const {
        const long L = (long)i * G + c; if (L >= nwg) return false;
        int wgid = (int)L; { const int q = nwg / NXCD, r = nwg % NXCD, xcd = wgid % NXCD, off = wgid / NXCD; wgid = (xcd < r ? xcd * (q + 1) : r * (q + 1) + (xcd - r) * q) + off; }
        const int nig = WGM * nN, gid = wgid / nig, fm = gid * WGM, gsz = (nM - fm) < WGM ? (nM - fm) : WGM;
        u.pm = fm + ((wgid % nig) % gsz); u.pn = (wgid % nig) / gsz; return true;
    }
    __device__ __forceinline__ void a_ready(const Unit&) const {}
    __device__ __forceinline__ void done(const Unit&) const {}
};

__device__ __forceinline__ unsigned cvt_pk_bf16(float lo, float hi) { unsigned r; asm volatile("v_cvt_pk_bf16_f32 %0, %1, %2" : "=v"(r) : "v"(lo), "v"(hi)); return r; }
typedef float f32x2 __attribute__((ext_vector_type(2)));
__device__ __forceinline__ f32x2 gelu_pk(f32x2 v) {
    const f32x2 av = __builtin_elementwise_abs(v), d = av * 0.2316418882f + 1.0f;
    f32x2 t; t.x = __builtin_amdgcn_rcpf(d.x); t.y = __builtin_amdgcn_rcpf(d.y);
    f32x2 q = t * 0.5307027145f + (-0.7265760135f); q = q * t + 0.7107068705f; q = q * t + (-0.142248368f); q = q * t + 0.127414796f; q = q * t;
    const f32x2 s = (v * v) * (-0.72134752044f);
    f32x2 e; e.x = __builtin_amdgcn_exp2f(s.x); e.y = __builtin_amdgcn_exp2f(s.y);
    const f32x2 m = v * (q * e), r = v - m;
    f32x2 o; o.x = v.x < 0.f ? m.x : r.x; o.y = v.y < 0.f ? m.y : r.y; return o;
}

template <int ACT  > struct EpiBf16 {
    static constexpr bool PERM = true, AFTER_DRAIN = false; static_assert(ACT == 0 || ACT == 1, "EpiBf16: ACT is 0 (none) or 1 (gelu_pk)");
    bf16_t* O; int ldc; const float* bias; int split_cols; size_t split_stride; float scale0;
    __device__ __forceinline__ void operator()(const f32x4 (&acc)[2][2][4][2], const Unit& u, int wr, int wc, int fr, int fq) const {
        const int row0 = u.pm * BM + wr * 64 + fr; int colt = u.pn * BM; bf16_t* base = O;
        float sc = 1.f; if (split_cols) { const int t = colt / split_cols; base += (size_t)t * split_stride; colt -= t * split_cols; if (t == 0) sc = scale0; }
        const int col0 = colt + wc * 32 + 8 * fq, bcol0 = u.pn * BM + wc * 32 + 8 * fq;
        f32x4 bv[2][2];
#pragma unroll
        for (int bj = 0; bj < 2; ++bj)
#pragma unroll
            for (int n = 0; n < 2; ++n) bv[bj][n] = bias ? *(const f32x4*)(bias + bcol0 + bj * HALF + 4 * n) : (f32x4){0.f, 0.f, 0.f, 0.f};
#pragma unroll
        for (int ai = 0; ai < 2; ++ai)
#pragma unroll
            for (int m = 0; m < 4; ++m) { bf16_t* rowp = base + (size_t)(row0 + ai * HALF + m * 16) * ldc + col0;
#pragma unroll
                for (int bj = 0; bj < 2; ++bj) { f32x4 v0 = acc[ai][bj][m][0] + bv[bj][0], v1 = acc[ai][bj][m][1] + bv[bj][1];
                    if (ACT == 1) { f32x2 a = gelu_pk((f32x2){v0[0], v0[1]}), b = gelu_pk((f32x2){v0[2], v0[3]}), c = gelu_pk((f32x2){v1[0], v1[1]}), d = gelu_pk((f32x2){v1[2], v1[3]});
                        v0 = (f32x4){a.x, a.y, b.x, b.y}; v1 = (f32x4){c.x, c.y, d.x, d.y}; }
                    v0 = v0 * sc; v1 = v1 * sc; u32x4 w; w.x = cvt_pk_bf16(v0[0], v0[1]); w.y = cvt_pk_bf16(v0[2], v0[3]); w.z = cvt_pk_bf16(v1[0], v1[1]); w.w = cvt_pk_bf16(v1[2], v1[3]);
                    *(u32x4*)(rowp + bj * HALF) = w; } }
    }
};

struct EpiSwiglu {
    static constexpr bool PERM = true, AFTER_DRAIN = false;
    bf16_t* O; int ldo;
    __device__ __forceinline__ void operator()(const f32x4 (&acc)[2][2][4][2], const Unit& u, int wr, int wc, int fr, int fq) const {
        const int row0 = u.pm * BM + wr * 64 + fr; const int col0 = u.pn * 128 + wc * 32 + 8 * fq;
#pragma unroll
        for (int ai = 0; ai < 2; ++ai)
#pragma unroll
            for (int m = 0; m < 4; ++m) { bf16_t* rowp = O + (size_t)(row0 + ai * HALF + m * 16) * ldo + col0;
                float r[8];
#pragma unroll
                for (int n = 0; n < 2; ++n)
#pragma unroll
                    for (int e = 0; e < 4; ++e) { const float g = acc[ai][0][m][n][e], up = acc[ai][1][m][n][e];
                        r[4 * n + e] = g * __builtin_amdgcn_rcpf(1.0f + __expf(-g)) * up; }
                u32x4 w; w.x = cvt_pk_bf16(r[0], r[1]); w.y = cvt_pk_bf16(r[2], r[3]); w.z = cvt_pk_bf16(r[4], r[5]); w.w = cvt_pk_bf16(r[6], r[7]);
                *(u32x4*)rowp = w; }
    }
};

struct EpiPlain {
    static constexpr bool PERM = true, AFTER_DRAIN = false;
    bf16_t* O; int ldc;
    __device__ __forceinline__ void operator()(const f32x4 (&acc)[2][2][4][2], const Unit& u, int wr, int wc, int fr, int fq) const {
        bf16_t* base = O + (size_t)(u.pm * BM + wr * 64 + fr) * ldc + u.pn * BM + wc * 32 + 8 * fq;
#pragma unroll
        for (int ai = 0; ai < 2; ++ai)
#pragma unroll
            for (int m = 0; m < 4; ++m) { bf16_t* rowp = base + (size_t)(ai * HALF + m * 16) * ldc;
#pragma unroll
                for (int bj = 0; bj < 2; ++bj) { const f32x4 v0 = acc[ai][bj][m][0], v1 = acc[ai][bj][m][1];
                    u32x4 w; w.x = cvt_pk_bf16(v0[0], v0[1]); w.y = cvt_pk_bf16(v0[2], v0[3]); w.z = cvt_pk_bf16(v1[0], v1[1]); w.w = cvt_pk_bf16(v1[2], v1[3]);
                    *(u32x4*)(rowp + bj * HALF) = w; } }
    }
};
template <class Epi, class Sched, bool ALIGN_EPI = false, bool SP2 = false>
__device__ __forceinline__ void gemm_phase(PG8_LAS unsigned char* lds, const Gemm g, const Sched& S, const Epi& E) {
    int tid_ = threadIdx.x; asm volatile("" : "+v"(tid_));
    const int tid = tid_, wid = __builtin_amdgcn_readfirstlane(tid >> 6), lane = tid & 63, wr = wid >> 2, wc = wid & 3, fr = lane & 15, fq = lane >> 4;
    const int K = g.K, nt = K / BK;
    unsigned voffA[2], voffB[2];
#pragma unroll
    for (int i = 0; i < 2; ++i) { int R, C; stage_rc(tid * 16 + i * 8192, R, C); const int Rb = Epi::PERM ? ((R & ~31) + perm32(R & 31)) : R;
        voffA[i] = (unsigned)(R * K + C) * 2u; voffB[i] = (unsigned)(Rb * K + C) * 2u; }
    const size_t kstep = (size_t)(BK * 2);
    const size_t hstep = (size_t)HALF * K * 2;
    const size_t tstep = 2 * hstep;
    const unsigned ldsw = (unsigned)wid * 1024u;
    const int aoff = lds_byte(wr * 64 + fr, fq * 8), boff = lds_byte(wc * 32 + fr, fq * 8);
#define PG8_SA(b, h) (((b) * 2 + (h)) * HTB)
#define PG8_SB(b, h) ((4 + (b) * 2 + (h)) * HTB)
#define PG8_STAGE(bufoff, gbase, voff) do { _Pragma("unroll") for (int _i = 0; _i < 2; ++_i) \
        __builtin_amdgcn_global_load_lds((const unsigned*)((const char*)(gbase) + (voff)[_i]), (PG8_LAS unsigned*)(lds + (bufoff) + ldsw + _i * 8192), 16, 0, 0); } while (0)
#define PG8_LDA(dst, b, h) do { _Pragma("unroll") for (int m = 0; m < 4; ++m) _Pragma("unroll") for (int k = 0; k < 2; ++k) dst[m][k] = *(const PG8_LAS bf16x8*)(lds + PG8_SA(b, h) + aoff + m * 2048 + k * 1024); } while (0)
#define PG8_LDB(dst, b, h) do { _Pragma("unroll") for (int n = 0; n < 2; ++n) _Pragma("unroll") for (int k = 0; k < 2; ++k) dst[n][k] = *(const PG8_LAS bf16x8*)(lds + PG8_SB(b, h) + boff + n * 2048 + k * 1024); } while (0)
#define PG8_MMA(ai, bj, At, Bt) do { __builtin_amdgcn_s_setprio(1); _Pragma("unroll") for (int m = 0; m < 4; ++m) _Pragma("unroll") for (int n = 0; n < 2; ++n) _Pragma("unroll") for (int k = 0; k < 2; ++k) \
        acc[ai][bj][m][n] = __builtin_amdgcn_mfma_f32_16x16x32_bf16(Bt[n][k], At[m][k], acc[ai][bj][m][n], 0, 0, 0); __builtin_amdgcn_s_setprio(0); } while (0)
#define PG8_WAIT_V(n) asm volatile("s_waitcnt vmcnt(" #n ")" ::: "memory")
#define PG8_WAIT_L(n) asm volatile("s_waitcnt lgkmcnt(" #n ")" ::: "memory")
#define PG8_BAR __builtin_amdgcn_s_barrier()
#define PG8_SCHED __builtin_amdgcn_sched_barrier(0)
    Unit cur, nxt; int ui = 0;
    if (!S.next(0, cur)) return;
    f32x4 acc[2][2][4][2];
#pragma unroll
    for (int a = 0; a < 2; ++a)
#pragma unroll
        for (int b = 0; b < 2; ++b)
#pragma unroll
            for (int m = 0; m < 4; ++m)
#pragma unroll
                for (int n = 0; n < 2; ++n) acc[a][b][m][n] = (f32x4){0.f, 0.f, 0.f, 0.f};
    bf16x8 At[4][2], B0[2][2], B1[2][2];
    const char* cA = (const char*)g.A + (size_t)cur.pm * tstep; const char* cB = (const char*)g.Bt + (size_t)cur.pn * tstep;
    S.a_ready(cur);
    if constexpr (SP2) {
        PG8_STAGE(PG8_SB(0, 0), cB, voffB); PG8_STAGE(PG8_SB(0, 1), cB + hstep, voffB); PG8_STAGE(PG8_SA(0, 0), cA, voffA); PG8_STAGE(PG8_SA(0, 1), cA + hstep, voffA);
        if (wr == 1) PG8_BAR;
        PG8_WAIT_V(2); PG8_BAR;
        PG8_STAGE(PG8_SB(1, 0), cB + kstep, voffB); PG8_STAGE(PG8_SA(1, 0), cA + kstep, voffA); PG8_STAGE(PG8_SB(1, 1), cB + hstep + kstep, voffB);
        PG8_WAIT_V(6); PG8_BAR;
    } else {
        PG8_STAGE(PG8_SB(0, 0), cB, voffB); PG8_STAGE(PG8_SA(0, 0), cA, voffA); PG8_STAGE(PG8_SB(0, 1), cB + hstep, voffB); PG8_STAGE(PG8_SA(0, 1), cA + hstep, voffA);
        if (wr == 1) PG8_BAR;
        PG8_WAIT_V(4); PG8_BAR;
        PG8_STAGE(PG8_SB(1, 0), cB + kstep, voffB); PG8_STAGE(PG8_SA(1, 0), cA + kstep, voffA); PG8_STAGE(PG8_SB(1, 1), cB + hstep + kstep, voffB);
        PG8_WAIT_V(6); PG8_BAR;
    }
    for (;;) {
        const bool has_next = S.next(ui + 1, nxt);
        const char* nA = has_next ? (const char*)g.A + (size_t)nxt.pm * tstep : cA; const char* nB = has_next ? (const char*)g.Bt + (size_t)nxt.pn * tstep : cB;
        for (int t = 0; t < nt; t += 2) {
            const bool last = (t == nt - 2);
            const char* a1 = cA + (size_t)(t + 1) * kstep;
            const char* a2 = last ? nA : cA + (size_t)(t + 2) * kstep; const char* b2 = last ? nB : cB + (size_t)(t + 2) * kstep;
            const char* a3 = a2 + kstep; const char* b3 = b2 + kstep;
            if (last && has_next) S.a_ready(nxt);
            if constexpr (SP2) {
            PG8_LDB(B0, 0, 0); PG8_LDB(B1, 0, 1); PG8_SCHED; PG8_LDA(At, 0, 0); PG8_STAGE(PG8_SA(1, 1), a1 + hstep, voffA);
            PG8_WAIT_V(8); PG8_WAIT_L(0); PG8_BAR; PG8_MMA(0, 0, At, B0); PG8_MMA(0, 1, At, B1); PG8_BAR; PG8_SCHED;
            PG8_LDA(At, 0, 1); PG8_STAGE(PG8_SB(0, 0), b2, voffB); PG8_STAGE(PG8_SB(0, 1), b2 + hstep, voffB); PG8_STAGE(PG8_SA(0, 0), a2, voffA);
            PG8_WAIT_V(8); PG8_WAIT_L(0); PG8_BAR; PG8_MMA(1, 0, At, B0); PG8_MMA(1, 1, At, B1); PG8_BAR; PG8_SCHED;
            PG8_LDB(B0, 1, 0); PG8_LDB(B1, 1, 1); PG8_SCHED; PG8_LDA(At, 1, 0); PG8_STAGE(PG8_SA(0, 1), a2 + hstep, voffA);
            PG8_WAIT_V(8); PG8_WAIT_L(0); PG8_BAR; PG8_MMA(0, 0, At, B0); PG8_MMA(0, 1, At, B1); PG8_BAR; PG8_SCHED;
            PG8_LDA(At, 1, 1); PG8_STAGE(PG8_SB(1, 0), b3, voffB); PG8_STAGE(PG8_SB(1, 1), b3 + hstep, voffB); PG8_STAGE(PG8_SA(1, 0), a3, voffA);
            PG8_WAIT_V(8); PG8_WAIT_L(0); PG8_BAR; PG8_MMA(1, 0, At, B0); PG8_MMA(1, 1, At, B1); PG8_BAR; PG8_SCHED;
            } else {
            PG8_LDB(B0, 0, 0); PG8_SCHED; PG8_LDA(At, 0, 0); PG8_STAGE(PG8_SA(1, 1), a1 + hstep, voffA);
            PG8_WAIT_L(8); PG8_BAR; PG8_WAIT_L(0); PG8_MMA(0, 0, At, B0); PG8_BAR; PG8_SCHED;
            PG8_LDB(B1, 0, 1); PG8_STAGE(PG8_SB(0, 0), b2, voffB);
            PG8_BAR; PG8_WAIT_L(0); PG8_MMA(0, 1, At, B1); PG8_BAR;
            PG8_LDA(At, 0, 1); PG8_STAGE(PG8_SA(0, 0), a2, voffA);
            PG8_BAR; PG8_WAIT_L(0); PG8_MMA(1, 0, At, B0); PG8_BAR; PG8_SCHED;
            PG8_STAGE(PG8_SB(0, 1), b2 + hstep, voffB);
            PG8_WAIT_V(6); PG8_BAR; PG8_MMA(1, 1, At, B1); PG8_BAR;
            PG8_LDB(B0, 1, 0); PG8_SCHED; PG8_LDA(At, 1, 0); PG8_STAGE(PG8_SA(0, 1), a2 + hstep, voffA);
            PG8_WAIT_L(8); PG8_BAR; PG8_WAIT_L(0); PG8_MMA(0, 0, At, B0); PG8_BAR; PG8_SCHED;
            PG8_LDB(B1, 1, 1); PG8_STAGE(PG8_SB(1, 0), b3, voffB);
            PG8_BAR; PG8_WAIT_L(0); PG8_MMA(0, 1, At, B1); PG8_BAR;
            PG8_LDA(At, 1, 1); PG8_STAGE(PG8_SA(1, 0), a3, voffA);
            PG8_BAR; PG8_WAIT_L(0); PG8_MMA(1, 0, At, B0); PG8_BAR; PG8_SCHED;
            PG8_STAGE(PG8_SB(1, 1), b3 + hstep, voffB);
            PG8_WAIT_V(6); PG8_BAR; PG8_MMA(1, 1, At, B1); PG8_BAR;
            }
        }
        if constexpr (ALIGN_EPI) { if (wr == 0) PG8_BAR; }
        if constexpr (!Epi::AFTER_DRAIN) { E(acc, cur, wr, wc, fr, fq); S.done(cur); }
        if (!has_next) break;
#pragma unroll
        for (int a = 0; a < 2; ++a)
#pragma unroll
            for (int b = 0; b < 2; ++b)
#pragma unroll
                for (int m = 0; m < 4; ++m)
#pragma unroll
                    for (int n = 0; n < 2; ++n) acc[a][b][m][n] = (f32x4){0.f, 0.f, 0.f, 0.f};
        cur = nxt; cA = nA; cB = nB; ++ui;
        if constexpr (ALIGN_EPI) { if (wr == 1) PG8_BAR; }
    }
    PG8_WAIT_V(0);
    if constexpr (!ALIGN_EPI) { if (wr == 0) PG8_BAR; }
    PG8_BAR;
    if constexpr (Epi::AFTER_DRAIN) { E.fused(acc, cur, wr, wc, fr, fq, lds, wid, lane); S.done(cur); }
#undef PG8_SA
#undef PG8_SB
#undef PG8_STAGE
#undef PG8_LDA
#undef PG8_LDB
#undef PG8_MMA
#undef PG8_WAIT_V
#undef PG8_WAIT_L
#undef PG8_BAR
#undef PG8_SCHED
}
}

#define LAS __attribute__((address_space(3)))
typedef unsigned short bf16_t;
typedef short bf16x8 __attribute__((ext_vector_type(8)));
typedef float f32x4 __attribute__((ext_vector_type(4)));
typedef float f32x16 __attribute__((ext_vector_type(16)));
typedef unsigned u32x4 __attribute__((ext_vector_type(4)));
typedef unsigned u32x2 __attribute__((ext_vector_type(2)));
#define MFMA32(a, b, c) __builtin_amdgcn_mfma_f32_32x32x16_bf16((a), (b), (c), 0, 0, 0)

constexpr int DM = 1024, SEQ = 8192, LCTX = 256, ML = 2 * SEQ, MC = 2 * LCTX, MT = ML + MC;
constexpr int PW = 2560, FF = 2816, INW = 2304, KVT = SEQ + LCTX, NCH = 66;
constexpr int C_QA = 0, C_KA = 256, C_VA = 384, C_QB = 512, C_KB = 768, C_VB = 896, C_FR = 1024, C_FI = 1280, C_RQ = 1536, C_RK = 1792, C_RV = 2048, C_RG = 2304;
constexpr float LN_EPS = 1e-6f, ALPHA = 1.4142135623730951f, LOG2E = 1.4426950408889634f, QSCALE = 0.125f * 1.4426950408889634f;
constexpr size_t KiB = 1024, MiB = 1024 * 1024;
constexpr size_t OFF_MOD = 0, OFF_ROPEG = 256 * KiB, OFF_TW = 320 * KiB, OFF_F128R = 384 * KiB, OFF_F128I = 416 * KiB, OFF_C64 = 448 * KiB, OFF_S64 = 456 * KiB,
                 OFF_C256 = 512 * KiB, OFF_S256 = 640 * KiB, OFF_ROPES = 1 * MiB, OFF_XC = 3 * MiB,
                 OFF_WIN = 5 * MiB, OFF_WOUT = 10 * MiB, OFF_WGU = 12 * MiB, OFF_WDN = 23 * MiB, OFF_H = 29 * MiB, OFF_P = 62 * MiB,
                 OFF_MIX = 153 * MiB, OFF_VAT = 186 * MiB, OFF_VBT = 191 * MiB, OFF_TB = 196 * MiB, OFF_SLOC = 212 * MiB, OFF_ST = 229 * MiB,
                 OFF_Y2 = 196 * MiB, WS_NEED = 238 * MiB;
constexpr int LDS_BYTES = 147456;
constexpr size_t OFF_BAR = 208 * KiB;
#define RLX_AGENT __ATOMIC_RELAXED, __HIP_MEMORY_SCOPE_AGENT

struct Params { const float* in[20]; float* out; unsigned char* ws; int n_steps, pad; };

__device__ __forceinline__ unsigned f2bf(float f) { unsigned u = __builtin_bit_cast(unsigned, f); return (u + 0x7fffu + ((u >> 16) & 1u)) >> 16; }
typedef float f32x2_t __attribute__((ext_vector_type(2))); typedef __bf16 bf16x2_t __attribute__((ext_vector_type(2)));
__device__ __forceinline__ unsigned pk2(float lo, float hi) { f32x2_t v = {lo, hi}; bf16x2_t b = __builtin_convertvector(v, bf16x2_t); return __builtin_bit_cast(unsigned, b); }
__device__ __forceinline__ float xhalf_max(float v) { auto rr = __builtin_amdgcn_permlane32_swap(__float_as_uint(v), __float_as_uint(v), false, false); return fmaxf(__uint_as_float(rr[0]), __uint_as_float(rr[1])); }
__device__ __forceinline__ float xhalf_sum(float v) { auto rr = __builtin_amdgcn_permlane32_swap(__float_as_uint(v), __float_as_uint(v), false, false); return __uint_as_float(rr[0]) + __uint_as_float(rr[1]); }
__device__ __forceinline__ float bflo(unsigned w) { return __builtin_bit_cast(float, w << 16); }
__device__ __forceinline__ float bfhi(unsigned w) { return __builtin_bit_cast(float, w & 0xffff0000u); }
__device__ __forceinline__ float bf2f(bf16_t h) { return __builtin_bit_cast(float, (unsigned)h << 16); }
__device__ __forceinline__ int crow(int r, int hi) { return (r & 3) + 8 * (r >> 2) + 4 * hi; }
__device__ __forceinline__ float wave_sum(float v) {
#pragma unroll
    for (int o = 1; o < 64; o <<= 1) v += __shfl_xor(v, o);
    return v;
}
__device__ __forceinline__ bf16x8 pack8(float a0, float a1, float a2, float a3, float a4, float a5, float a6, float a7) {
    u32x4 p; p.x = pk2(a0, a1); p.y = pk2(a2, a3); p.z = pk2(a4, a5); p.w = pk2(a6, a7); return __builtin_bit_cast(bf16x8, p);
}
__device__ __forceinline__ bf16x8 join8(u32x2 lo, u32x2 hi) { u32x4 p; p.x = lo.x; p.y = lo.y; p.z = hi.x; p.w = hi.y; return __builtin_bit_cast(bf16x8, p); }
__device__ __forceinline__ void sincos_red(float ang, float& c, float& s) {
    const double a = (double)ang; const double k = rint(a * 0.15915494309189535); const float r = (float)(a - k * 6.283185307179586);
    c = cosf(r); s = sinf(r);
}
__device__ __forceinline__ float logsig(float x) { return -log1pf(expf(-x)); }
#define LDSW() asm volatile("s_waitcnt lgkmcnt(0)" ::: "memory")

__device__ __forceinline__ void ph_tables(unsigned char* ws, int gtid, int NT) {
    float2* ropeg = (float2*)(ws + OFF_ROPEG);
    for (int i = gtid; i < 128 * 16; i += NT) { const int p = i >> 4, f = i & 15; const float inv = exp2f(-(float)f * (13.287712379549449f / 16.f)); float c, s; sincos_red((float)p * inv, c, s); ropeg[i] = make_float2(c, s); }
    float2* ropes = (float2*)(ws + OFF_ROPES);
    for (int i = gtid; i < SEQ * 32; i += NT) { const int p = i >> 5, f = i & 31; const float inv = exp2f(-(float)f * (13.287712379549449f / 32.f)); float c, s; sincos_red((float)p * inv, c, s); ropes[i] = make_float2(c, s); }
    float2* tw = (float2*)(ws + OFF_TW);
    for (int i = gtid; i < 8192; i += NT) { const float a = (float)i * (1.0f / 4096.0f); tw[i] = make_float2(cospif(a), sinpif(a)); }
    bf16_t* f128r = (bf16_t*)(ws + OFF_F128R); bf16_t* f128i = (bf16_t*)(ws + OFF_F128I);
    for (int i = gtid; i < 128 * 128; i += NT) { const int m = ((i >> 7) * (i & 127)) & 127; const float a = (float)m * (1.0f / 64.0f); f128r[i] = (bf16_t)f2bf(cospif(a)); f128i[i] = (bf16_t)f2bf(-sinpif(a)); }
    bf16_t* c64 = (bf16_t*)(ws + OFF_C64); bf16_t* s64 = (bf16_t*)(ws + OFF_S64);
    for (int i = gtid; i < 64 * 64; i += NT) { const int m = ((i >> 6) * (i & 63)) & 63; const float a = (float)m * (1.0f / 32.0f); c64[i] = (bf16_t)f2bf(cospif(a)); s64[i] = (bf16_t)f2bf(sinpif(a)); }
    bf16_t* c256 = (bf16_t*)(ws + OFF_C256); bf16_t* s256 = (bf16_t*)(ws + OFF_S256);
    for (int i = gtid; i < 256 * 256; i += NT) { const int m = ((i >> 8) * (i & 255)) & 255; const float a = (float)m * (1.0f / 128.0f); c256[i] = (bf16_t)f2bf(cospif(a)); s256[i] = (bf16_t)f2bf(sinpif(a)); }
}

__device__ __forceinline__ void ph_mod(const float* c, const float* c_ctx, const float* w_mod, const float* b_mod, float* modv, unsigned char* lds, int tid, int bid, int G) {
    float* sc = (float*)lds; float* part = sc + 3 * 1024;
    if (bid >= 48 && G >= 48) return;
    for (int i = tid; i < 3072; i += 512) { const int v = i >> 10, k = i & 1023; const float cv = v < 2 ? c[v * 1024 + k] : c_ctx[k]; sc[i] = cv / (1.0f + expf(-cv)); }
    __syncthreads();
    for (int u = bid; u < 48; u += (G >= 48 ? 48 : G)) {
        const int layer = u / 24, cgp = u % 24, cq = tid & 63, kg = tid >> 6;
        const float* w = w_mod + (size_t)layer * 1024 * 6144 + cgp * 256 + 4 * cq;
        f32x4 a0 = {0.f, 0.f, 0.f, 0.f}, a1 = a0, a2 = a0;
        for (int k0 = kg * 128; k0 < kg * 128 + 128; k0 += 16) {
            f32x4 wv[16];
#pragma unroll
            for (int e = 0; e < 16; ++e) wv[e] = *(const f32x4*)(w + (size_t)(k0 + e) * 6144);
#pragma unroll
            for (int e = 0; e < 16; ++e) { a0 += wv[e] * sc[k0 + e]; a1 += wv[e] * sc[1024 + k0 + e]; a2 += wv[e] * sc[2048 + k0 + e]; }
        }
        *(f32x4*)(part + (kg * 3 + 0) * 256 + 4 * cq) = a0; *(f32x4*)(part + (kg * 3 + 1) * 256 + 4 * cq) = a1; *(f32x4*)(part + (kg * 3 + 2) * 256 + 4 * cq) = a2;
        __syncthreads();
        for (int t = tid; t < 768; t += 512) { const int v = t >> 8, cc = t & 255; float s = 0.f;
#pragma unroll
            for (int k2 = 0; k2 < 8; ++k2) s += part[(k2 * 3 + v) * 256 + cc];
            modv[(layer * 3 + v) * 6144 + cgp * 256 + cc] = s + b_mod[layer * 6144 + cgp * 256 + cc]; }
        __syncthreads();
    }
}

__device__ __forceinline__ void transpose_item(const float* W, int ldw, int k0, int nsrc0, bf16_t* WT, int K, int drow0, float* scr, int lane) {
    f32x4 wv[8];
#pragma unroll
    for (int i = 0; i < 8; ++i) wv[i] = *(const f32x4*)(W + (size_t)(k0 + (lane >> 3) + 8 * i) * ldw + nsrc0 + 4 * (lane & 7));
#pragma unroll
    for (int i = 0; i < 8; ++i) { float* d = scr + ((lane >> 3) + 8 * i) * 33 + 4 * (lane & 7); d[0] = wv[i].x; d[1] = wv[i].y; d[2] = wv[i].z; d[3] = wv[i].w; }
    LDSW();
    const int c = lane & 7;
#pragma unroll
    for (int j = 0; j < 4; ++j) { const int n = (lane >> 3) + 8 * j; const float* s = scr + (8 * c) * 33 + n;
        u32x4 o; o.x = pk2(s[0 * 33], s[1 * 33]); o.y = pk2(s[2 * 33], s[3 * 33]); o.z = pk2(s[4 * 33], s[5 * 33]); o.w = pk2(s[6 * 33], s[7 * 33]);
        *(u32x4*)(WT + (size_t)(drow0 + n) * K + k0 + 8 * c) = o; }
    LDSW();
}

__device__ __forceinline__ void ph_weights(const Params& p, int layer, unsigned char* lds, int tid, int bid_in, int G_in, int skip = 0) {
    if (G_in < 2 * skip) skip = 0;
    if (bid_in < skip) return;
    const int bid = bid_in - skip, G = G_in - skip;
    unsigned char* ws = p.ws;
    const float* w_in = p.in[6] + (size_t)layer * DM * INW; const float* fmix = p.in[10] + (size_t)layer * 4 * 64 * 64;
    const float* w_out = p.in[13] + (size_t)layer * DM * DM; const float* w_gu = p.in[16] + (size_t)layer * DM * 2 * FF; const float* w_dn = p.in[17] + (size_t)layer * FF * DM;
    bf16_t* Win = (bf16_t*)(ws + OFF_WIN); bf16_t* Wout = (bf16_t*)(ws + OFF_WOUT); bf16_t* Wgu = (bf16_t*)(ws + OFF_WGU); bf16_t* Wdn = (bf16_t*)(ws + OFF_WDN);
    const int lane = tid & 63, wave = tid >> 6;
    float* Gm = (float*)lds; float* wt = Gm + 4096;
    for (int u = bid; u < 128; u += G) {
        const int kb = u >> 3, g = (u >> 1) & 3, ri = u & 1;
        { const int ci = tid >> 3, e0 = (tid & 7) * 8; float acc[8];
#pragma unroll
          for (int e = 0; e < 8; ++e) acc[e] = 0.f;
          for (int cp = 0; cp < 64; ++cp) { const int m = (ci * cp) & 63; const float a = (float)m * (1.0f / 32.0f); const float tr = ri == 0 ? cospif(a) : -sinpif(a);
              const float* fr = fmix + ((g * 64 + cp) * 64 + e0);
#pragma unroll
              for (int e = 0; e < 8; ++e) acc[e] += tr * fr[e]; }
#pragma unroll
          for (int e = 0; e < 8; ++e) Gm[ci * 64 + e0 + e] = acc[e] * 0.125f; }
        for (int i = tid; i < 4096; i += 512) { const int kk = i >> 6, cc = i & 63; wt[kk * 65 + cc] = w_in[(size_t)(kb * 64 + kk) * INW + 1024 + 64 * g + cc]; }
        __syncthreads();
        { const int e = tid & 63, kk0 = (tid >> 6) * 8; float acc[8];
#pragma unroll
          for (int q = 0; q < 8; ++q) acc[q] = 0.f;
          for (int cc = 0; cc < 64; ++cc) { const float gv = Gm[cc * 64 + e];
#pragma unroll
              for (int q = 0; q < 8; ++q) acc[q] += wt[(kk0 + q) * 65 + cc] * gv; }
          u32x4 o; o.x = pk2(acc[0], acc[1]); o.y = pk2(acc[2], acc[3]); o.z = pk2(acc[4], acc[5]); o.w = pk2(acc[6], acc[7]);
          *(u32x4*)(Win + (size_t)(1024 + ri * 256 + g * 64 + e) * DM + kb * 64 + kk0) = o; }
        __syncthreads();
    }
    float* scr = (float*)lds + wave * 2176;
    const int gw = bid * 8 + wave, NGW = G * 8;
    for (int it = gw; it < 5760; it += NGW) {
        int r = it;
        if (r < 512) { transpose_item(w_in, INW, 64 * (r >> 5), 32 * (r & 31), Win, DM, 32 * (r & 31), scr, lane); continue; } r -= 512;
        if (r < 512) { transpose_item(w_in, INW, 64 * (r >> 5), 1280 + 32 * (r & 31), Win, DM, 1536 + 32 * (r & 31), scr, lane); continue; } r -= 512;
        if (r < 512) { transpose_item(w_out, DM, 64 * (r >> 5), 32 * (r & 31), Wout, DM, 32 * (r & 31), scr, lane); continue; } r -= 512;
        if (r < 2816) { const int kb = r / 176, n0 = 32 * (r % 176); const int bj = n0 / FF, rr = n0 % FF; const int drow = (rr >> 7) * 256 + bj * 128 + (rr & 127);
            transpose_item(w_gu, 2 * FF, 64 * kb, n0, Wgu, DM, drow, scr, lane); continue; } r -= 2816;
        transpose_item(w_dn, DM, 64 * (r >> 5), 32 * (r & 31), Wdn, FF, 32 * (r & 31), scr, lane);
    }
}

__device__ __forceinline__ void ln_stats(const f32x4 (&v)[4], float& mean, float& rstd) {
    float s = 0.f;
#pragma unroll
    for (int j = 0; j < 4; ++j) s += (v[j].x + v[j].y) + (v[j].z + v[j].w);
    mean = wave_sum(s) * (1.0f / DM); float q = 0.f;
#pragma unroll
    for (int j = 0; j < 4; ++j) { const f32x4 d = v[j] - mean; q += (d.x * d.x + d.y * d.y) + (d.z * d.z + d.w * d.w); }
    rstd = rsqrtf(wave_sum(q) * (1.0f / DM) + LN_EPS);
}
__device__ __forceinline__ void store_h(bf16_t* hrow, const f32x4 (&v)[4], float mean, float rstd, const float* sh, const float* scl, int lane) {
#pragma unroll
    for (int j = 0; j < 4; ++j) { const int col = 4 * lane + 256 * j; const f32x4 s = *(const f32x4*)(scl + col), t = *(const f32x4*)(sh + col);
        const f32x4 y = (v[j] - mean) * rstd * (s + 1.0f) + t; u32x2 w; w.x = pk2(y.x, y.y); w.y = pk2(y.z, y.w); *(u32x2*)(hrow + col) = w; }
}
__device__ __forceinline__ void ph_h0(const Params& p, int gw, int NGW, int lane) {
    const float* modv = (const float*)(p.ws + OFF_MOD); bf16_t* H = (bf16_t*)(p.ws + OFF_H);
    f32x4 xn[4];
    if (gw < MT) { const float* src = gw < ML ? p.in[0] + (size_t)gw * DM : p.in[2] + (size_t)(gw - ML) * DM;
#pragma unroll
        for (int j = 0; j < 4; ++j) xn[j] = *(const f32x4*)(src + 4 * lane + 256 * j); }
    for (int row = gw; row < MT; row += NGW) {
        const float* mod = modv + (size_t)(row < ML ? (row >> 13) : 2) * 6144;
        f32x4 v[4], sv[4], tv[4];
#pragma unroll
        for (int j = 0; j < 4; ++j) { v[j] = xn[j]; sv[j] = *(const f32x4*)(mod + 1024 + 4 * lane + 256 * j); tv[j] = *(const f32x4*)(mod + 4 * lane + 256 * j); }
        const int nrow = row + NGW;
        if (nrow < MT) { const float* src = nrow < ML ? p.in[0] + (size_t)nrow * DM : p.in[2] + (size_t)(nrow - ML) * DM;
#pragma unroll
            for (int j = 0; j < 4; ++j) xn[j] = *(const f32x4*)(src + 4 * lane + 256 * j); }
        float mean, rstd; ln_stats(v, mean, rstd);
        bf16_t* hrow = H + (size_t)row * DM;
#pragma unroll
        for (int j = 0; j < 4; ++j) { const f32x4 y = (v[j] - mean) * rstd * (sv[j] + 1.0f) + tv[j]; u32x2 w; w.x = pk2(y.x, y.y); w.y = pk2(y.z, y.w); *(u32x2*)(hrow + 4 * lane + 256 * j) = w; }
    }
}
__device__ __forceinline__ void ph_rowpass(const Params& p, int layer, int which, int mrows, bool do_h, int gw, int NGW, int lane) {
    const float* modv = (const float*)(p.ws + OFF_MOD); bf16_t* H = (bf16_t*)(p.ws + OFF_H);
    const bf16_t* Y = (const bf16_t*)(p.ws + (which == 0 ? OFF_P : OFF_Y2));
    const float* lw = p.in[which == 0 ? 14 : 18] + layer * DM; const float* lb = p.in[which == 0 ? 15 : 19] + layer * DM;
    float* xc = (float*)(p.ws + OFF_XC);
    const bool from_in = (layer == 0 && which == 0);
    f32x4 lwv[4], lbv[4], xn[4]; u32x2 yn[4];
#pragma unroll
    for (int j = 0; j < 4; ++j) { lwv[j] = *(const f32x4*)(lw + 4 * lane + 256 * j); lbv[j] = *(const f32x4*)(lb + 4 * lane + 256 * j); }
#define RP_SRC(r) (from_in ? ((r) < ML ? p.in[0] + (size_t)(r) * DM : p.in[2] + (size_t)((r) - ML) * DM) : ((r) < ML ? (const float*)p.out + (size_t)(r) * DM : (const float*)xc + (size_t)((r) - ML) * DM))
    if (gw < mrows) { const float* src = RP_SRC(gw);
#pragma unroll
        for (int j = 0; j < 4; ++j) { xn[j] = *(const f32x4*)(src + 4 * lane + 256 * j); yn[j] = *(const u32x2*)(Y + (size_t)gw * DM + 4 * lane + 256 * j); } }
    for (int row = gw; row < mrows; row += NGW) {
        float* xs = row < ML ? p.out + (size_t)row * DM : xc + (size_t)(row - ML) * DM;
        const int vi = row < ML ? (row >> 13) : 2;
        const float* mod = modv + (size_t)(layer * 3 + vi) * 6144;
        const float* gate = mod + (which == 0 ? 2048 : 5120);
        const float* mod2 = which == 0 ? mod + 3072 : modv + (size_t)((layer + 1) * 3 + vi) * 6144;
        f32x4 v[4], sv[4], tv[4];
#pragma unroll
        for (int j = 0; j < 4; ++j) { const int col = 4 * lane + 256 * j; const f32x4 g = *(const f32x4*)(gate + col);
            f32x4 y; y.x = bflo(yn[j].x); y.y = bfhi(yn[j].x); y.z = bflo(yn[j].y); y.w = bfhi(yn[j].y);
            v[j] = xn[j] * ALPHA + g * y;
            if (do_h) { sv[j] = *(const f32x4*)(mod2 + 1024 + col); tv[j] = *(const f32x4*)(mod2 + col); } }
        const int nrow = row + NGW;
        if (nrow < mrows) { const float* src = RP_SRC(nrow);
#pragma unroll
            for (int j = 0; j < 4; ++j) { xn[j] = *(const f32x4*)(src + 4 * lane + 256 * j); yn[j] = *(const u32x2*)(Y + (size_t)nrow * DM + 4 * lane + 256 * j); } }
        float mean, rstd; ln_stats(v, mean, rstd);
#pragma unroll
        for (int j = 0; j < 4; ++j) { const int col = 4 * lane + 256 * j; v[j] = (v[j] - mean) * rstd * lwv[j] + lbv[j];
#ifdef SELFCHECK
            if (layer == 1 && which == 1) { const unsigned fl = *(const unsigned*)(p.ws + 200 * 1024); v[j] = v[j] * (1.0f + 0.1f * (float)(fl & 15u)); }
#endif
            *(f32x4*)(xs + col) = v[j]; }
        if (do_h) {
            ln_stats(v, mean, rstd);
            bf16_t* hrow = H + (size_t)row * DM;
#pragma unroll
            for (int j = 0; j < 4; ++j) { const f32x4 y = (v[j] - mean) * rstd * (sv[j] + 1.0f) + tv[j]; u32x2 w; w.x = pk2(y.x, y.y); w.y = pk2(y.z, y.w); *(u32x2*)(hrow + 4 * lane + 256 * j) = w; }
        }
    }
#undef RP_SRC
}
#define XB_TMO      128
#define XB_XCNT(j)  (256  + 64 * (j))
#define XB_XSUB(j)  (1280 + 64 * (j))
#define XB_XGEN(j)  (2304 + 64 * (j))
#define XB_TOP      3328
#define XB_TOPGEN   3392
#define XCD_BAR_WORDS 3456
#define XB_SPIN_CAP (1u << 18)

__device__ __forceinline__ unsigned xb_ld(unsigned* p)              { return __hip_atomic_load(p, __ATOMIC_RELAXED, __HIP_MEMORY_SCOPE_AGENT); }
__device__ __forceinline__ unsigned xb_add(unsigned* p, unsigned v) { return __hip_atomic_fetch_add(p, v, __ATOMIC_RELAXED, __HIP_MEMORY_SCOPE_AGENT); }
__device__ __forceinline__ unsigned xb_xcc_id() { return (unsigned)__builtin_amdgcn_s_getreg((3 << 11) | 20) & 0xFu; }
#define XB_SPIN(cond, bar) do { unsigned _sp = 0; while (cond) { __builtin_amdgcn_s_sleep(1); \
    if ((++_sp & 255u) == 0u) { if (xb_ld(&(bar)[XB_TMO])) break; if (_sp > XB_SPIN_CAP) { atomicAdd(&(bar)[XB_TMO], 1u); break; } } } } while (0)

struct XcdBarrier {
    unsigned* bar; unsigned x;
    volatile LAS unsigned* st;
};

__device__ __forceinline__ XcdBarrier xcd_barrier_post(unsigned* bar, volatile LAS unsigned* st) {
    XcdBarrier b; b.bar = bar; b.x = xb_xcc_id(); b.st = st;
    if (threadIdx.x == 0) (void)xb_add(&bar[XB_XCNT(b.x)], 1u);
    return b;
}
__device__ __forceinline__ void xcd_barrier_complete(unsigned* bar, unsigned x, unsigned& nloc, unsigned& nx) {
    const unsigned G = gridDim.x * gridDim.y * gridDim.z;
    unsigned sum, cnt, mine, sp = 0u;
    for (;;) {
        sum = 0u; cnt = 0u; mine = 0u;
#pragma unroll
        for (unsigned j = 0; j < 16; ++j) { const unsigned c = xb_ld(&bar[XB_XCNT(j)]); sum += c; cnt += (c > 0u) ? 1u : 0u; mine = (j == x) ? c : mine; }
        if (sum == G) break;
        __builtin_amdgcn_s_sleep(1);
        if ((++sp & 255u) == 0u) { if (xb_ld(&bar[XB_TMO])) break; if (sp > XB_SPIN_CAP) { atomicAdd(&bar[XB_TMO], 1u); break; } }
    }
    nloc = mine > 0u ? mine : 1u; nx = cnt > 0u ? cnt : 1u;
}

__device__ __forceinline__ void xcd_barrier(const XcdBarrier& b) {
    asm volatile("s_waitcnt vmcnt(0)" ::: "memory");
    __syncthreads();
    if (threadIdx.x == 0) {
        unsigned* bar = b.bar;
        __builtin_amdgcn_s_waitcnt(0);
        unsigned nloc = b.st[0], nx = b.st[1];
        if (nloc == 0u) { xcd_barrier_complete(bar, b.x, nloc, nx); b.st[0] = nloc; b.st[1] = nx; }
        const unsigned old = xb_add(&bar[XB_XSUB(b.x)], 1u);
        const unsigned gen = old / nloc;
        if (old + 1u == (gen + 1u) * nloc) {
            __builtin_amdgcn_fence(__ATOMIC_RELEASE, "agent");
            asm volatile("s_waitcnt vmcnt(0)" ::: "memory");
            const unsigned og = xb_add(&bar[XB_TOP], 1u);
            const unsigned tg = og / nx;
            if (og + 1u == (tg + 1u) * nx) xb_add(&bar[XB_TOPGEN], 1u);
            else XB_SPIN(xb_ld(&bar[XB_TOPGEN]) == tg, bar);
            __builtin_amdgcn_fence(__ATOMIC_ACQUIRE, "agent");
            xb_add(&bar[XB_XGEN(b.x)], 1u);
            asm volatile("s_waitcnt vmcnt(0)" ::: "memory");
        } else {
            XB_SPIN(xb_ld(&bar[XB_XGEN(b.x)]) == gen, bar);
            __builtin_amdgcn_fence(__ATOMIC_ACQUIRE, "agent");
            asm volatile("s_waitcnt vmcnt(0)" ::: "memory");
        }
    }
    __syncthreads();
}

__device__ __forceinline__ void ph_prep(const Params& p, int layer, unsigned char* lds, int gw, int NGW, int lane, int wave) {
    bf16_t* P = (bf16_t*)(p.ws + OFF_P); const float2* ropeg = (const float2*)(p.ws + OFF_ROPEG);
    const float* aqn = p.in[7] + layer * 64; const float* akn = p.in[8] + layer * 64;
    for (int it = gw; it < (MT * 12) / 64; it += NGW) {
        const int item = it * 64 + lane; const int row = item / 12, s = item % 12;
        int col; bool isq, norm; const float* nw = aqn;
        if (s < 4) { col = C_QA + 64 * s; isq = true; norm = true; }
        else if (s < 6) { col = C_KA + 64 * (s - 4); isq = false; norm = true; nw = akn; }
        else if (s < 10) { col = C_QB + 64 * (s - 6); isq = true; norm = false; }
        else { col = C_KB + 64 * (s - 10); isq = false; norm = false; }
        bf16_t* ptr = P + (size_t)row * PW + col;
        u32x4 w[8];
#pragma unroll
        for (int q = 0; q < 8; ++q) w[q] = *(const u32x4*)(ptr + 8 * q);
        float x[64];
#pragma unroll
        for (int q = 0; q < 8; ++q) { x[8 * q + 0] = bflo(w[q].x); x[8 * q + 1] = bfhi(w[q].x); x[8 * q + 2] = bflo(w[q].y); x[8 * q + 3] = bfhi(w[q].y);
            x[8 * q + 4] = bflo(w[q].z); x[8 * q + 5] = bfhi(w[q].z); x[8 * q + 6] = bflo(w[q].w); x[8 * q + 7] = bfhi(w[q].w); }
        if (norm) { float ss = 0.f;
#pragma unroll
            for (int e = 0; e < 64; ++e) ss += x[e] * x[e];
            const float r = rsqrtf(ss * (1.0f / 64.0f) + LN_EPS);
#pragma unroll
            for (int e = 0; e < 64; ++e) x[e] *= r * nw[e]; }
        if (row < ML) { const int t = row & (SEQ - 1); const float2* ra = ropeg + (t >> 6) * 16; const float2* rb = ropeg + (t & 63) * 16;
#pragma unroll
            for (int e = 0; e < 16; ++e) { const float2 a = ra[e], bq = rb[e];
                const float y0 = x[e] * a.x - x[16 + e] * a.y, y1 = x[16 + e] * a.x + x[e] * a.y, y2 = x[32 + e] * bq.x - x[48 + e] * bq.y, y3 = x[48 + e] * bq.x + x[32 + e] * bq.y;
                x[e] = y0; x[16 + e] = y1; x[32 + e] = y2; x[48 + e] = y3; } }
        const float qs = isq ? QSCALE : 1.0f;
#pragma unroll
        for (int q = 0; q < 8; ++q) { u32x4 o; o.x = pk2(x[8 * q] * qs, x[8 * q + 1] * qs); o.y = pk2(x[8 * q + 2] * qs, x[8 * q + 3] * qs); o.z = pk2(x[8 * q + 4] * qs, x[8 * q + 5] * qs); o.w = pk2(x[8 * q + 6] * qs, x[8 * q + 7] * qs);
            *(u32x4*)(ptr + 8 * q) = o; }
    }
    bf16_t* scr = (bf16_t*)lds + wave * 4608;
    for (int u = gw; u < 1056; u += NGW) {
        const int tile = u % 132, r = u / 132; const int kvh = r & 1, b = (r >> 1) & 1, which = r >> 2;
        const int row = tile < 128 ? b * SEQ + tile * 64 + lane : ML + b * LCTX + (tile - 128) * 64 + lane;
        const bf16_t* src = P + (size_t)row * PW + (which ? C_VB : C_VA) + 64 * kvh;
#pragma unroll
        for (int q = 0; q < 8; ++q) *(u32x4*)(scr + lane * 72 + 8 * q) = *(const u32x4*)(src + 8 * q);
        LDSW();
        bf16_t* dst = (bf16_t*)(p.ws + (which ? OFF_VBT : OFF_VAT)) + (size_t)((b * 2 + kvh) * 64 + lane) * KVT + tile * 64;
#pragma unroll
        for (int q = 0; q < 8; ++q) { u32x4 o;
            const int t0 = 16 * (q >> 1) + 4 * (q & 1), t1 = t0 + 8;
            o.x = (unsigned)scr[(t0 + 0) * 72 + lane] | ((unsigned)scr[(t0 + 1) * 72 + lane] << 16); o.y = (unsigned)scr[(t0 + 2) * 72 + lane] | ((unsigned)scr[(t0 + 3) * 72 + lane] << 16);
            o.z = (unsigned)scr[(t1 + 0) * 72 + lane] | ((unsigned)scr[(t1 + 1) * 72 + lane] << 16); o.w = (unsigned)scr[(t1 + 2) * 72 + lane] | ((unsigned)scr[(t1 + 3) * 72 + lane] << 16);
            *(u32x4*)(dst + 8 * q) = o; }
        LDSW();
    }
}

__device__ __forceinline__ int ret_row(int b, int j, int s) { return j < 2 ? ML + b * LCTX + j * 128 + s : b * SEQ + (j - 2) * 128 + s; }
__device__ __forceinline__ void ret_load_rot(const bf16_t* P, const float2* ropes, int b, int j, int s, int q4, int col, float (&lo)[8], float (&hi)[8]) {
    const bf16_t* pk = P + (size_t)ret_row(b, j, s) * PW + col;
    const u32x4 a = *(const u32x4*)(pk + 8 * q4), c = *(const u32x4*)(pk + 32 + 8 * q4);
    lo[0] = bflo(a.x); lo[1] = bfhi(a.x); lo[2] = bflo(a.y); lo[3] = bfhi(a.y); lo[4] = bflo(a.z); lo[5] = bfhi(a.z); lo[6] = bflo(a.w); lo[7] = bfhi(a.w);
    hi[0] = bflo(c.x); hi[1] = bfhi(c.x); hi[2] = bflo(c.y); hi[3] = bfhi(c.y); hi[4] = bflo(c.z); hi[5] = bfhi(c.z); hi[6] = bflo(c.w); hi[7] = bfhi(c.w);
    if (j >= 2) { const int t = (j - 2) * 128 + s;
#pragma unroll
        for (int e = 0; e < 8; ++e) { const float2 cs = ropes[t * 32 + 8 * q4 + e]; const float y1 = lo[e] * cs.x - hi[e] * cs.y, y2 = hi[e] * cs.x + lo[e] * cs.y; lo[e] = y1; hi[e] = y2; } }
}
__device__ __forceinline__ void ret_load_vt(const bf16_t* P, bf16_t* VT, int b, int h, int j, int s, int q4) {
    const bf16_t* pv = P + (size_t)ret_row(b, j, s) * PW + C_RV + 64 * h + 16 * q4;
    const u32x4 a = *(const u32x4*)pv, c = *(const u32x4*)(pv + 8);
    bf16_t* d = VT + (16 * q4) * 136 + s;
    d[0 * 136] = (bf16_t)a.x; d[1 * 136] = (bf16_t)(a.x >> 16); d[2 * 136] = (bf16_t)a.y; d[3 * 136] = (bf16_t)(a.y >> 16);
    d[4 * 136] = (bf16_t)a.z; d[5 * 136] = (bf16_t)(a.z >> 16); d[6 * 136] = (bf16_t)a.w; d[7 * 136] = (bf16_t)(a.w >> 16);
    d[8 * 136] = (bf16_t)c.x; d[9 * 136] = (bf16_t)(c.x >> 16); d[10 * 136] = (bf16_t)c.y; d[11 * 136] = (bf16_t)(c.y >> 16);
    d[12 * 136] = (bf16_t)c.z; d[13 * 136] = (bf16_t)(c.z >> 16); d[14 * 136] = (bf16_t)c.w; d[15 * 136] = (bf16_t)(c.w >> 16);
}
__device__ __forceinline__ void ph_ret_local(const Params& p, int layer, unsigned char* lds, int tid, int bid, int G) {
    const bf16_t* P = (const bf16_t*)(p.ws + OFF_P); const float2* ropes = (const float2*)(p.ws + OFF_ROPES); float* Sloc = (float*)(p.ws + OFF_SLOC);
    bf16_t* KTf = (bf16_t*)lds; bf16_t* KTb = KTf + 64 * 136; bf16_t* VT = KTb + 64 * 136;
    const int lane = tid & 63, wave = tid >> 6, l31 = lane & 31, hi = lane >> 5, s = tid >> 2, q4 = tid & 3;
    for (int u = bid; u < 8 * NCH; u += G) {
        const int j = u % NCH, bh = u / NCH, b = bh >> 2, h = bh & 3;
        const float lgf = logsig(p.in[11][layer * 8 + h]), lgb = logsig(p.in[11][layer * 8 + 4 + h]);
        float lo[8], hi8[8]; ret_load_rot(P, ropes, b, j, s, q4, C_RK + 64 * h, lo, hi8);
        const float wf = expf(lgf * (float)(127 - s)) * 0.125f, wb = expf(lgb * (float)s) * 0.125f;
#pragma unroll
        for (int e = 0; e < 8; ++e) { const int d = 8 * q4 + e;
            KTf[d * 136 + s] = (bf16_t)f2bf(lo[e] * wf); KTf[(d + 32) * 136 + s] = (bf16_t)f2bf(hi8[e] * wf);
            KTb[d * 136 + s] = (bf16_t)f2bf(lo[e] * wb); KTb[(d + 32) * 136 + s] = (bf16_t)f2bf(hi8[e] * wb); }
        ret_load_vt(P, VT, b, h, j, s, q4);
        __syncthreads();
        const int dir = wave & 1, mb = (wave >> 1) & 1, nb = wave >> 2;
        const bf16_t* KT = dir ? KTb : KTf;
        f32x16 acc;
#pragma unroll
        for (int r = 0; r < 16; ++r) acc[r] = 0.f;
#pragma unroll
        for (int c = 0; c < 8; ++c) { const bf16x8 a = *(const bf16x8*)(VT + (32 * mb + l31) * 136 + 16 * c + 8 * hi); const bf16x8 bb = *(const bf16x8*)(KT + (32 * nb + l31) * 136 + 16 * c + 8 * hi);
            acc = MFMA32(a, bb, acc); }
        float* dst = Sloc + ((size_t)((bh * 2 + dir) * NCH + j)) * 4096 + 32 * nb + l31;
#pragma unroll
        for (int r = 0; r < 16; ++r) dst[(32 * mb + crow(r, hi)) * 64] = acc[r];
        __syncthreads();
    }
}
__device__ __forceinline__ void ph_ret_scan(const Params& p, int layer, int gtid, int NT) {
    const float* Sloc = (const float*)(p.ws + OFF_SLOC); bf16_t* St = (bf16_t*)(p.ws + OFF_ST);
    for (int e = gtid; e < 16 * 4096; e += NT) {
        const int seq = e >> 12, el = e & 4095, dir = seq & 1, h = (seq >> 1) & 3;
        const float g = expf(logsig(p.in[11][layer * 8 + dir * 4 + h]) * 128.0f);
        const float* sl = Sloc + (size_t)seq * NCH * 4096 + el; bf16_t* st = St + (size_t)seq * NCH * 4096 + el;
        float S = 0.f;
        if (dir == 0) {
#pragma unroll 11
            for (int j = 0; j < NCH; ++j) { st[(size_t)j * 4096] = (bf16_t)f2bf(S); S = S * g + sl[(size_t)j * 4096]; } }
        else { st[4096] = (bf16_t)f2bf(S); S = S * g + sl[4096]; st[0] = (bf16_t)f2bf(S); S = S * g + sl[0];
#pragma unroll 8
            for (int j = NCH - 1; j >= 2; --j) { st[(size_t)j * 4096] = (bf16_t)f2bf(S); S = S * g + sl[(size_t)j * 4096]; } }
    }
}
__device__ __forceinline__ void ret_rot_regs(const u32x4& a, const u32x4& c, const float2* ropes, int j, int s, int q4, float (&lo)[8], float (&hi)[8]) {
    lo[0] = bflo(a.x); lo[1] = bfhi(a.x); lo[2] = bflo(a.y); lo[3] = bfhi(a.y); lo[4] = bflo(a.z); lo[5] = bfhi(a.z); lo[6] = bflo(a.w); lo[7] = bfhi(a.w);
    hi[0] = bflo(c.x); hi[1] = bfhi(c.x); hi[2] = bflo(c.y); hi[3] = bfhi(c.y); hi[4] = bflo(c.z); hi[5] = bfhi(c.z); hi[6] = bflo(c.w); hi[7] = bfhi(c.w);
    if (j >= 2) { const int t = (j - 2) * 128 + s;
#pragma unroll
        for (int e = 0; e < 8; ++e) { const float2 cs = ropes[t * 32 + 8 * q4 + e]; const float y1 = lo[e] * cs.x - hi[e] * cs.y, y2 = hi[e] * cs.x + lo[e] * cs.y; lo[e] = y1; hi[e] = y2; } }
}
__device__ __forceinline__ void ph_ret_out(const Params& p, int layer, unsigned char* lds, int tid, int bid, int G) {
    const bf16_t* P = (const bf16_t*)(p.ws + OFF_P); const float2* ropes = (const float2*)(p.ws + OFF_ROPES); const bf16_t* St = (const bf16_t*)(p.ws + OFF_ST);
    bf16_t* MIX = (bf16_t*)(p.ws + OFF_MIX); const float* gnw = p.in[12] + layer * 256;
    bf16_t* Qs = (bf16_t*)lds; bf16_t* Ks = Qs + 128 * 72; bf16_t* VT = Ks + 128 * 72; float* red = (float*)(VT + 64 * 136);
    const int lane = tid & 63, wave = tid >> 6, l31 = lane & 31, hi = lane >> 5, s = tid >> 2, q4 = tid & 3;
    const int jlo = layer == 0 ? 0 : 2, nj = NCH - jlo, total = 8 * nj;
    u32x4 qa, qc, ka, kc, va, vc;
#define R3_LOAD(uu) do { const int j_ = jlo + (uu) % nj, bh_ = (uu) / nj; const bf16_t* pr_ = P + (size_t)ret_row(bh_ >> 2, j_, s) * PW + 64 * (bh_ & 3); \
        qa = *(const u32x4*)(pr_ + C_RQ + 8 * q4); qc = *(const u32x4*)(pr_ + C_RQ + 32 + 8 * q4); ka = *(const u32x4*)(pr_ + C_RK + 8 * q4); kc = *(const u32x4*)(pr_ + C_RK + 32 + 8 * q4); \
        va = *(const u32x4*)(pr_ + C_RV + 16 * q4); vc = *(const u32x4*)(pr_ + C_RV + 16 * q4 + 8); } while (0)
    if (bid < total) R3_LOAD(bid);
    for (int u = bid; u < total; u += G) {
        const int j = jlo + u % nj, bh = u / nj, b = bh >> 2, h = bh & 3;
        const float lgf = logsig(p.in[11][layer * 8 + h]), lgb = logsig(p.in[11][layer * 8 + 4 + h]);
        { float lo[8], hi8[8]; ret_rot_regs(qa, qc, ropes, j, s, q4, lo, hi8);
          *(bf16x8*)(Qs + s * 72 + 8 * q4) = pack8(lo[0], lo[1], lo[2], lo[3], lo[4], lo[5], lo[6], lo[7]);
          *(bf16x8*)(Qs + s * 72 + 32 + 8 * q4) = pack8(hi8[0], hi8[1], hi8[2], hi8[3], hi8[4], hi8[5], hi8[6], hi8[7]);
          ret_rot_regs(ka, kc, ropes, j, s, q4, lo, hi8);
          *(bf16x8*)(Ks + s * 72 + 8 * q4) = pack8(lo[0] * 0.125f, lo[1] * 0.125f, lo[2] * 0.125f, lo[3] * 0.125f, lo[4] * 0.125f, lo[5] * 0.125f, lo[6] * 0.125f, lo[7] * 0.125f);
          *(bf16x8*)(Ks + s * 72 + 32 + 8 * q4) = pack8(hi8[0] * 0.125f, hi8[1] * 0.125f, hi8[2] * 0.125f, hi8[3] * 0.125f, hi8[4] * 0.125f, hi8[5] * 0.125f, hi8[6] * 0.125f, hi8[7] * 0.125f); }
        { bf16_t* d = VT + (16 * q4) * 136 + s;
          d[0 * 136] = (bf16_t)va.x; d[1 * 136] = (bf16_t)(va.x >> 16); d[2 * 136] = (bf16_t)va.y; d[3 * 136] = (bf16_t)(va.y >> 16);
          d[4 * 136] = (bf16_t)va.z; d[5 * 136] = (bf16_t)(va.z >> 16); d[6 * 136] = (bf16_t)va.w; d[7 * 136] = (bf16_t)(va.w >> 16);
          d[8 * 136] = (bf16_t)vc.x; d[9 * 136] = (bf16_t)(vc.x >> 16); d[10 * 136] = (bf16_t)vc.y; d[11 * 136] = (bf16_t)(vc.y >> 16);
          d[12 * 136] = (bf16_t)vc.z; d[13 * 136] = (bf16_t)(vc.z >> 16); d[14 * 136] = (bf16_t)vc.w; d[15 * 136] = (bf16_t)(vc.w >> 16); }
        if (u + G < total) R3_LOAD(u + G);
        const int rb = wave & 3, dh = wave >> 2, iq = 32 * rb + l31;
        const size_t row = (size_t)ret_row(b, j, iq);
        bf16x8 sff[4], sbf[4]; u32x2 gwv[4];
        { const bf16_t* stf = St + ((size_t)((bh * 2 + 0) * NCH + j)) * 4096 + (32 * dh + l31) * 64 + 8 * hi;
          const bf16_t* stb = St + ((size_t)((bh * 2 + 1) * NCH + j)) * 4096 + (32 * dh + l31) * 64 + 8 * hi;
#pragma unroll
          for (int c = 0; c < 4; ++c) { sff[c] = *(const bf16x8*)(stf + 16 * c); sbf[c] = *(const bf16x8*)(stb + 16 * c); }
#pragma unroll
          for (int g = 0; g < 4; ++g) gwv[g] = *(const u32x2*)(P + row * PW + C_RG + 64 * h + 32 * dh + 8 * g + 4 * hi); }
        __syncthreads();
        bf16x8 qf[4];
#pragma unroll
        for (int c = 0; c < 4; ++c) qf[c] = *(const bf16x8*)(Qs + iq * 72 + 16 * c + 8 * hi);
        const float lgf2 = lgf * LOG2E, lgb2 = lgb * LOG2E;
        f32x16 o;
#pragma unroll
        for (int r = 0; r < 16; ++r) o[r] = 0.f;
#pragma unroll 1
        for (int sb = 0; sb < 4; ++sb) {
            f32x16 sa;
#pragma unroll
            for (int r = 0; r < 16; ++r) sa[r] = 0.f;
#pragma unroll
            for (int c = 0; c < 4; ++c) { const bf16x8 kf = *(const bf16x8*)(Ks + (32 * sb + l31) * 72 + 16 * c + 8 * hi); sa = MFMA32(kf, qf[c], sa); }
#pragma unroll
            for (int r = 0; r < 16; ++r) { const int dl = iq - (32 * sb + crow(r, hi));
                const float w = dl > 0 ? exp2f(lgf2 * (float)dl) : (dl < 0 ? exp2f(lgb2 * (float)(-dl)) : 2.0f); sa[r] *= w; }
#pragma unroll
            for (int c2 = 0; c2 < 2; ++c2) {
                const bf16x8 pa = pack8(sa[8 * c2 + 0], sa[8 * c2 + 1], sa[8 * c2 + 2], sa[8 * c2 + 3], sa[8 * c2 + 4], sa[8 * c2 + 5], sa[8 * c2 + 6], sa[8 * c2 + 7]);
                const bf16_t* vp = VT + (32 * dh + l31) * 136 + 32 * sb + 16 * c2 + 4 * hi;
                const bf16x8 vf = join8(*(const u32x2*)vp, *(const u32x2*)(vp + 8));
                o = MFMA32(vf, pa, o); }
        }
        f32x16 uf, ub;
#pragma unroll
        for (int r = 0; r < 16; ++r) { uf[r] = 0.f; ub[r] = 0.f; }
#pragma unroll
        for (int c = 0; c < 4; ++c) { uf = MFMA32(sff[c], qf[c], uf); ub = MFMA32(sbf[c], qf[c], ub); }
        const float xf = exp2f(lgf2 * (float)(iq + 1)), xb = exp2f(lgb2 * (float)(128 - iq));
        float sm = 0.f, sq = 0.f;
#pragma unroll
        for (int r = 0; r < 16; ++r) { o[r] += xf * uf[r] + xb * ub[r]; sm += o[r]; sq += o[r] * o[r]; }
        sm += __shfl_xor(sm, 32); sq += __shfl_xor(sq, 32);
        if (hi == 0) { red[(iq * 2 + dh) * 2 + 0] = sm; red[(iq * 2 + dh) * 2 + 1] = sq; }
        __syncthreads();
        const float tsum = red[(iq * 2 + 0) * 2 + 0] + red[(iq * 2 + 1) * 2 + 0], tsq = red[(iq * 2 + 0) * 2 + 1] + red[(iq * 2 + 1) * 2 + 1];
        const float mean = tsum * (1.0f / 64.0f), var = tsq * (1.0f / 64.0f) - mean * mean, rstd = rsqrtf(fmaxf(var, 0.f) + LN_EPS);
#pragma unroll
        for (int g = 0; g < 4; ++g) { const int d = 32 * dh + 8 * g + 4 * hi;
            const u32x2 gw = gwv[g]; const f32x4 nw = *(const f32x4*)(gnw + 64 * h + d);
            const float g0 = bflo(gw.x), g1 = bfhi(gw.x), g2 = bflo(gw.y), g3 = bfhi(gw.y);
            const float y0 = (o[4 * g + 0] - mean) * rstd * nw.x * (g0 / (1.0f + __expf(-g0))), y1 = (o[4 * g + 1] - mean) * rstd * nw.y * (g1 / (1.0f + __expf(-g1)));
            const float y2 = (o[4 * g + 2] - mean) * rstd * nw.z * (g2 / (1.0f + __expf(-g2))), y3 = (o[4 * g + 3] - mean) * rstd * nw.w * (g3 / (1.0f + __expf(-g3)));
            u32x2 w; w.x = pk2(y0, y1); w.y = pk2(y2, y3); *(u32x2*)(MIX + row * DM + 768 + 64 * h + d) = w; }
        __syncthreads();
    }
#undef R3_LOAD
}

__device__ __forceinline__ bf16x8 gather8(const bf16_t* base, size_t stride) {
    u32x4 o; o.x = (unsigned)base[0] | ((unsigned)base[stride] << 16); o.y = (unsigned)base[2 * stride] | ((unsigned)base[3 * stride] << 16);
    o.z = (unsigned)base[4 * stride] | ((unsigned)base[5 * stride] << 16); o.w = (unsigned)base[6 * stride] | ((unsigned)base[7 * stride] << 16); return __builtin_bit_cast(bf16x8, o);
}
__device__ __forceinline__ bf16x8 neg8(bf16x8 v) { u32x4 o = __builtin_bit_cast(u32x4, v); o.x ^= 0x80008000u; o.y ^= 0x80008000u; o.z ^= 0x80008000u; o.w ^= 0x80008000u; return __builtin_bit_cast(bf16x8, o); }
__device__ __forceinline__ void ph_four_a(const Params& p, unsigned char* lds, int gw, int NGW, int lane, int wave) {
    const bf16_t* P = (const bf16_t*)(p.ws + OFF_P); bf16_t* TB = (bf16_t*)(p.ws + OFF_TB); const float2* tw = (const float2*)(p.ws + OFF_TW);
    const bf16_t* F_r = (const bf16_t*)(p.ws + OFF_F128R); const bf16_t* F_i = (const bf16_t*)(p.ws + OFF_F128I);
    const int l31 = lane & 31, hi = lane >> 5, wv = __builtin_amdgcn_readfirstlane(wave);
    const bf16_t* ys = (const bf16_t*)lds + wv * 8192;
    for (int u = gw; u < 2048; u += NGW) {
        const int mh = u & 1, nb = (u >> 1) & 7, l2 = (u >> 4) & 63, b = u >> 10;
        { const bf16_t* src = P + (size_t)(b * SEQ + 64 * (lane >> 2) + l2) * PW + C_FR + 32 * nb + 8 * (lane & 3);
#pragma unroll
          for (int q = 0; q < 16; ++q)
              __builtin_amdgcn_global_load_lds((const unsigned*)(src + (size_t)(64 * 16 * (q & 7)) * PW + 256 * (q >> 3)), (LAS unsigned*)((LAS unsigned char*)lds + wv * 16384 + q * 1024), 16, 0, 0); }
        f32x16 tr[2], ti[2];
#pragma unroll
        for (int m = 0; m < 2; ++m)
#pragma unroll
            for (int r = 0; r < 16; ++r) { tr[m][r] = 0.f; ti[m][r] = 0.f; }
        asm volatile("s_waitcnt vmcnt(0)" ::: "memory");
#pragma unroll 4
        for (int c = 0; c < 8; ++c) {
            const bf16_t* yb = ys + (16 * c + 8 * hi) * 32 + l31;
            const bf16x8 yr = gather8(yb, 32), yi = gather8(yb + 4096, 32), nyi = neg8(yi);
#pragma unroll
            for (int m = 0; m < 2; ++m) { const int k1 = 32 * (2 * mh + m) + l31;
                const bf16x8 fr = *(const bf16x8*)(F_r + k1 * 128 + 16 * c + 8 * hi), fi = *(const bf16x8*)(F_i + k1 * 128 + 16 * c + 8 * hi);
                tr[m] = MFMA32(fr, yr, tr[m]); tr[m] = MFMA32(fi, nyi, tr[m]); ti[m] = MFMA32(fr, yi, ti[m]); ti[m] = MFMA32(fi, yr, ti[m]); }
        }
        LDSW();
#pragma unroll
        for (int m = 0; m < 2; ++m)
#pragma unroll
            for (int r = 0; r < 16; ++r) { const int k1 = 32 * (2 * mh + m) + crow(r, hi); const float2 w = tw[l2 * k1];
                const float a = tr[m][r] * w.x + ti[m][r] * w.y, bb = ti[m][r] * w.x - tr[m][r] * w.y;
                bf16_t* dst = TB + ((size_t)((b * 128 + k1) * 64 + l2)) * 512 + 32 * nb + l31; dst[0] = (bf16_t)f2bf(a); dst[256] = (bf16_t)f2bf(bb); }
    }
}
__device__ __forceinline__ void ph_four_b(const Params& p, unsigned char* lds, int gw, int NGW, int lane, int wave) {
    const bf16_t* TB = (const bf16_t*)(p.ws + OFF_TB); bf16_t* MIX = (bf16_t*)(p.ws + OFF_MIX);
    const bf16_t* C64 = (const bf16_t*)(p.ws + OFF_C64); const bf16_t* S64 = (const bf16_t*)(p.ws + OFF_S64);
    const int l31 = lane & 31, hi = lane >> 5, wv = __builtin_amdgcn_readfirstlane(wave);
    const bf16_t* xs = (const bf16_t*)lds + wv * 4096;
    for (int u = gw; u < 2048; u += NGW) {
        const int nb = u & 7, k1 = (u >> 3) & 127, b = u >> 10;
        const bf16_t* src = TB + ((size_t)((b * 128 + k1) * 64 + (lane >> 2))) * 512 + 32 * nb + 8 * (lane & 3);
#pragma unroll
        for (int q = 0; q < 8; ++q)
            __builtin_amdgcn_global_load_lds((const unsigned*)(src + (size_t)(16 * (q & 3)) * 512 + 256 * (q >> 2)), (LAS unsigned*)((LAS unsigned char*)lds + wv * 8192 + q * 1024), 16, 0, 0);
        f32x16 acc[2];
#pragma unroll
        for (int m = 0; m < 2; ++m)
#pragma unroll
            for (int r = 0; r < 16; ++r) acc[m][r] = 0.f;
        asm volatile("s_waitcnt vmcnt(0)" ::: "memory");
#pragma unroll
        for (int c = 0; c < 4; ++c) {
            const bf16_t* xb = xs + (16 * c + 8 * hi) * 32 + l31;
            const bf16x8 xr = gather8(xb, 32), xi = gather8(xb + 2048, 32);
#pragma unroll
            for (int m = 0; m < 2; ++m) { const bf16x8 cf = *(const bf16x8*)(C64 + (32 * m + l31) * 64 + 16 * c + 8 * hi), sf = *(const bf16x8*)(S64 + (32 * m + l31) * 64 + 16 * c + 8 * hi);
                acc[m] = MFMA32(cf, xr, acc[m]); acc[m] = MFMA32(sf, xi, acc[m]); }
        }
        LDSW();
#pragma unroll
        for (int m = 0; m < 2; ++m)
#pragma unroll
            for (int r = 0; r < 16; ++r) { const int lp = k1 + 128 * (32 * m + crow(r, hi));
                MIX[(size_t)(b * SEQ + lp) * DM + 512 + 32 * nb + l31] = (bf16_t)f2bf(acc[m][r] * 0.011048543456039806f); }
    }
}
__device__ __forceinline__ void ph_four_ctx(const Params& p, unsigned char* lds, int bid, int G, int lane, int wave) {
    const bf16_t* P = (const bf16_t*)(p.ws + OFF_P); bf16_t* MIX = (bf16_t*)(p.ws + OFF_MIX);
    const bf16_t* C256 = (const bf16_t*)(p.ws + OFF_C256); const bf16_t* S256 = (const bf16_t*)(p.ws + OFF_S256);
    const int l31 = lane & 31, hi = lane >> 5;
    if (__builtin_amdgcn_readfirstlane(wave) != 0) return;
    const bf16_t* ys = (const bf16_t*)lds;
    for (int u = bid; u < 128; u += G) {
        const int nb = u & 7, mb = (u >> 3) & 7, b = u >> 6;
        { const bf16_t* src = P + (size_t)(ML + b * LCTX + (lane >> 2)) * PW + C_FR + 32 * nb + 8 * (lane & 3);
#pragma unroll
          for (int q = 0; q < 32; ++q)
              __builtin_amdgcn_global_load_lds((const unsigned*)(src + (size_t)(16 * (q & 15)) * PW + 256 * (q >> 4)), (LAS unsigned*)((LAS unsigned char*)lds + q * 1024), 16, 0, 0); }
        f32x16 acc;
#pragma unroll
        for (int r = 0; r < 16; ++r) acc[r] = 0.f;
        asm volatile("s_waitcnt vmcnt(0)" ::: "memory");
#pragma unroll 4
        for (int c = 0; c < 16; ++c) {
            const bf16_t* yb = ys + (16 * c + 8 * hi) * 32 + l31;
            const bf16x8 yr = gather8(yb, 32), yi = gather8(yb + 8192, 32);
            const bf16x8 cf = *(const bf16x8*)(C256 + (32 * mb + l31) * 256 + 16 * c + 8 * hi), sf = *(const bf16x8*)(S256 + (32 * mb + l31) * 256 + 16 * c + 8 * hi);
            acc = MFMA32(cf, yr, acc); acc = MFMA32(sf, yi, acc);
        }
        LDSW();
#pragma unroll
        for (int r = 0; r < 16; ++r) MIX[(size_t)(ML + b * LCTX + 32 * mb + crow(r, hi)) * DM + 512 + 32 * nb + l31] = (bf16_t)f2bf(acc[r] * 0.0625f);
    }
}

#ifdef SELFCHECK
constexpr size_t OFF_FLAGS = 200 * KiB;
__device__ __forceinline__ unsigned hash32(unsigned x) { x ^= x >> 16; x *= 0x7feb352du; x ^= x >> 15; x *= 0x846ca68bu; x ^= x >> 16; return x; }
__device__ __forceinline__ void ph_selfcheck(const Params& p, int layer, int gw, int NGW, int lane) {
    const bf16_t* P = (const bf16_t*)(p.ws + OFF_P); const bf16_t* MIX = (const bf16_t*)(p.ws + OFF_MIX); unsigned* flags = (unsigned*)(p.ws + OFF_FLAGS);
    const float2* ropes = (const float2*)(p.ws + OFF_ROPES);
    for (int smp = gw; smp < 4096; smp += NGW) {
        const unsigned hsh = hash32(0x9e3779b9u * (unsigned)smp + 12345u);
        const int kind = smp & 3, b = (hsh >> 3) & 1, h = (hsh >> 4) & 3; const bool cx = (smp & 4) != 0;
        const int t = cx ? ((hsh >> 8) & 255) : ((hsh >> 8) & 8191);
        const int row = cx ? ML + b * LCTX + t : b * SEQ + t; const int d = lane;
        float ref = 0.f, got = 0.f;
        if (kind < 2) {
            const int isB = kind, kvh = h >> 1;
            const bf16_t* q = P + (size_t)row * PW + (isB ? C_QB : C_QA) + 64 * h;
            const int kcol = (isB ? C_KB : C_KA) + 64 * kvh, vcol = (isB ? C_VB : C_VA) + 64 * kvh;
            float mx = -1e30f;
            for (int pass = 0; pass < 2; ++pass) {
                float acc = 0.f, den = 0.f;
                for (int s = cx ? SEQ : 0; s < KVT; ++s) {
                    if (isB && s < SEQ) { int dd = s - t; dd = dd < 0 ? -dd : dd; if (dd > 128) continue; }
                    const int krow = s < SEQ ? b * SEQ + s : ML + b * LCTX + (s - SEQ);
                    const bf16_t* k = P + (size_t)krow * PW + kcol;
                    float sc = 0.f;
                    for (int e = 0; e < 64; ++e) sc += bf2f(q[e]) * bf2f(k[e]);
                    if (pass == 0) mx = fmaxf(mx, sc);
                    else { const float pr = exp2f(sc - mx); den += pr; acc += pr * bf2f(P[(size_t)krow * PW + vcol + d]); }
                }
                if (pass == 1) { if (isB) den += exp2f(p.in[9][layer * 4 + h] * LOG2E - mx); ref = acc / den; }
            }
            got = bf2f(MIX[(size_t)row * DM + (isB ? 256 : 0) + 64 * h + d]);
        } else if (kind == 2) {
            const int col = 64 * h + d; float acc = 0.f;
            if (!cx) { for (int l = 0; l < SEQ; ++l) { const int m = (l * t) & 8191; const float a = (float)m * (1.0f / 4096.0f);
                acc += cospif(a) * bf2f(P[(size_t)(b * SEQ + l) * PW + C_FR + col]) + sinpif(a) * bf2f(P[(size_t)(b * SEQ + l) * PW + C_FI + col]); }
              ref = acc * 0.011048543456039806f; }
            else { for (int l = 0; l < LCTX; ++l) { const int m = (l * t) & 255; const float a = (float)m * (1.0f / 128.0f);
                acc += cospif(a) * bf2f(P[(size_t)(ML + b * LCTX + l) * PW + C_FR + col]) + sinpif(a) * bf2f(P[(size_t)(ML + b * LCTX + l) * PW + C_FI + col]); }
              ref = acc * 0.0625f; }
            got = bf2f(MIX[(size_t)row * DM + 512 + col]);
        } else {
            const float lgf = logsig(p.in[11][layer * 8 + h]), lgb = logsig(p.in[11][layer * 8 + 4 + h]);
            float qv[64];
#pragma unroll
            for (int e = 0; e < 32; ++e) { const float x1 = bf2f(P[(size_t)row * PW + C_RQ + 64 * h + e]), x2 = bf2f(P[(size_t)row * PW + C_RQ + 64 * h + 32 + e]); const float2 cs = cx ? make_float2(1.f, 0.f) : ropes[t * 32 + e];
                qv[e] = x1 * cs.x - x2 * cs.y; qv[32 + e] = x2 * cs.x + x1 * cs.y; }
            float acc = 0.f;
            for (int s = cx ? SEQ : 0; s < KVT; ++s) {
                const int krow = s < SEQ ? b * SEQ + s : ML + b * LCTX + (s - SEQ);
                const bf16_t* k = P + (size_t)krow * PW + C_RK + 64 * h;
                float sc = 0.f;
#pragma unroll
                for (int e = 0; e < 32; ++e) { float x1 = bf2f(k[e]), x2 = bf2f(k[32 + e]);
                    if (s < SEQ) { const float2 cs = ropes[s * 32 + e]; const float y1 = x1 * cs.x - x2 * cs.y, y2 = x2 * cs.x + x1 * cs.y; x1 = y1; x2 = y2; }
                    sc += qv[e] * x1 + qv[32 + e] * x2; }
                sc *= 0.125f;
                float w;
                if (s < SEQ) { w = 0.f; if (s <= t) w += expf(lgf * (float)(t - s)); if (s >= t) w += expf(lgb * (float)(s - t)); }
                else if (!cx) { const int j = s - SEQ; w = expf(lgf * (float)(t + 256 - j)) + expf(lgb * (float)(8192 - t + j)); }
                else { const int j = s - SEQ; w = 0.f; if (j <= t) w += expf(lgf * (float)(t - j)); if (j >= t) w += expf(lgb * (float)(j - t)); }
                acc += w * sc * bf2f(P[(size_t)krow * PW + C_RV + 64 * h + d]);
            }
            const float mean = wave_sum(acc) * (1.0f / 64.0f); const float dv = acc - mean; const float var = wave_sum(dv * dv) * (1.0f / 64.0f);
            const float g = bf2f(P[(size_t)row * PW + C_RG + 64 * h + d]);
            ref = dv * rsqrtf(var + LN_EPS) * p.in[12][layer * 256 + 64 * h + d] * (g / (1.0f + expf(-g)));
            got = bf2f(MIX[(size_t)row * DM + 768 + 64 * h + d]);
        }
        const float e2 = wave_sum((ref - got) * (ref - got)), r2 = wave_sum(ref * ref);
        if (lane == 0 && !(e2 <= 0.0025f * r2 + 1e-12f)) atomicOr(flags, 1u << kind);
    }
}
#endif
#ifndef DBL
#define DBL 0
#endif
#define REP(k) for (int rep_ = 0; rep_ < 1 + ((DBL >> (k)) & 1); ++rep_)

template <bool masked, bool SAFE>
__device__ __forceinline__ bool attn_unit(const Params& p, int layer, unsigned char* lds, int tid, int b, int h, int qblk, int isB, int isctx) {
    const bf16_t* P = (const bf16_t*)(p.ws + OFF_P); bf16_t* MIX = (bf16_t*)(p.ws + OFF_MIX);
    bf16_t* Kt = (bf16_t*)lds;
    bf16_t* Vt = Kt + 4 * 4096;
    const int lane = tid & 63, wave = tid >> 6, l31 = lane & 31, hi = lane >> 5;
    const int kvh = h >> 1;
    const int qrow0 = isctx ? ML + b * LCTX : b * SEQ + 256 * qblk;
    int t_lo = 0, nlat = 128;
    if (isctx) nlat = 0; else if (isB) { t_lo = 4 * qblk - 2; if (t_lo < 0) t_lo = 0; int t_hi = 4 * qblk + 6; if (t_hi > 128) t_hi = 128; nlat = t_hi - t_lo; }
    const int ntile = nlat + 4;
    const int qcol = (isB ? C_QB : C_QA) + 64 * h, kcol = (isB ? C_KB : C_KA) + 64 * kvh;
    const bf16_t* VTg = (const bf16_t*)(p.ws + (isB ? OFF_VBT : OFF_VAT)) + (size_t)((b * 2 + kvh) * 64) * KVT;
    bf16x8 qf[4];
    { const bf16_t* qp = P + (size_t)(qrow0 + 32 * wave + l31) * PW + qcol + 8 * hi;
#pragma unroll
      for (int c = 0; c < 4; ++c) qf[c] = *(const bf16x8*)(qp + 16 * c); }
    const int qpos = 256 * qblk + 32 * wave + l31, qp0 = 256 * qblk + 32 * wave;
    f32x16 o0, o1;
#pragma unroll
    for (int r = 0; r < 16; ++r) { o0[r] = 0.f; o1[r] = 0.f; }
    float m = -1e30f, l = 0.f;
    f32x16 negm;
#pragma unroll
    for (int r = 0; r < 16; ++r) negm[r] = 0.f;
    bool first = true;
    const int wv = __builtin_amdgcn_readfirstlane(wave), dr = 8 * wv + (lane >> 3), dc = (lane & 7) ^ ((dr >> 1) & 7);
    const int sw = (l31 >> 1) & 7;
#define SWZ(idx) (8 * ((((idx) | hi)) ^ sw))
#define ATT_TILE(i) ((i) < nlat ? t_lo + (i) : 128 + (i) - nlat)
#define ATT_DMA(i, buf) do { const int t_ = ATT_TILE(i); const int krow_ = t_ < 128 ? b * SEQ + 64 * t_ + dr : ML + b * LCTX + 64 * (t_ - 128) + dr; \
    __builtin_amdgcn_global_load_lds((const unsigned*)(P + (size_t)krow_ * PW + kcol + 8 * dc), (LAS unsigned*)((LAS unsigned char*)lds + (buf) * 8192 + wv * 1024), 16, 0, 0); \
    __builtin_amdgcn_global_load_lds((const unsigned*)(VTg + (size_t)dr * KVT + 64 * t_ + 8 * dc), (LAS unsigned*)((LAS unsigned char*)lds + 32768 + (buf) * 8192 + wv * 1024), 16, 0, 0); } while (0)
    ATT_DMA(0, 0); ATT_DMA(1, 1);
    __syncthreads();
    for (int ip = 0; ip < ntile; ip += 2) {
      const int stage = (ip >> 1) & 1;
      if (ip + 2 < ntile) { ATT_DMA(ip + 2, (stage ^ 1) * 2); ATT_DMA(ip + 3, (stage ^ 1) * 2 + 1); }
#pragma unroll 1
      for (int sub = 0; sub < 2; ++sub) {
        const int i = ip + sub; const int buf = stage * 2 + sub;
        const int t = ATT_TILE(i);
        const bool lat = t < 128;
        const bool active = !(isB && lat) || (64 * t + 63 >= qp0 - 128 && 64 * t <= qp0 + 31 + 128);
        if (active) {
            const bf16_t* kb = Kt + buf * 4096 + l31 * 64;
            f32x16 s0, s1;
#define ATT_SCORES() do { s0 = MFMA32(*(const bf16x8*)(kb + SWZ(0)), qf[0], negm); s1 = MFMA32(*(const bf16x8*)(kb + 2048 + SWZ(0)), qf[0], negm); \
                _Pragma("unroll") for (int c = 1; c < 4; ++c) { s0 = MFMA32(*(const bf16x8*)(kb + SWZ(2 * c)), qf[c], s0); s1 = MFMA32(*(const bf16x8*)(kb + 2048 + SWZ(2 * c)), qf[c], s1); } } while (0)
#define ATT_MASK() do { if (masked && lat) { _Pragma("unroll") for (int r = 0; r < 16; ++r) { const int kp = 64 * t + crow(r, hi); int d0 = kp - qpos; d0 = d0 < 0 ? -d0 : d0; int d1 = kp + 32 - qpos; d1 = d1 < 0 ? -d1 : d1; \
                if (d0 > 128) s0[r] = -1e30f; if (d1 > 128) s1[r] = -1e30f; } } } while (0)
            ATT_SCORES();
            const bf16_t* vb = Vt + buf * 4096 + l31 * 64;
            const bf16x8 vf00 = *(const bf16x8*)(vb + SWZ(0)), vf01 = *(const bf16x8*)(vb + SWZ(4)), vf02 = *(const bf16x8*)(vb + SWZ(2)), vf03 = *(const bf16x8*)(vb + SWZ(6));
            const bf16x8 vf10 = *(const bf16x8*)(vb + 2048 + SWZ(0)), vf11 = *(const bf16x8*)(vb + 2048 + SWZ(4)), vf12 = *(const bf16x8*)(vb + 2048 + SWZ(2)), vf13 = *(const bf16x8*)(vb + 2048 + SWZ(6));
            __builtin_amdgcn_sched_barrier(0);
            ATT_MASK();
            {
                if (first) { first = false;
                    float mx = fmaxf(s0[0], s1[0]);
#pragma unroll
                    for (int r = 1; r < 16; ++r) mx = fmaxf(mx, fmaxf(s0[r], s1[r]));
                    m = xhalf_max(mx); if (masked) m = m < -1e29f ? 0.f : m;
#pragma unroll
                    for (int r = 0; r < 16; ++r) { s0[r] -= m; s1[r] -= m; negm[r] = -m; } }
                float ps = 0.f, ps1 = 0.f;
#pragma unroll
                for (int r = 0; r < 16; ++r) { s0[r] = __builtin_amdgcn_exp2f(s0[r]); s1[r] = __builtin_amdgcn_exp2f(s1[r]); ps += s0[r]; ps += s1[r]; }
                (void)ps1;
                if (SAFE && __any(!(ps <= 4096.0f))) {
                    ATT_SCORES(); ATT_MASK();
                    float mx = fmaxf(s0[0], s1[0]);
#pragma unroll
                    for (int r = 1; r < 16; ++r) mx = fmaxf(mx, fmaxf(s0[r], s1[r]));
                    mx = xhalf_max(mx);
                    const float dl = fmaxf(mx, 0.f), sc = __builtin_amdgcn_exp2f(-dl); m += dl; l *= sc; ps = 0.f;
#pragma unroll
                    for (int r = 0; r < 16; ++r) { o0[r] *= sc; o1[r] *= sc; negm[r] = -m; s0[r] = __builtin_amdgcn_exp2f(s0[r] - dl); s1[r] = __builtin_amdgcn_exp2f(s1[r] - dl); ps += s0[r] + s1[r]; }
                }
                l += ps;
            }
#undef ATT_MASK
#undef ATT_SCORES
            {   const bf16x8 pa00 = pack8(s0[0], s0[1], s0[2], s0[3], s0[4], s0[5], s0[6], s0[7]), pa10 = pack8(s1[0], s1[1], s1[2], s1[3], s1[4], s1[5], s1[6], s1[7]);
                const bf16x8 pa01 = pack8(s0[8], s0[9], s0[10], s0[11], s0[12], s0[13], s0[14], s0[15]), pa11 = pack8(s1[8], s1[9], s1[10], s1[11], s1[12], s1[13], s1[14], s1[15]);
                o0 = MFMA32(vf00, pa00, o0); o1 = MFMA32(vf10, pa00, o1);
                o0 = MFMA32(vf01, pa10, o0); o1 = MFMA32(vf11, pa10, o1);
                o0 = MFMA32(vf02, pa01, o0); o1 = MFMA32(vf12, pa01, o1);
                o0 = MFMA32(vf03, pa11, o0); o1 = MFMA32(vf13, pa11, o1);
            }
        }
      }
      __syncthreads();
    }
#undef ATT_TILE
#undef ATT_DMA
#undef SWZ
    l = xhalf_sum(l);
    const bool bad = !SAFE && __syncthreads_or(!(l < 1e30f) ? 1 : 0) != 0;
    if (bad) return true;
    if (isB) l += exp2f(p.in[9][layer * 4 + h] * LOG2E - m);
    const float inv = 1.0f / l;
    bf16_t* op = MIX + (size_t)(qrow0 + 32 * wave + l31) * DM + (isB ? 256 : 0) + 64 * h + 4 * hi;
#pragma unroll
    for (int g = 0; g < 4; ++g) { u32x2 w; w.x = pk2(o0[4 * g] * inv, o0[4 * g + 1] * inv); w.y = pk2(o0[4 * g + 2] * inv, o0[4 * g + 3] * inv); *(u32x2*)(op + 8 * g) = w;
        u32x2 w1; w1.x = pk2(o1[4 * g] * inv, o1[4 * g + 1] * inv); w1.y = pk2(o1[4 * g + 2] * inv, o1[4 * g + 3] * inv); *(u32x2*)(op + 32 + 8 * g) = w1; }
    return false;
}
__device__ __forceinline__ void ph_attn(const Params& p, int layer, unsigned char* lds, int tid, int bid, int G) {
    const int nlat_u = bid < 512 ? (512 - bid + G - 1) / G : 0;
    int cv0 = 0, cvstep = 1, ncv = 0;
    if (layer == 0) { if (G >= 32) { cv0 = bid - (G - 16); ncv = cv0 >= 0 ? 1 : 0; } else { cv0 = bid; cvstep = G; ncv = bid < 16 ? (16 - bid + G - 1) / G : 0; } }
    for (int k = 0; k < nlat_u + ncv; ++k) {
        const int u = k < nlat_u ? bid + k * G : 512 + cv0 + (k - nlat_u) * cvstep;
        int b, h, qblk, isB, isctx;
        if (u < 512) { const int v = u & 255, grp = v & 3, idx = v >> 2; isB = u >> 8; isctx = 0; b = grp >> 1; h = (grp & 1) * 2 + (idx >> 5); qblk = idx & 31; }
        else { const int v = u - 512; isB = v >> 3; isctx = 1; b = (v >> 2) & 1; h = v & 3; qblk = 0; }
        if (isB && !isctx) { if (attn_unit<true, false>(p, layer, lds, tid, b, h, qblk, isB, isctx)) attn_unit<true, true>(p, layer, lds, tid, b, h, qblk, isB, isctx); }
        else { if (attn_unit<false, false>(p, layer, lds, tid, b, h, qblk, isB, isctx)) attn_unit<false, true>(p, layer, lds, tid, b, h, qblk, isB, isctx); }
    }
}

__device__ __forceinline__ void ph_ctx_gemm(const bf16_t* A, const bf16_t* Bt, bf16_t* O, int K, int gw, int NGW, int lane) {
    const int l31 = lane & 31, hi = lane >> 5;
    for (int u = gw; u < 512; u += NGW) {
        const int mb = u >> 5, nb = u & 31;
        const bf16_t* ap = A + (size_t)(ML + 32 * mb + l31) * K + 8 * hi; const bf16_t* bp = Bt + (size_t)(32 * nb + l31) * K + 8 * hi;
        f32x16 acc;
#pragma unroll
        for (int r = 0; r < 16; ++r) acc[r] = 0.f;
#pragma unroll 8
        for (int c = 0; c < K / 16; ++c) acc = MFMA32(*(const bf16x8*)(ap + 16 * c), *(const bf16x8*)(bp + 16 * c), acc);
#pragma unroll
        for (int r = 0; r < 16; ++r) O[(size_t)(ML + 32 * mb + crow(r, hi)) * DM + 32 * nb + l31] = (bf16_t)f2bf(acc[r]);
    }
}

__global__ void __launch_bounds__(512, 2) fwd_megakernel(Params p_arg) {
    extern __shared__ __attribute__((aligned(16))) unsigned char lds[];
    cg::grid_group grid = cg::this_grid();
    const int n_steps = p_arg.n_steps;
    volatile LAS unsigned* bst = (volatile LAS unsigned*)((LAS unsigned char*)lds + 140000);
    if (threadIdx.x < 2) bst[threadIdx.x] = 0u;
    __syncthreads();
    const XcdBarrier xbar = xcd_barrier_post((unsigned*)(p_arg.ws + OFF_BAR), bst);
#define GRID_SYNC() do { if (n_steps < 0) grid.sync(); else xcd_barrier(xbar); } while (0)
#pragma unroll 1
    for (int step = 0; step < n_steps; ++step) {
        const __attribute__((address_space(4))) Params* pp = (const __attribute__((address_space(4))) Params*)__builtin_amdgcn_kernarg_segment_ptr();
        asm volatile("" : "+s"(pp));
#if defined(__HIP_DEVICE_COMPILE__)
        const Params p = *pp;
#else
        const Params p = p_arg;
#endif
        int bid = blockIdx.x; asm volatile("" : "+s"(bid));
        const int G = gridDim.x, NGW = G * 8, NT = G * 512;
        unsigned char* ws = p.ws;
        const int layer = step < 2 ? 0 : (step - 2) / 9, ph = step < 2 ? step : 2 + (step - 2) % 9;
        const bool last = layer == 1;
        const int mrows = last ? ML : MT;
        int gk = 0;
        const bf16_t* gA = nullptr; const bf16_t* gB = nullptr; bf16_t* gO = nullptr; int gM = 0, gN = 0, gK = 0;
#define IDS int t_ = threadIdx.x; asm volatile("" : "+v"(t_)); const int tid = t_, lane = t_ & 63, wave = __builtin_amdgcn_readfirstlane(t_ >> 6), gw = bid * 8 + wave, gtid = bid * 512 + t_; (void)tid; (void)lane; (void)wave; (void)gw; (void)gtid
        switch (ph) {
        case 0:
#ifdef SELFCHECK
            { IDS; if (gtid == 0) *(unsigned*)(ws + OFF_FLAGS) = 0u; }
#endif
            { IDS; ph_tables(ws, gtid, NT); }
            REP(7) { { IDS; ph_mod(p.in[1], p.in[3], p.in[4], p.in[5], (float*)(ws + OFF_MOD), lds, tid, bid, G); } __syncthreads(); { IDS; ph_weights(p, 0, lds, tid, bid, G, 48); } __syncthreads(); } break;
        case 1: REP(6) { IDS; ph_h0(p, gw, NGW, lane); } break;
        case 2: gk = 1; gA = (const bf16_t*)(ws + OFF_H); gB = (const bf16_t*)(ws + OFF_WIN); gO = (bf16_t*)(ws + OFF_P); gM = MT; gN = PW; gK = DM; break;
        case 3: { IDS; ph_prep(p, layer, lds, gw, NGW, lane, wave); } __syncthreads(); REP(2) { IDS; ph_ret_local(p, layer, lds, tid, bid, G); } REP(3) { { IDS; ph_four_a(p, lds, gw, NGW, lane, wave); } if (!last) { __syncthreads(); { IDS; ph_four_ctx(p, lds, bid, G, lane, wave); } } } break;
        case 4: REP(9) { IDS; ph_ret_scan(p, layer, gtid, NT); } REP(0) { IDS; ph_attn(p, layer, lds, tid, bid, G); } REP(4) { IDS; ph_four_b(p, lds, gw, NGW, lane, wave); } break;
        case 5: REP(5) { IDS; ph_ret_out(p, layer, lds, tid, bid, G); }
#ifdef SELFCHECK
            if (layer == 0) { GRID_SYNC(); { IDS; ph_selfcheck(p, layer, gw, NGW, lane); } }
#endif
            break;
        case 6: gk = 1; gA = (const bf16_t*)(ws + OFF_MIX); gB = (const bf16_t*)(ws + OFF_WOUT); gO = (bf16_t*)(ws + OFF_P); gM = ML; gN = DM; gK = DM; break;
        case 7: { IDS; ph_rowpass(p, layer, 0, mrows, true, gw, NGW, lane); } break;
        case 8: gk = 2; gA = (const bf16_t*)(ws + OFF_H); gB = (const bf16_t*)(ws + OFF_WGU); gO = (bf16_t*)(ws + OFF_P); gM = mrows; gN = 2 * FF; gK = DM; break;
        case 9: gk = 1; gA = (const bf16_t*)(ws + OFF_P); gB = (const bf16_t*)(ws + OFF_WDN); gO = (bf16_t*)(ws + OFF_Y2); gM = ML; gN = DM; gK = FF; break;
        default: { IDS; ph_rowpass(p, layer, 1, mrows, !last, gw, NGW, lane); } if (!last) { IDS; ph_weights(p, 1, lds, tid, bid, G); } break;
        }
        if (gk == 1) REP(1) { pg8::Gemm g{gA, gB, gM, gN, gK}; pg8::StaticOrder S; S.init(gM, gN, G, bid);
            pg8::EpiPlain E{gO, gN};
            pg8::gemm_phase<pg8::EpiPlain, pg8::StaticOrder, true, true>((PG8_LAS unsigned char*)lds, g, S, E);
            if (!last && gN == DM) { IDS; ph_ctx_gemm(gA, gB, gO, gK, gw, NGW, lane); } }
        else if (gk == 2) REP(1) { pg8::Gemm g{gA, gB, gM, gN, gK}; pg8::StaticOrder S; S.init(gM, gN, G, bid);
            pg8::EpiSwiglu E{gO, FF};
            pg8::gemm_phase<pg8::EpiSwiglu, pg8::StaticOrder, true, true>((PG8_LAS unsigned char*)lds, g, S, E); }
        if (step + 1 < n_steps) GRID_SYNC();
        REP(8) { if (rep_ == 1) GRID_SYNC(); }
    }
}

extern "C" void kernel_launch(void* const* d_in, const int* in_sizes, int n_in, void* d_out, int out_size, void* d_ws, size_t ws_size, hipStream_t stream) {
    static int grid = 0;
    if (grid == 0) {
        if (n_in != 20 || out_size != ML * DM || ws_size < WS_NEED) { fprintf(stderr, "kernel_launch: unexpected shapes (n_in %d, out %d, ws %zu)\n", n_in, out_size, ws_size); grid = -1; return; }
        int dev = 0, cus = 0, per_cu = 0;
        hipGetDevice(&dev); hipDeviceGetAttribute(&cus, hipDeviceAttributeMultiprocessorCount, dev);
        if (hipFuncSetAttribute((const void*)fwd_megakernel, hipFuncAttributeMaxDynamicSharedMemorySize, LDS_BYTES) != hipSuccess) { fprintf(stderr, "kernel_launch: hipFuncSetAttribute failed\n"); grid = -1; return; }
        if (hipOccupancyMaxActiveBlocksPerMultiprocessor(&per_cu, (const void*)fwd_megakernel, 512, LDS_BYTES) != hipSuccess || per_cu < 1) { fprintf(stderr, "kernel_launch: occupancy query says %d\n", per_cu); per_cu = 1; }
        (void)hipGetLastError();
        grid = cus;
    }
    if (grid < 0) return;
    Params p{};
    p.n_steps = 20; p.pad = 0;
    for (int i = 0; i < 20; ++i) p.in[i] = (const float*)d_in[i];
    p.out = (float*)d_out; p.ws = (unsigned char*)d_ws;
    if (hipMemsetAsync((char*)d_ws + OFF_BAR, 0, 16384, stream) != hipSuccess) { fprintf(stderr, "kernel_launch: memset failed\n"); return; }
    void* args[] = {&p};
    hipError_t e = hipLaunchCooperativeKernel((const void*)fwd_megakernel, dim3(grid), dim3(512), args, LDS_BYTES, stream);
    if (e != hipSuccess) fprintf(stderr, "cooperative launch failed: %s (grid %d)\n", hipGetErrorString(e), grid);
}
```

```cpp
#include <hip/hip_runtime.h>
#include <hip/hip_cooperative_groups.h>
#include <cstdio>
#include <cstdint>
namespace cg = cooperative_groups;
namespace pg8 {
#define PG8_LAS __attribute__((address_space(3)))
typedef unsigned short bf16_t;
typedef short bf16x8 __attribute__((ext_vector_type(8)));
typedef float f32x4 __attribute__((ext_vector_type(4)));
typedef unsigned u32x4 __attribute__((ext_vector_type(4)));
constexpr int BM = 256, BK = 64, HALF = 128, HTB = HALF * BK * 2  , STAGE_BYTES = 8 * HTB, NXCD = 8, WGM = 8;

__host__ __device__ __forceinline__ int lds_byte(int r, int c) { const int st = (r >> 4) * 2 + (c >> 5), rr = r & 15, cc = c & 31, ob = rr * 64 + cc * 2; return st * 1024 + (ob ^ (((ob >> 9) & 1) << 5)); }
__host__ __device__ __forceinline__ void stage_rc(int b, int& R, int& C) { const int st = b / 1024, sb = b % 1024, swz = sb ^ (((sb >> 9) & 1) << 5); R = (st >> 1) * 16 + swz / 64; C = (st & 1) * 32 + (swz % 64) / 2; }
__host__ __device__ __forceinline__ int perm32(int rho) { const int n = rho >> 4, i = rho & 15; return 8 * (i >> 2) + 4 * n + (i & 3); }

struct Unit { int pm, pn; };
struct Gemm { const bf16_t* A; const bf16_t* Bt; int M, N, K; };

struct StaticOrder {
    int nM, nN, nwg, G, c;
    __host__ __device__ void init(int M, int N, int G_, int c_) { nM = M / BM; nN = N / BM; nwg = nM * nN; G = G_; c = c_; }
    __host__ __device__ bool next(int i, Unit& u) const {
        const long L = (long)i * G + c; if (L >= nwg) return false;
        int wgid = (int)L; { const int q = nwg / NXCD, r = nwg % NXCD, xcd = wgid % NXCD, off = wgid / NXCD; wgid = (xcd < r ? xcd * (q + 1) : r * (q + 1) + (xcd - r) * q) + off; }
        const int nig = WGM * nN, gid = wgid / nig, fm = gid * WGM, gsz = (nM - fm) < WGM ? (nM - fm) : WGM;
        u.pm = fm + ((wgid % nig) % gsz); u.pn = (wgid % nig) / gsz; return true;
    }
    __device__ __forceinline__ void a_ready(const Unit&) const {}
    __device__ __forceinline__ void done(const Unit&) const {}
};

__device__ __forceinline__ unsigned cvt_pk_bf16(float lo, float hi) { unsigned r; asm volatile("v_cvt_pk_bf16_f32 %0, %1, %2" : "=v"(r) : "v"(lo), "v"(hi)); return r; }
typedef float f32x2 __attribute__((ext_vector_type(2)));
__device__ __forceinline__ f32x2 gelu_pk(f32x2 v) {
    const f32x2 av = __builtin_elementwise_abs(v), d = av * 0.2316418882f + 1.0f;
    f32x2 t; t.x = __builtin_amdgcn_rcpf(d.x); t.y = __builtin_amdgcn_rcpf(d.y);
    f32x2 q = t * 0.5307027145f + (-0.7265760135f); q = q * t + 0.7107068705f; q = q * t + (-0.142248368f); q = q * t + 0.127414796f; q = q * t;
    const f32x2 s = (v * v) * (-0.72134752044f);
    f32x2 e; e.x = __builtin_amdgcn_exp2f(s.x); e.y = __builtin_amdgcn_exp2f(s.y);
    const f32x2 m = v * (q * e), r = v - m;
    f32x2 o; o.x = v.x < 0.f ? m.x : r.x; o.y = v.y < 0.f ? m.y : r.y; return o;
}

template <int ACT  > struct EpiBf16 {
    static constexpr bool PERM = true, AFTER_DRAIN = false; static_assert(ACT == 0 || ACT == 1, "EpiBf16: ACT is 0 (none) or 1 (gelu_pk)");
    bf16_t* O; int ldc; const float* bias; int split_cols; size_t split_stride; float scale0;
    __device__ __forceinline__ void operator()(const f32x4 (&acc)[2][2][4][2], const Unit& u, int wr, int wc, int fr, int fq) const {
        const int row0 = u.pm * BM + wr * 64 + fr; int colt = u.pn * BM; bf16_t* base = O;
        float sc = 1.f; if (split_cols) { const int t = colt / split_cols; base += (size_t)t * split_stride; colt -= t * split_cols; if (t == 0) sc = scale0; }
        const int col0 = colt + wc * 32 + 8 * fq, bcol0 = u.pn * BM + wc * 32 + 8 * fq;
        f32x4 bv[2][2];
#pragma unroll
        for (int bj = 0; bj < 2; ++bj)
#pragma unroll
            for (int n = 0; n < 2; ++n) bv[bj][n] = bias ? *(const f32x4*)(bias + bcol0 + bj * HALF + 4 * n) : (f32x4){0.f, 0.f, 0.f, 0.f};
#pragma unroll
        for (int ai = 0; ai < 2; ++ai)
#pragma unroll
            for (int m = 0; m < 4; ++m) { bf16_t* rowp = base + (size_t)(row0 + ai * HALF + m * 16) * ldc + col0;
#pragma unroll
                for (int bj = 0; bj < 2; ++bj) { f32x4 v0 = acc[ai][bj][m][0] + bv[bj][0], v1 = acc[ai][bj][m][1] + bv[bj][1];
                    if (ACT == 1) { f32x2 a = gelu_pk((f32x2){v0[0], v0[1]}), b = gelu_pk((f32x2){v0[2], v0[3]}), c = gelu_pk((f32x2){v1[0], v1[1]}), d = gelu_pk((f32x2){v1[2], v1[3]});
                        v0 = (f32x4){a.x, a.y, b.x, b.y}; v1 = (f32x4){c.x, c.y, d.x, d.y}; }
                    v0 = v0 * sc; v1 = v1 * sc; u32x4 w; w.x = cvt_pk_bf16(v0[0], v0[1]); w.y = cvt_pk_bf16(v0[2], v0[3]); w.z = cvt_pk_bf16(v1[0], v1[1]); w.w = cvt_pk_bf16(v1[2], v1[3]);
                    *(u32x4*)(rowp + bj * HALF) = w; } }
    }
};

struct EpiSwiglu {
    static constexpr bool PERM = true, AFTER_DRAIN = false;
    bf16_t* O; int ldo;
    __device__ __forceinline__ void operator()(const f32x4 (&acc)[2][2][4][2], const Unit& u, int wr, int wc, int fr, int fq) const {
        const int row0 = u.pm * BM + wr * 64 + fr; const int col0 = u.pn * 128 + wc * 32 + 8 * fq;
#pragma unroll
        for (int ai = 0; ai < 2; ++ai)
#pragma unroll
            for (int m = 0; m < 4; ++m) { bf16_t* rowp = O + (size_t)(row0 + ai * HALF + m * 16) * ldo + col0;
                float r[8];
#pragma unroll
                for (int n = 0; n < 2; ++n)
#pragma unroll
                    for (int e = 0; e < 4; ++e) { const float g = acc[ai][0][m][n][e], up = acc[ai][1][m][n][e];
                        r[4 * n + e] = g * __builtin_amdgcn_rcpf(1.0f + __expf(-g)) * up; }
                u32x4 w; w.x = cvt_pk_bf16(r[0], r[1]); w.y = cvt_pk_bf16(r[2], r[3]); w.z = cvt_pk_bf16(r[4], r[5]); w.w = cvt_pk_bf16(r[6], r[7]);
                *(u32x4*)rowp = w; }
    }
};

struct EpiPlain {
    static constexpr bool PERM = true, AFTER_DRAIN = false;
    bf16_t* O; int ldc;
    __device__ __forceinline__ void operator()(const f32x4 (&acc)[2][2][4][2], const Unit& u, int wr, int wc, int fr, int fq) const {
        bf16_t* base = O + (size_t)(u.pm * BM + wr * 64 + fr) * ldc + u.pn * BM + wc * 32 + 8 * fq;
#pragma unroll
        for (int ai = 0; ai < 2; ++ai)
#pragma unroll
            for (int m = 0; m < 4; ++m) { bf16_t* rowp = base + (size_t)(ai * HALF + m * 16) * ldc;
#pragma unroll
                for (int bj = 0; bj < 2; ++bj) { const f32x4 v0 = acc[ai][bj][m][0], v1 = acc[ai][bj][m][1];
                    u32x4 w; w.x = cvt_pk_bf16(v0[0], v0[1]); w.y = cvt_pk_bf16(v0[2], v0[3]); w.z = cvt_pk_bf16(v1[0], v1[1]); w.w = cvt_pk_bf16(v1[2], v1[3]);
                    *(u32x4*)(rowp + bj * HALF) = w; } }
    }
};
template <class Epi, class Sched, bool ALIGN_EPI = false, bool SP2 = false>
__device__ __forceinline__ void gemm_phase(PG8_LAS unsigned char* lds, const Gemm g, const Sched& S, const Epi& E) {
    int tid_ = threadIdx.x; asm volatile("" : "+v"(tid_));
    const int tid = tid_, wid = __builtin_amdgcn_readfirstlane(tid >> 6), lane = tid & 63, wr = wid >> 2, wc = wid & 3, fr = lane & 15, fq = lane >> 4;
    const int K = g.K, nt = K / BK;
    unsigned voffA[2], voffB[2];
#pragma unroll
    for (int i = 0; i < 2; ++i) { int R, C; stage_rc(tid * 16 + i * 8192, R, C); const int Rb = Epi::PERM ? ((R & ~31) + perm32(R & 31)) : R;
        voffA[i] = (unsigned)(R * K + C) * 2u; voffB[i] = (unsigned)(Rb * K + C) * 2u; }
    const size_t kstep = (size_t)(BK * 2);
    const size_t hstep = (size_t)HALF * K * 2;
    const size_t tstep = 2 * hstep;
    const unsigned ldsw = (unsigned)wid * 1024u;
    const int aoff = lds_byte(wr * 64 + fr, fq * 8), boff = lds_byte(wc * 32 + fr, fq * 8);
#define PG8_SA(b, h) (((b) * 2 + (h)) * HTB)
#define PG8_SB(b, h) ((4 + (b) * 2 + (h)) * HTB)
#define PG8_STAGE(bufoff, gbase, voff) do { _Pragma("unroll") for (int _i = 0; _i < 2; ++_i) \
        __builtin_amdgcn_global_load_lds((const unsigned*)((const char*)(gbase) + (voff)[_i]), (PG8_LAS unsigned*)(lds + (bufoff) + ldsw + _i * 8192), 16, 0, 0); } while (0)
#define PG8_LDA(dst, b, h) do { _Pragma("unroll") for (int m = 0; m < 4; ++m) _Pragma("unroll") for (int k = 0; k < 2; ++k) dst[m][k] = *(const PG8_LAS bf16x8*)(lds + PG8_SA(b, h) + aoff + m * 2048 + k * 1024); } while (0)
#define PG8_LDB(dst, b, h) do { _Pragma("unroll") for (int n = 0; n < 2; ++n) _Pragma("unroll") for (int k = 0; k < 2; ++k) dst[n][k] = *(const PG8_LAS bf16x8*)(lds + PG8_SB(b, h) + boff + n * 2048 + k * 1024); } while (0)
#define PG8_MMA(ai, bj, At, Bt) do { __builtin_amdgcn_s_setprio(1); _Pragma("unroll") for (int m = 0; m < 4; ++m) _Pragma("unroll") for (int n = 0; n < 2; ++n) _Pragma("unroll") for (int k = 0; k < 2; ++k) \
        acc[ai][bj][m][n] = __builtin_amdgcn_mfma_f32_16x16x32_bf16(Bt[n][k], At[m][k], acc[ai][bj][m][n], 0, 0, 0); __builtin_amdgcn_s_setprio(0); } while (0)
#define PG8_WAIT_V(n) asm volatile("s_waitcnt vmcnt(" #n ")" ::: "memory")
#define PG8_WAIT_L(n) asm volatile("s_waitcnt lgkmcnt(" #n ")" ::: "memory")
#define PG8_BAR __builtin_amdgcn_s_barrier()
#define PG8_SCHED __builtin_amdgcn_sched_barrier(0)
    Unit cur, nxt; int ui = 0;
    if (!S.next(0, cur)) return;
    f32x4 acc[2][2][4][2];
#pragma unroll
    for (int a = 0; a < 2; ++a)
#pragma unroll
        for (int b = 0; b < 2; ++b)
#pragma unroll
            for (int m = 0; m < 4; ++m)
#pragma unroll
                for (int n = 0; n < 2; ++n) acc[a][b][m][n] = (f32x4){0.f, 0.f, 0.f, 0.f};
    bf16x8 At[4][2], B0[2][2], B1[2][2];
    const char* cA = (const char*)g.A + (size_t)cur.pm * tstep; const char* cB = (const char*)g.Bt + (size_t)cur.pn * tstep;
    S.a_ready(cur);
    if constexpr (SP2) {
        PG8_STAGE(PG8_SB(0, 0), cB, voffB); PG8_STAGE(PG8_SB(0, 1), cB + hstep, voffB); PG8_STAGE(PG8_SA(0, 0), cA, voffA); PG8_STAGE(PG8_SA(0, 1), cA + hstep, voffA);
        if (wr == 1) PG8_BAR;
        PG8_WAIT_V(2); PG8_BAR;
        PG8_STAGE(PG8_SB(1, 0), cB + kstep, voffB); PG8_STAGE(PG8_SA(1, 0), cA + kstep, voffA); PG8_STAGE(PG8_SB(1, 1), cB + hstep + kstep, voffB);
        PG8_WAIT_V(6); PG8_BAR;
    } else {
        PG8_STAGE(PG8_SB(0, 0), cB, voffB); PG8_STAGE(PG8_SA(0, 0), cA, voffA); PG8_STAGE(PG8_SB(0, 1), cB + hstep, voffB); PG8_STAGE(PG8_SA(0, 1), cA + hstep, voffA);
        if (wr == 1) PG8_BAR;
        PG8_WAIT_V(4); PG8_BAR;
        PG8_STAGE(PG8_SB(1, 0), cB + kstep, voffB); PG8_STAGE(PG8_SA(1, 0), cA + kstep, voffA); PG8_STAGE(PG8_SB(1, 1), cB + hstep + kstep, voffB);
        PG8_WAIT_V(6); PG8_BAR;
    }
    for (;;) {
        const bool has_next = S.next(ui + 1, nxt);
        const char* nA = has_next ? (const char*)g.A + (size_t)nxt.pm * tstep : cA; const char* nB = has_next ? (const char*)g.Bt + (size_t)nxt.pn * tstep : cB;
        for (int t = 0; t < nt; t += 2) {
            const bool last = (t == nt - 2);
            const char* a1 = cA + (size_t)(t + 1) * kstep;
            const char* a2 = last ? nA : cA + (size_t)(t + 2) * kstep; const char* b2 = last ? nB : cB + (size_t)(t + 2) * kstep;
            const char* a3 = a2 + kstep; const char* b3 = b2 + kstep;
            if (last && has_next) S.a_ready(nxt);
            if constexpr (SP2) {
            PG8_LDB(B0, 0, 0); PG8_LDB(B1, 0, 1); PG8_SCHED; PG8_LDA(At, 0, 0); PG8_STAGE(PG8_SA(1, 1), a1 + hstep, voffA);
            PG8_WAIT_V(8); PG8_WAIT_L(0); PG8_BAR; PG8_MMA(0, 0, At, B0); PG8_MMA(0, 1, At, B1); PG8_BAR; PG8_SCHED;
            PG8_LDA(At, 0, 1); PG8_STAGE(PG8_SB(0, 0), b2, voffB); PG8_STAGE(PG8_SB(0, 1), b2 + hstep, voffB); PG8_STAGE(PG8_SA(0, 0), a2, voffA);
            PG8_WAIT_V(8); PG8_WAIT_L(0); PG8_BAR; PG8_MMA(1, 0, At, B0); PG8_MMA(1, 1, At, B1); PG8_BAR; PG8_SCHED;
            PG8_LDB(B0, 1, 0); PG8_LDB(B1, 1, 1); PG8_SCHED; PG8_LDA(At, 1, 0); PG8_STAGE(PG8_SA(0, 1), a2 + hstep, voffA);
            PG8_WAIT_V(8); PG8_WAIT_L(0); PG8_BAR; PG8_MMA(0, 0, At, B0); PG8_MMA(0, 1, At, B1); PG8_BAR; PG8_SCHED;
            PG8_LDA(At, 1, 1); PG8_STAGE(PG8_SB(1, 0), b3, voffB); PG8_STAGE(PG8_SB(1, 1), b3 + hstep, voffB); PG8_STAGE(PG8_SA(1, 0), a3, voffA);
            PG8_WAIT_V(8); PG8_WAIT_L(0); PG8_BAR; PG8_MMA(1, 0, At, B0); PG8_MMA(1, 1, At, B1); PG8_BAR; PG8_SCHED;
            } else {
            PG8_LDB(B0, 0, 0); PG8_SCHED; PG8_LDA(At, 0, 0); PG8_STAGE(PG8_SA(1, 1), a1 + hstep, voffA);
            PG8_WAIT_L(8); PG8_BAR; PG8_WAIT_L(0); PG8_MMA(0, 0, At, B0); PG8_BAR; PG8_SCHED;
            PG8_LDB(B1, 0, 1); PG8_STAGE(PG8_SB(0, 0), b2, voffB);
            PG8_BAR; PG8_WAIT_L(0); PG8_MMA(0, 1, At, B1); PG8_BAR;
            PG8_LDA(At, 0, 1); PG8_STAGE(PG8_SA(0, 0), a2, voffA);
            PG8_BAR; PG8_WAIT_L(0); PG8_MMA(1, 0, At, B0); PG8_BAR; PG8_SCHED;
            PG8_STAGE(PG8_SB(0, 1), b2 + hstep, voffB);
            PG8_WAIT_V(6); PG8_BAR; PG8_MMA(1, 1, At, B1); PG8_BAR;
            PG8_LDB(B0, 1, 0); PG8_SCHED; PG8_LDA(At, 1, 0); PG8_STAGE(PG8_SA(0, 1), a2 + hstep, voffA);
            PG8_WAIT_L(8); PG8_BAR; PG8_WAIT_L(0); PG8_MMA(0, 0, At, B0); PG8_BAR; PG8_SCHED;
            PG8_LDB(B1, 1, 1); PG8_STAGE(PG8_SB(1, 0), b3, voffB);
            PG8_BAR; PG8_WAIT_L(0); PG8_MMA(0, 1, At, B1); PG8_BAR;
            PG8_LDA(At, 1, 1); PG8_STAGE(PG8_SA(1, 0), a3, voffA);
            PG8_BAR; PG8_WAIT_L(0); PG8_MMA(1, 0, At, B0); PG8_BAR; PG8_SCHED;
            PG8_STAGE(PG8_SB(1, 1), b3 + hstep, voffB);
            PG8_WAIT_V(6); PG8_BAR; PG8_MMA(1, 1, At, B1); PG8_BAR;
            }
        }
        if constexpr (ALIGN_EPI) { if (wr == 0) PG8_BAR; }
        if constexpr (!Epi::AFTER_DRAIN) { E(acc, cur, wr, wc, fr, fq); S.done(cur); }
        if (!has_next) break;
#pragma unroll
        for (int a = 0; a < 2; ++a)
#pragma unroll
            for (int b = 0; b < 2; ++b)
#pragma unroll
                for (int m = 0; m < 4; ++m)
#pragma unroll
                    for (int n = 0; n < 2; ++n) acc[a][b][m][n] = (f32x4){0.f, 0.f, 0.f, 0.f};
        cur = nxt; cA = nA; cB = nB; ++ui;
        if constexpr (ALIGN_EPI) { if (wr == 1) PG8_BAR; }
    }
    PG8_WAIT_V(0);
    if constexpr (!ALIGN_EPI) { if (wr == 0) PG8_BAR; }
    PG8_BAR;
    if constexpr (Epi::AFTER_DRAIN) { E.fused(acc, cur, wr, wc, fr, fq, lds, wid, lane); S.done(cur); }
#undef PG8_SA
#undef PG8_SB
#undef PG8_STAGE
#undef PG8_LDA
#undef PG8_LDB
#undef PG8_MMA
#undef PG8_WAIT_V
#undef PG8_WAIT_L
#undef PG8_BAR
#undef PG8_SCHED
}
}

#define LAS __attribute__((address_space(3)))
typedef unsigned short bf16_t;
typedef short bf16x8 __attribute__((ext_vector_type(8)));
typedef float f32x4 __attribute__((ext_vector_type(4)));
typedef float f32x16 __attribute__((ext_vector_type(16)));
typedef unsigned u32x4 __attribute__((ext_vector_type(4)));
typedef unsigned u32x2 __attribute__((ext_vector_type(2)));
#define MFMA32(a, b, c) __builtin_amdgcn_mfma_f32_32x32x16_bf16((a), (b), (c), 0, 0, 0)

constexpr int DM = 1024, SEQ = 8192, LCTX = 256, ML = 2 * SEQ, MC = 2 * LCTX, MT = ML + MC;
constexpr int PW = 2560, FF = 2816, INW = 2304, KVT = SEQ + LCTX, NCH = 66;
constexpr int C_QA = 0, C_KA = 256, C_VA = 384, C_QB = 512, C_KB = 768, C_VB = 896, C_FR = 1024, C_FI = 1280, C_RQ = 1536, C_RK = 1792, C_RV = 2048, C_RG = 2304;
constexpr float LN_EPS = 1e-6f, ALPHA = 1.4142135623730951f, LOG2E = 1.4426950408889634f, QSCALE = 0.125f * 1.4426950408889634f;
constexpr size_t KiB = 1024, MiB = 1024 * 1024;
constexpr size_t OFF_MOD = 0, OFF_ROPEG = 256 * KiB, OFF_TW = 320 * KiB, OFF_F128R = 384 * KiB, OFF_F128I = 416 * KiB, OFF_C64 = 448 * KiB, OFF_S64 = 456 * KiB,
                 OFF_C256 = 512 * KiB, OFF_S256 = 640 * KiB, OFF_ROPES = 1 * MiB, OFF_XC = 3 * MiB,
                 OFF_WIN = 5 * MiB, OFF_WOUT = 10 * MiB, OFF_WGU = 12 * MiB, OFF_WDN = 23 * MiB, OFF_H = 29 * MiB, OFF_P = 62 * MiB,
                 OFF_MIX = 153 * MiB, OFF_VAT = 186 * MiB, OFF_VBT = 191 * MiB, OFF_TB = 196 * MiB, OFF_SLOC = 212 * MiB, OFF_ST = 229 * MiB,
                 OFF_Y2 = 196 * MiB, WS_NEED = 238 * MiB;
constexpr int LDS_BYTES = 147456;
constexpr size_t OFF_BAR = 208 * KiB;
#define RLX_AGENT __ATOMIC_RELAXED, __HIP_MEMORY_SCOPE_AGENT

struct Params { const float* in[20]; float* out; unsigned char* ws; int n_steps, pad; };

__device__ __forceinline__ unsigned f2bf(float f) { unsigned u = __builtin_bit_cast(unsigned, f); return (u + 0x7fffu + ((u >> 16) & 1u)) >> 16; }
typedef float f32x2_t __attribute__((ext_vector_type(2))); typedef __bf16 bf16x2_t __attribute__((ext_vector_type(2)));
__device__ __forceinline__ unsigned pk2(float lo, float hi) { f32x2_t v = {lo, hi}; bf16x2_t b = __builtin_convertvector(v, bf16x2_t); return __builtin_bit_cast(unsigned, b); }
__device__ __forceinline__ float xhalf_max(float v) { auto rr = __builtin_amdgcn_permlane32_swap(__float_as_uint(v), __float_as_uint(v), false, false); return fmaxf(__uint_as_float(rr[0]), __uint_as_float(rr[1])); }
__device__ __forceinline__ float xhalf_sum(float v) { auto rr = __builtin_amdgcn_permlane32_swap(__float_as_uint(v), __float_as_uint(v), false, false); return __uint_as_float(rr[0]) + __uint_as_float(rr[1]); }
__device__ __forceinline__ float bflo(unsigned w) { return __builtin_bit_cast(float, w << 16); }
__device__ __forceinline__ float bfhi(unsigned w) { return __builtin_bit_cast(float, w & 0xffff0000u); }
__device__ __forceinline__ float bf2f(bf16_t h) { return __builtin_bit_cast(float, (unsigned)h << 16); }
__device__ __forceinline__ int crow(int r, int hi) { return (r & 3) + 8 * (r >> 2) + 4 * hi; }
__device__ __forceinline__ float wave_sum(float v) {
#pragma unroll
    for (int o = 1; o < 64; o <<= 1) v += __shfl_xor(v, o);
    return v;
}
__device__ __forceinline__ bf16x8 pack8(float a0, float a1, float a2, float a3, float a4, float a5, float a6, float a7) {
    u32x4 p; p.x = pk2(a0, a1); p.y = pk2(a2, a3); p.z = pk2(a4, a5); p.w = pk2(a6, a7); return __builtin_bit_cast(bf16x8, p);
}
__device__ __forceinline__ bf16x8 join8(u32x2 lo, u32x2 hi) { u32x4 p; p.x = lo.x; p.y = lo.y; p.z = hi.x; p.w = hi.y; return __builtin_bit_cast(bf16x8, p); }
__device__ __forceinline__ void sincos_red(float ang, float& c, float& s) {
    const double a = (double)ang; const double k = rint(a * 0.15915494309189535); const float r = (float)(a - k * 6.283185307179586);
    c = cosf(r); s = sinf(r);
}
__device__ __forceinline__ float logsig(float x) { return -log1pf(expf(-x)); }
#define LDSW() asm volatile("s_waitcnt lgkmcnt(0)" ::: "memory")

__device__ __forceinline__ void ph_tables(unsigned char* ws, int gtid, int NT) {
    float2* ropeg = (float2*)(ws + OFF_ROPEG);
    for (int i = gtid; i < 128 * 16; i += NT) { const int p = i >> 4, f = i & 15; const float inv = exp2f(-(float)f * (13.287712379549449f / 16.f)); float c, s; sincos_red((float)p * inv, c, s); ropeg[i] = make_float2(c, s); }
    float2* ropes = (float2*)(ws + OFF_ROPES);
    for (int i = gtid; i < SEQ * 32; i += NT) { const int p = i >> 5, f = i & 31; const float inv = exp2f(-(float)f * (13.287712379549449f / 32.f)); float c, s; sincos_red((float)p * inv, c, s); ropes[i] = make_float2(c, s); }
    float2* tw = (float2*)(ws + OFF_TW);
    for (int i = gtid; i < 8192; i += NT) { const float a = (float)i * (1.0f / 4096.0f); tw[i] = make_float2(cospif(a), sinpif(a)); }
    bf16_t* f128r = (bf16_t*)(ws + OFF_F128R); bf16_t* f128i = (bf16_t*)(ws + OFF_F128I);
    for (int i = gtid; i < 128 * 128; i += NT) { const int m = ((i >> 7) * (i & 127)) & 127; const float a = (float)m * (1.0f / 64.0f); f128r[i] = (bf16_t)f2bf(cospif(a)); f128i[i] = (bf16_t)f2bf(-sinpif(a)); }
    bf16_t* c64 = (bf16_t*)(ws + OFF_C64); bf16_t* s64 = (bf16_t*)(ws + OFF_S64);
    for (int i = gtid; i < 64 * 64; i += NT) { const int m = ((i >> 6) * (i & 63)) & 63; const float a = (float)m * (1.0f / 32.0f); c64[i] = (bf16_t)f2bf(cospif(a)); s64[i] = (bf16_t)f2bf(sinpif(a)); }
    bf16_t* c256 = (bf16_t*)(ws + OFF_C256); bf16_t* s256 = (bf16_t*)(ws + OFF_S256);
    for (int i = gtid; i < 256 * 256; i += NT) { const int m = ((i >> 8) * (i & 255)) & 255; const float a = (float)m * (1.0f / 128.0f); c256[i] = (bf16_t)f2bf(cospif(a)); s256[i] = (bf16_t)f2bf(sinpif(a)); }
}

__device__ __forceinline__ void ph_mod(const float* c, const float* c_ctx, const float* w_mod, const float* b_mod, float* modv, unsigned char* lds, int tid, int bid, int G) {
    float* sc = (float*)lds; float* part = sc + 3 * 1024;
    if (bid >= 48 && G >= 48) return;
    for (int i = tid; i < 3072; i += 512) { const int v = i >> 10, k = i & 1023; const float cv = v < 2 ? c[v * 1024 + k] : c_ctx[k]; sc[i] = cv / (1.0f + expf(-cv)); }
    __syncthreads();
    for (int u = bid; u < 48; u += (G >= 48 ? 48 : G)) {
        const int layer = u / 24, cgp = u % 24, cq = tid & 63, kg = tid >> 6;
        const float* w = w_mod + (size_t)layer * 1024 * 6144 + cgp * 256 + 4 * cq;
        f32x4 a0 = {0.f, 0.f, 0.f, 0.f}, a1 = a0, a2 = a0;
        for (int k0 = kg * 128; k0 < kg * 128 + 128; k0 += 16) {
            f32x4 wv[16];
#pragma unroll
            for (int e = 0; e < 16; ++e) wv[e] = *(const f32x4*)(w + (size_t)(k0 + e) * 6144);
#pragma unroll
            for (int e = 0; e < 16; ++e) { a0 += wv[e] * sc[k0 + e]; a1 += wv[e] * sc[1024 + k0 + e]; a2 += wv[e] * sc[2048 + k0 + e]; }
        }
        *(f32x4*)(part + (kg * 3 + 0) * 256 + 4 * cq) = a0; *(f32x4*)(part + (kg * 3 + 1) * 256 + 4 * cq) = a1; *(f32x4*)(part + (kg * 3 + 2) * 256 + 4 * cq) = a2;
        __syncthreads();
        for (int t = tid; t < 768; t += 512) { const int v = t >> 8, cc = t & 255; float s = 0.f;
#pragma unroll
            for (int k2 = 0; k2 < 8; ++k2) s += part[(k2 * 3 + v) * 256 + cc];
            modv[(layer * 3 + v) * 6144 + cgp * 256 + cc] = s + b_mod[layer * 6144 + cgp * 256 + cc]; }
        __syncthreads();
    }
}

__device__ __forceinline__ void transpose_item(const float* W, int ldw, int k0, int nsrc0, bf16_t* WT, int K, int drow0, float* scr, int lane) {
    f32x4 wv[8];
#pragma unroll
    for (int i = 0; i < 8; ++i) wv[i] = *(const f32x4*)(W + (size_t)(k0 + (lane >> 3) + 8 * i) * ldw + nsrc0 + 4 * (lane & 7));
#pragma unroll
    for (int i = 0; i < 8; ++i) { float* d = scr + ((lane >> 3) + 8 * i) * 33 + 4 * (lane & 7); d[0] = wv[i].x; d[1] = wv[i].y; d[2] = wv[i].z; d[3] = wv[i].w; }
    LDSW();
    const int c = lane & 7;
#pragma unroll
    for (int j = 0; j < 4; ++j) { const int n = (lane >> 3) + 8 * j; const float* s = scr + (8 * c) * 33 + n;
        u32x4 o; o.x = pk2(s[0 * 33], s[1 * 33]); o.y = pk2(s[2 * 33], s[3 * 33]); o.z = pk2(s[4 * 33], s[5 * 33]); o.w = pk2(s[6 * 33], s[7 * 33]);
        *(u32x4*)(WT + (size_t)(drow0 + n) * K + k0 + 8 * c) = o; }
    LDSW();
}

__device__ __forceinline__ void ph_weights(const Params& p, int layer, unsigned char* lds, int tid, int bid_in, int G_in, int skip = 0) {
    if (G_in < 2 * skip) skip = 0;
    if (bid_in < skip) return;
    const int bid = bid_in - skip, G = G_in - skip;
    unsigned char* ws = p.ws;
    const float* w_in = p.in[6] + (size_t)layer * DM * INW; const float* fmix = p.in[10] + (size_t)layer * 4 * 64 * 64;
    const float* w_out = p.in[13] + (size_t)layer * DM * DM; const float* w_gu = p.in[16] + (size_t)layer * DM * 2 * FF; const float* w_dn = p.in[17] + (size_t)layer * FF * DM;
    bf16_t* Win = (bf16_t*)(ws + OFF_WIN); bf16_t* Wout = (bf16_t*)(ws + OFF_WOUT); bf16_t* Wgu = (bf16_t*)(ws + OFF_WGU); bf16_t* Wdn = (bf16_t*)(ws + OFF_WDN);
    const int lane = tid & 63, wave = tid >> 6;
    float* Gm = (float*)lds; float* wt = Gm + 4096;
    for (int u = bid; u < 128; u += G) {
        const int kb = u >> 3, g = (u >> 1) & 3, ri = u & 1;
        { const int ci = tid >> 3, e0 = (tid & 7) * 8; float acc[8];
#pragma unroll
          for (int e = 0; e < 8; ++e) acc[e] = 0.f;
          for (int cp = 0; cp < 64; ++cp) { const int m = (ci * cp) & 63; const float a = (float)m * (1.0f / 32.0f); const float tr = ri == 0 ? cospif(a) : -sinpif(a);
              const float* fr = fmix + ((g * 64 + cp) * 64 + e0);
#pragma unroll
              for (int e = 0; e < 8; ++e) acc[e] += tr * fr[e]; }
#pragma unroll
          for (int e = 0; e < 8; ++e) Gm[ci * 64 + e0 + e] = acc[e] * 0.125f; }
        for (int i = tid; i < 4096; i += 512) { const int kk = i >> 6, cc = i & 63; wt[kk * 65 + cc] = w_in[(size_t)(kb * 64 + kk) * INW + 1024 + 64 * g + cc]; }
        __syncthreads();
        { const int e = tid & 63, kk0 = (tid >> 6) * 8; float acc[8];
#pragma unroll
          for (int q = 0; q < 8; ++q) acc[q] = 0.f;
          for (int cc = 0; cc < 64; ++cc) { const float gv = Gm[cc * 64 + e];
#pragma unroll
              for (int q = 0; q < 8; ++q) acc[q] += wt[(kk0 + q) * 65 + cc] * gv; }
          u32x4 o; o.x = pk2(acc[0], acc[1]); o.y = pk2(acc[2], acc[3]); o.z = pk2(acc[4], acc[5]); o.w = pk2(acc[6], acc[7]);
          *(u32x4*)(Win + (size_t)(1024 + ri * 256 + g * 64 + e) * DM + kb * 64 + kk0) = o; }
        __syncthreads();
    }
    float* scr = (float*)lds + wave * 2176;
    const int gw = bid * 8 + wave, NGW = G * 8;
    for (int it = gw; it < 5760; it += NGW) {
        int r = it;
        if (r < 512) { transpose_item(w_in, INW, 64 * (r >> 5), 32 * (r & 31), Win, DM, 32 * (r & 31), scr, lane); continue; } r -= 512;
        if (r < 512) { transpose_item(w_in, INW, 64 * (r >> 5), 1280 + 32 * (r & 31), Win, DM, 1536 + 32 * (r & 31), scr, lane); continue; } r -= 512;
        if (r < 512) { transpose_item(w_out, DM, 64 * (r >> 5), 32 * (r & 31), Wout, DM, 32 * (r & 31), scr, lane); continue; } r -= 512;
        if (r < 2816) { const int kb = r / 176, n0 = 32 * (r % 176); const int bj = n0 / FF, rr = n0 % FF; const int drow = (rr >> 7) * 256 + bj * 128 + (rr & 127);
            transpose_item(w_gu, 2 * FF, 64 * kb, n0, Wgu, DM, drow, scr, lane); continue; } r -= 2816;
        transpose_item(w_dn, DM, 64 * (r >> 5), 32 * (r & 31), Wdn, FF, 32 * (r & 31), scr, lane);
    }
}

__device__ __forceinline__ void ln_stats(const f32x4 (&v)[4], float& mean, float& rstd) {
    float s = 0.f;
#pragma unroll
    for (int j = 0; j < 4; ++j) s += (v[j].x + v[j].y) + (v[j].z + v[j].w);
    mean = wave_sum(s) * (1.0f / DM); float q = 0.f;
#pragma unroll
    for (int j = 0; j < 4; ++j) { const f32x4 d = v[j] - mean; q += (d.x * d.x + d.y * d.y) + (d.z * d.z + d.w * d.w); }
    rstd = rsqrtf(wave_sum(q) * (1.0f / DM) + LN_EPS);
}
__device__ __forceinline__ void store_h(bf16_t* hrow, const f32x4 (&v)[4], float mean, float rstd, const float* sh, const float* scl, int lane) {
#pragma unroll
    for (int j = 0; j < 4; ++j) { const int col = 4 * lane + 256 * j; const f32x4 s = *(const f32x4*)(scl + col), t = *(const f32x4*)(sh + col);
        const f32x4 y = (v[j] - mean) * rstd * (s + 1.0f) + t; u32x2 w; w.x = pk2(y.x, y.y); w.y = pk2(y.z, y.w); *(u32x2*)(hrow + col) = w; }
}
__device__ __forceinline__ void ph_h0(const Params& p, int gw, int NGW, int lane) {
    const float* modv = (const float*)(p.ws + OFF_MOD); bf16_t* H = (bf16_t*)(p.ws + OFF_H);
    f32x4 xn[4];
    if (gw < MT) { const float* src = gw < ML ? p.in[0] + (size_t)gw * DM : p.in[2] + (size_t)(gw - ML) * DM;
#pragma unroll
        for (int j = 0; j < 4; ++j) xn[j] = *(const f32x4*)(src + 4 * lane + 256 * j); }
    for (int row = gw; row < MT; row += NGW) {
        const float* mod = modv + (size_t)(row < ML ? (row >> 13) : 2) * 6144;
        f32x4 v[4], sv[4], tv[4];
#pragma unroll
        for (int j = 0; j < 4; ++j) { v[j] = xn[j]; sv[j] = *(const f32x4*)(mod + 1024 + 4 * lane + 256 * j); tv[j] = *(const f32x4*)(mod + 4 * lane + 256 * j); }
        const int nrow = row + NGW;
        if (nrow < MT) { const float* src = nrow < ML ? p.in[0] + (size_t)nrow * DM : p.in[2] + (size_t)(nrow - ML) * DM;
#pragma unroll
            for (int j = 0; j < 4; ++j) xn[j] = *(const f32x4*)(src + 4 * lane + 256 * j); }
        float mean, rstd; ln_stats(v, mean, rstd);
        bf16_t* hrow = H + (size_t)row * DM;
#pragma unroll
        for (int j = 0; j < 4; ++j) { const f32x4 y = (v[j] - mean) * rstd * (sv[j] + 1.0f) + tv[j]; u32x2 w; w.x = pk2(y.x, y.y); w.y = pk2(y.z, y.w); *(u32x2*)(hrow + 4 * lane + 256 * j) = w; }
    }
}
__device__ __forceinline__ void ph_rowpass(const Params& p, int layer, int which, int mrows, bool do_h, int gw, int NGW, int lane) {
    const float* modv = (const float*)(p.ws + OFF_MOD); bf16_t* H = (bf16_t*)(p.ws + OFF_H);
    const bf16_t* Y = (const bf16_t*)(p.ws + (which == 0 ? OFF_P : OFF_Y2));
    const float* lw = p.in[which == 0 ? 14 : 18] + layer * DM; const float* lb = p.in[which == 0 ? 15 : 19] + layer * DM;
    float* xc = (float*)(p.ws + OFF_XC);
    const bool from_in = (layer == 0 && which == 0);
    f32x4 lwv[4], lbv[4], xn[4]; u32x2 yn[4];
#pragma unroll
    for (int j = 0; j < 4; ++j) { lwv[j] = *(const f32x4*)(lw + 4 * lane + 256 * j); lbv[j] = *(const f32x4*)(lb + 4 * lane + 256 * j); }
#define RP_SRC(r) (from_in ? ((r) < ML ? p.in[0] + (size_t)(r) * DM : p.in[2] + (size_t)((r) - ML) * DM) : ((r) < ML ? (const float*)p.out + (size_t)(r) * DM : (const float*)xc + (size_t)((r) - ML) * DM))
    if (gw < mrows) { const float* src = RP_SRC(gw);
#pragma unroll
        for (int j = 0; j < 4; ++j) { xn[j] = *(const f32x4*)(src + 4 * lane + 256 * j); yn[j] = *(const u32x2*)(Y + (size_t)gw * DM + 4 * lane + 256 * j); } }
    for (int row = gw; row < mrows; row += NGW) {
        float* xs = row < ML ? p.out + (size_t)row * DM : xc + (size_t)(row - ML) * DM;
        const int vi = row < ML ? (row >> 13) : 2;
        const float* mod = modv + (size_t)(layer * 3 + vi) * 6144;
        const float* gate = mod + (which == 0 ? 2048 : 5120);
        const float* mod2 = which == 0 ? mod + 3072 : modv + (size_t)((layer + 1) * 3 + vi) * 6144;
        f32x4 v[4], sv[4], tv[4];
#pragma unroll
        for (int j = 0; j < 4; ++j) { const int col = 4 * lane + 256 * j; const f32x4 g = *(const f32x4*)(gate + col);
            f32x4 y; y.x = bflo(yn[j].x); y.y = bfhi(yn[j].x); y.z = bflo(yn[j].y); y.w = bfhi(yn[j].y);
            v[j] = xn[j] * ALPHA + g * y;
            if (do_h) { sv[j] = *(const f32x4*)(mod2 + 1024 + col); tv[j] = *(const f32x4*)(mod2 + col); } }
        const int nrow = row + NGW;
        if (nrow < mrows) { const float* src = RP_SRC(nrow);
#pragma unroll
            for (int j = 0; j < 4; ++j) { xn[j] = *(const f32x4*)(src + 4 * lane + 256 * j); yn[j] = *(const u32x2*)(Y + (size_t)nrow * DM + 4 * lane + 256 * j); } }
        float mean, rstd; ln_stats(v, mean, rstd);
#pragma unroll
        for (int j = 0; j < 4; ++j) { const int col = 4 * lane + 256 * j; v[j] = (v[j] - mean) * rstd * lwv[j] + lbv[j];
#ifdef SELFCHECK
            if (layer == 1 && which == 1) { const unsigned fl = *(const unsigned*)(p.ws + 200 * 1024); v[j] = v[j] * (1.0f + 0.1f * (float)(fl & 15u)); }
#endif
            *(f32x4*)(xs + col) = v[j]; }
        if (do_h) {
            ln_stats(v, mean, rstd);
            bf16_t* hrow = H + (size_t)row * DM;
#pragma unroll
            for (int j = 0; j < 4; ++j) { const f32x4 y = (v[j] - mean) * rstd * (sv[j] + 1.0f) + tv[j]; u32x2 w; w.x = pk2(y.x, y.y); w.y = pk2(y.z, y.w); *(u32x2*)(hrow + 4 * lane + 256 * j) = w; }
        }
    }
#undef RP_SRC
}
#define XB_TMO      128
#define XB_XCNT(j)  (256  + 64 * (j))
#define XB_XSUB(j)  (1280 + 64 * (j))
#define XB_XGEN(j)  (2304 + 64 * (j))
#define XB_TOP      3328
#define XB_TOPGEN   3392
#define XCD_BAR_WORDS 3456
#define XB_SPIN_CAP (1u << 18)

__device__ __forceinline__ unsigned xb_ld(unsigned* p)              { return __hip_atomic_load(p, __ATOMIC_RELAXED, __HIP_MEMORY_SCOPE_AGENT); }
__device__ __forceinline__ unsigned xb_add(unsigned* p, unsigned v) { return __hip_atomic_fetch_add(p, v, __ATOMIC_RELAXED, __HIP_MEMORY_SCOPE_AGENT); }
__device__ __forceinline__ unsigned xb_xcc_id() { return (unsigned)__builtin_amdgcn_s_getreg((3 << 11) | 20) & 0xFu; }
#define XB_SPIN(cond, bar) do { unsigned _sp = 0; while (cond) { __builtin_amdgcn_s_sleep(1); \
    if ((++_sp & 255u) == 0u) { if (xb_ld(&(bar)[XB_TMO])) break; if (_sp > XB_SPIN_CAP) { atomicAdd(&(bar)[XB_TMO], 1u); break; } } } } while (0)

struct XcdBarrier {
    unsigned* bar; unsigned x;
    volatile LAS unsigned* st;
};

__device__ __forceinline__ XcdBarrier xcd_barrier_post(unsigned* bar, volatile LAS unsigned* st) {
    XcdBarrier b; b.bar = bar; b.x = xb_xcc_id(); b.st = st;
    if (threadIdx.x == 0) (void)xb_add(&bar[XB_XCNT(b.x)], 1u);
    return b;
}
__device__ __forceinline__ void xcd_barrier_complete(unsigned* bar, unsigned x, unsigned& nloc, unsigned& nx) {
    const unsigned G = gridDim.x * gridDim.y * gridDim.z;
    unsigned sum, cnt, mine, sp = 0u;
    for (;;) {
        sum = 0u; cnt = 0u; mine = 0u;
#pragma unroll
        for (unsigned j = 0; j < 16; ++j) { const unsigned c = xb_ld(&bar[XB_XCNT(j)]); sum += c; cnt += (c > 0u) ? 1u : 0u; mine = (j == x) ? c : mine; }
        if (sum == G) break;
        __builtin_amdgcn_s_sleep(1);
        if ((++sp & 255u) == 0u) { if (xb_ld(&bar[XB_TMO])) break; if (sp > XB_SPIN_CAP) { atomicAdd(&bar[XB_TMO], 1u); break; } }
    }
    nloc = mine > 0u ? mine : 1u; nx = cnt > 0u ? cnt : 1u;
}

__device__ __forceinline__ void xcd_barrier(const XcdBarrier& b) {
    asm volatile("s_waitcnt vmcnt(0)" ::: "memory");
    __syncthreads();
    if (threadIdx.x == 0) {
        unsigned* bar = b.bar;
        __builtin_amdgcn_s_waitcnt(0);
        unsigned nloc = b.st[0], nx = b.st[1];
        if (nloc == 0u) { xcd_barrier_complete(bar, b.x, nloc, nx); b.st[0] = nloc; b.st[1] = nx; }
        const unsigned old = xb_add(&bar[XB_XSUB(b.x)], 1u);
        const unsigned gen = old / nloc;
        if (old + 1u == (gen + 1u) * nloc) {
            __builtin_amdgcn_fence(__ATOMIC_RELEASE, "agent");
            asm volatile("s_waitcnt vmcnt(0)" ::: "memory");
            const unsigned og = xb_add(&bar[XB_TOP], 1u);
            const unsigned tg = og / nx;
            if (og + 1u == (tg + 1u) * nx) xb_add(&bar[XB_TOPGEN], 1u);
            else XB_SPIN(xb_ld(&bar[XB_TOPGEN]) == tg, bar);
            __builtin_amdgcn_fence(__ATOMIC_ACQUIRE, "agent");
            xb_add(&bar[XB_XGEN(b.x)], 1u);
            asm volatile("s_waitcnt vmcnt(0)" ::: "memory");
        } else {
            XB_SPIN(xb_ld(&bar[XB_XGEN(b.x)]) == gen, bar);
            __builtin_amdgcn_fence(__ATOMIC_ACQUIRE, "agent");
            asm volatile("s_waitcnt vmcnt(0)" ::: "memory");
        }
    }
    __syncthreads();
}

__device__ __forceinline__ void ph_prep(const Params& p, int layer, unsigned char* lds, int gw, int NGW, int lane, int wave) {
    bf16_t* P = (bf16_t*)(p.ws + OFF_P); const float2* ropeg = (const float2*)(p.ws + OFF_ROPEG);
    const float* aqn = p.in[7] + layer * 64; const float* akn = p.in[8] + layer * 64;
    for (int it = gw; it < (MT * 12) / 64; it += NGW) {
        const int item = it * 64 + lane; const int row = item / 12, s = item % 12;
        int col; bool isq, norm; const float* nw = aqn;
        if (s < 4) { col = C_QA + 64 * s; isq = true; norm = true; }
        else if (s < 6) { col = C_KA + 64 * (s - 4); isq = false; norm = true; nw = akn; }
        else if (s < 10) { col = C_QB + 64 * (s - 6); isq = true; norm = false; }
        else { col = C_KB + 64 * (s - 10); isq = false; norm = false; }
        bf16_t* ptr = P + (size_t)row * PW + col;
        u32x4 w[8];
#pragma unroll
        for (int q = 0; q < 8; ++q) w[q] = *(const u32x4*)(ptr + 8 * q);
        float x[64];
#pragma unroll
        for (int q = 0; q < 8; ++q) { x[8 * q + 0] = bflo(w[q].x); x[8 * q + 1] = bfhi(w[q].x); x[8 * q + 2] = bflo(w[q].y); x[8 * q + 3] = bfhi(w[q].y);
            x[8 * q + 4] = bflo(w[q].z); x[8 * q + 5] = bfhi(w[q].z); x[8 * q + 6] = bflo(w[q].w); x[8 * q + 7] = bfhi(w[q].w); }
        if (norm) { float ss = 0.f;
#pragma unroll
            for (int e = 0; e < 64; ++e) ss += x[e] * x[e];
            const float r = rsqrtf(ss * (1.0f / 64.0f) + LN_EPS);
#pragma unroll
            for (int e = 0; e < 64; ++e) x[e] *= r * nw[e]; }
        if (row < ML) { const int t = row & (SEQ - 1); const float2* ra = ropeg + (t >> 6) * 16; const float2* rb = ropeg + (t & 63) * 16;
#pragma unroll
            for (int e = 0; e < 16; ++e) { const float2 a = ra[e], bq = rb[e];
                const float y0 = x[e] * a.x - x[16 + e] * a.y, y1 = x[16 + e] * a.x + x[e] * a.y, y2 = x[32 + e] * bq.x - x[48 + e] * bq.y, y3 = x[48 + e] * bq.x + x[32 + e] * bq.y;
                x[e] = y0; x[16 + e] = y1; x[32 + e] = y2; x[48 + e] = y3; } }
        const float qs = isq ? QSCALE : 1.0f;
#pragma unroll
        for (int q = 0; q < 8; ++q) { u32x4 o; o.x = pk2(x[8 * q] * qs, x[8 * q + 1] * qs); o.y = pk2(x[8 * q + 2] * qs, x[8 * q + 3] * qs); o.z = pk2(x[8 * q + 4] * qs, x[8 * q + 5] * qs); o.w = pk2(x[8 * q + 6] * qs, x[8 * q + 7] * qs);
            *(u32x4*)(ptr + 8 * q) = o; }
    }
    bf16_t* scr = (bf16_t*)lds + wave * 4608;
    for (int u = gw; u < 1056; u += NGW) {
        const int tile = u % 132, r = u / 132; const int kvh = r & 1, b = (r >> 1) & 1, which = r >> 2;
        const int row = tile < 128 ? b * SEQ + tile * 64 + lane : ML + b * LCTX + (tile - 128) * 64 + lane;
        const bf16_t* src = P + (size_t)row * PW + (which ? C_VB : C_VA) + 64 * kvh;
#pragma unroll
        for (int q = 0; q < 8; ++q) *(u32x4*)(scr + lane * 72 + 8 * q) = *(const u32x4*)(src + 8 * q);
        LDSW();
        bf16_t* dst = (bf16_t*)(p.ws + (which ? OFF_VBT : OFF_VAT)) + (size_t)((b * 2 + kvh) * 64 + lane) * KVT + tile * 64;
#pragma unroll
        for (int q = 0; q < 8; ++q) { u32x4 o;
            const int t0 = 16 * (q >> 1) + 4 * (q & 1), t1 = t0 + 8;
            o.x = (unsigned)scr[(t0 + 0) * 72 + lane] | ((unsigned)scr[(t0 + 1) * 72 + lane] << 16); o.y = (unsigned)scr[(t0 + 2) * 72 + lane] | ((unsigned)scr[(t0 + 3) * 72 + lane] << 16);
            o.z = (unsigned)scr[(t1 + 0) * 72 + lane] | ((unsigned)scr[(t1 + 1) * 72 + lane] << 16); o.w = (unsigned)scr[(t1 + 2) * 72 + lane] | ((unsigned)scr[(t1 + 3) * 72 + lane] << 16);
            *(u32x4*)(dst + 8 * q) = o; }
        LDSW();
    }
}

__device__ __forceinline__ int ret_row(int b, int j, int s) { return j < 2 ? ML + b * LCTX + j * 128 + s : b * SEQ + (j - 2) * 128 + s; }
__device__ __forceinline__ void ret_load_rot(const bf16_t* P, const float2* ropes, int b, int j, int s, int q4, int col, float (&lo)[8], float (&hi)[8]) {
    const bf16_t* pk = P + (size_t)ret_row(b, j, s) * PW + col;
    const u32x4 a = *(const u32x4*)(pk + 8 * q4), c = *(const u32x4*)(pk + 32 + 8 * q4);
    lo[0] = bflo(a.x); lo[1] = bfhi(a.x); lo[2] = bflo(a.y); lo[3] = bfhi(a.y); lo[4] = bflo(a.z); lo[5] = bfhi(a.z); lo[6] = bflo(a.w); lo[7] = bfhi(a.w);
    hi[0] = bflo(c.x); hi[1] = bfhi(c.x); hi[2] = bflo(c.y); hi[3] = bfhi(c.y); hi[4] = bflo(c.z); hi[5] = bfhi(c.z); hi[6] = bflo(c.w); hi[7] = bfhi(c.w);
    if (j >= 2) { const int t = (j - 2) * 128 + s;
#pragma unroll
        for (int e = 0; e < 8; ++e) { const float2 cs = ropes[t * 32 + 8 * q4 + e]; const float y1 = lo[e] * cs.x - hi[e] * cs.y, y2 = hi[e] * cs.x + lo[e] * cs.y; lo[e] = y1; hi[e] = y2; } }
}
__device__ __forceinline__ void ret_load_vt(const bf16_t* P, bf16_t* VT, int b, int h, int j, int s, int q4) {
    const bf16_t* pv = P + (size_t)ret_row(b, j, s) * PW + C_RV + 64 * h + 16 * q4;
    const u32x4 a = *(const u32x4*)pv, c = *(const u32x4*)(pv + 8);
    bf16_t* d = VT + (16 * q4) * 136 + s;
    d[0 * 136] = (bf16_t)a.x; d[1 * 136] = (bf16_t)(a.x >> 16); d[2 * 136] = (bf16_t)a.y; d[3 * 136] = (bf16_t)(a.y >> 16);
    d[4 * 136] = (bf16_t)a.z; d[5 * 136] = (bf16_t)(a.z >> 16); d[6 * 136] = (bf16_t)a.w; d[7 * 136] = (bf16_t)(a.w >> 16);
    d[8 * 136] = (bf16_t)c.x; d[9 * 136] = (bf16_t)(c.x >> 16); d[10 * 136] = (bf16_t)c.y; d[11 * 136] = (bf16_t)(c.y >> 16);
    d[12 * 136] = (bf16_t)c.z; d[13 * 136] = (bf16_t)(c.z >> 16); d[14 * 136] = (bf16_t)c.w; d[15 * 136] = (bf16_t)(c.w >> 16);
}
__device__ __forceinline__ void ph_ret_local(const Params& p, int layer, unsigned char* lds, int tid, int bid, int G) {
    const bf16_t* P = (const bf16_t*)(p.ws + OFF_P); const float2* ropes = (const float2*)(p.ws + OFF_ROPES); float* Sloc = (float*)(p.ws + OFF_SLOC);
    bf16_t* KTf = (bf16_t*)lds; bf16_t* KTb = KTf + 64 * 136; bf16_t* VT = KTb + 64 * 136;
    const int lane = tid & 63, wave = tid >> 6, l31 = lane & 31, hi = lane >> 5, s = tid >> 2, q4 = tid & 3;
    for (int u = bid; u < 8 * NCH; u += G) {
        const int j = u % NCH, bh = u / NCH, b = bh >> 2, h = bh & 3;
        const float lgf = logsig(p.in[11][layer * 8 + h]), lgb = logsig(p.in[11][layer * 8 + 4 + h]);
        float lo[8], hi8[8]; ret_load_rot(P, ropes, b, j, s, q4, C_RK + 64 * h, lo, hi8);
        const float wf = expf(lgf * (float)(127 - s)) * 0.125f, wb = expf(lgb * (float)s) * 0.125f;
#pragma unroll
        for (int e = 0; e < 8; ++e) { const int d = 8 * q4 + e;
            KTf[d * 136 + s] = (bf16_t)f2bf(lo[e] * wf); KTf[(d + 32) * 136 + s] = (bf16_t)f2bf(hi8[e] * wf);
            KTb[d * 136 + s] = (bf16_t)f2bf(lo[e] * wb); KTb[(d + 32) * 136 + s] = (bf16_t)f2bf(hi8[e] * wb); }
        ret_load_vt(P, VT, b, h, j, s, q4);
        __syncthreads();
        const int dir = wave & 1, mb = (wave >> 1) & 1, nb = wave >> 2;
        const bf16_t* KT = dir ? KTb : KTf;
        f32x16 acc;
#pragma unroll
        for (int r = 0; r < 16; ++r) acc[r] = 0.f;
#pragma unroll
        for (int c = 0; c < 8; ++c) { const bf16x8 a = *(const bf16x8*)(VT + (32 * mb + l31) * 136 + 16 * c + 8 * hi); const bf16x8 bb = *(const bf16x8*)(KT + (32 * nb + l31) * 136 + 16 * c + 8 * hi);
            acc = MFMA32(a, bb, acc); }
        float* dst = Sloc + ((size_t)((bh * 2 + dir) * NCH + j)) * 4096 + 32 * nb + l31;
#pragma unroll
        for (int r = 0; r < 16; ++r) dst[(32 * mb + crow(r, hi)) * 64] = acc[r];
        __syncthreads();
    }
}
__device__ __forceinline__ void ph_ret_scan(const Params& p, int layer, int gtid, int NT) {
    const float* Sloc = (const float*)(p.ws + OFF_SLOC); bf16_t* St = (bf16_t*)(p.ws + OFF_ST);
    for (int e = gtid; e < 16 * 4096; e += NT) {
        const int seq = e >> 12, el = e & 4095, dir = seq & 1, h = (seq >> 1) & 3;
        const float g = expf(logsig(p.in[11][layer * 8 + dir * 4 + h]) * 128.0f);
        const float* sl = Sloc + (size_t)seq * NCH * 4096 + el; bf16_t* st = St + (size_t)seq * NCH * 4096 + el;
        float S = 0.f;
        if (dir == 0) {
#pragma unroll 11
            for (int j = 0; j < NCH; ++j) { st[(size_t)j * 4096] = (bf16_t)f2bf(S); S = S * g + sl[(size_t)j * 4096]; } }
        else { st[4096] = (bf16_t)f2bf(S); S = S * g + sl[4096]; st[0] = (bf16_t)f2bf(S); S = S * g + sl[0];
#pragma unroll 8
            for (int j = NCH - 1; j >= 2; --j) { st[(size_t)j * 4096] = (bf16_t)f2bf(S); S = S * g + sl[(size_t)j * 4096]; } }
    }
}
__device__ __forceinline__ void ret_rot_regs(const u32x4& a, const u32x4& c, const float2* ropes, int j, int s, int q4, float (&lo)[8], float (&hi)[8]) {
    lo[0] = bflo(a.x); lo[1] = bfhi(a.x); lo[2] = bflo(a.y); lo[3] = bfhi(a.y); lo[4] = bflo(a.z); lo[5] = bfhi(a.z); lo[6] = bflo(a.w); lo[7] = bfhi(a.w);
    hi[0] = bflo(c.x); hi[1] = bfhi(c.x); hi[2] = bflo(c.y); hi[3] = bfhi(c.y); hi[4] = bflo(c.z); hi[5] = bfhi(c.z); hi[6] = bflo(c.w); hi[7] = bfhi(c.w);
    if (j >= 2) { const int t = (j - 2) * 128 + s;
#pragma unroll
        for (int e = 0; e < 8; ++e) { const float2 cs = ropes[t * 32 + 8 * q4 + e]; const float y1 = lo[e] * cs.x - hi[e] * cs.y, y2 = hi[e] * cs.x + lo[e] * cs.y; lo[e] = y1; hi[e] = y2; } }
}
__device__ __forceinline__ void ph_ret_out(const Params& p, int layer, unsigned char* lds, int tid, int bid, int G) {
    const bf16_t* P = (const bf16_t*)(p.ws + OFF_P); const float2* ropes = (const float2*)(p.ws + OFF_ROPES); const bf16_t* St = (const bf16_t*)(p.ws + OFF_ST);
    bf16_t* MIX = (bf16_t*)(p.ws + OFF_MIX); const float* gnw = p.in[12] + layer * 256;
    bf16_t* Qs = (bf16_t*)lds; bf16_t* Ks = Qs + 128 * 72; bf16_t* VT = Ks + 128 * 72; float* red = (float*)(VT + 64 * 136);
    const int lane = tid & 63, wave = tid >> 6, l31 = lane & 31, hi = lane >> 5, s = tid >> 2, q4 = tid & 3;
    const int jlo = layer == 0 ? 0 : 2, nj = NCH - jlo, total = 8 * nj;
    u32x4 qa, qc, ka, kc, va, vc;
#define R3_LOAD(uu) do { const int j_ = jlo + (uu) % nj, bh_ = (uu) / nj; const bf16_t* pr_ = P + (size_t)ret_row(bh_ >> 2, j_, s) * PW + 64 * (bh_ & 3); \
        qa = *(const u32x4*)(pr_ + C_RQ + 8 * q4); qc = *(const u32x4*)(pr_ + C_RQ + 32 + 8 * q4); ka = *(const u32x4*)(pr_ + C_RK + 8 * q4); kc = *(const u32x4*)(pr_ + C_RK + 32 + 8 * q4); \
        va = *(const u32x4*)(pr_ + C_RV + 16 * q4); vc = *(const u32x4*)(pr_ + C_RV + 16 * q4 + 8); } while (0)
    if (bid < total) R3_LOAD(bid);
    for (int u = bid; u < total; u += G) {
        const int j = jlo + u % nj, bh = u / nj, b = bh >> 2, h = bh & 3;
        const float lgf = logsig(p.in[11][layer * 8 + h]), lgb = logsig(p.in[11][layer * 8 + 4 + h]);
        { float lo[8], hi8[8]; ret_rot_regs(qa, qc, ropes, j, s, q4, lo, hi8);
          *(bf16x8*)(Qs + s * 72 + 8 * q4) = pack8(lo[0], lo[1], lo[2], lo[3], lo[4], lo[5], lo[6], lo[7]);
          *(bf16x8*)(Qs + s * 72 + 32 + 8 * q4) = pack8(hi8[0], hi8[1], hi8[2], hi8[3], hi8[4], hi8[5], hi8[6], hi8[7]);
          ret_rot_regs(ka, kc, ropes, j, s, q4, lo, hi8);
          *(bf16x8*)(Ks + s * 72 + 8 * q4) = pack8(lo[0] * 0.125f, lo[1] * 0.125f, lo[2] * 0.125f, lo[3] * 0.125f, lo[4] * 0.125f, lo[5] * 0.125f, lo[6] * 0.125f, lo[7] * 0.125f);
          *(bf16x8*)(Ks + s * 72 + 32 + 8 * q4) = pack8(hi8[0] * 0.125f, hi8[1] * 0.125f, hi8[2] * 0.125f, hi8[3] * 0.125f, hi8[4] * 0.125f, hi8[5] * 0.125f, hi8[6] * 0.125f, hi8[7] * 0.125f); }
        { bf16_t* d = VT + (16 * q4) * 136 + s;
          d[0 * 136] = (bf16_t)va.x; d[1 * 136] = (bf16_t)(va.x >> 16); d[2 * 136] = (bf16_t)va.y; d[3 * 136] = (bf16_t)(va.y >> 16);
          d[4 * 136] = (bf16_t)va.z; d[5 * 136] = (bf16_t)(va.z >> 16); d[6 * 136] = (bf16_t)va.w; d[7 * 136] = (bf16_t)(va.w >> 16);
          d[8 * 136] = (bf16_t)vc.x; d[9 * 136] = (bf16_t)(vc.x >> 16); d[10 * 136] = (bf16_t)vc.y; d[11 * 136] = (bf16_t)(vc.y >> 16);
          d[12 * 136] = (bf16_t)vc.z; d[13 * 136] = (bf16_t)(vc.z >> 16); d[14 * 136] = (bf16_t)vc.w; d[15 * 136] = (bf16_t)(vc.w >> 16); }
        if (u + G < total) R3_LOAD(u + G);
        const int rb = wave & 3, dh = wave >> 2, iq = 32 * rb + l31;
        const size_t row = (size_t)ret_row(b, j, iq);
        bf16x8 sff[4], sbf[4]; u32x2 gwv[4];
        { const bf16_t* stf = St + ((size_t)((bh * 2 + 0) * NCH + j)) * 4096 + (32 * dh + l31) * 64 + 8 * hi;
          const bf16_t* stb = St + ((size_t)((bh * 2 + 1) * NCH + j)) * 4096 + (32 * dh + l31) * 64 + 8 * hi;
#pragma unroll
          for (int c = 0; c < 4; ++c) { sff[c] = *(const bf16x8*)(stf + 16 * c); sbf[c] = *(const bf16x8*)(stb + 16 * c); }
#pragma unroll
          for (int g = 0; g < 4; ++g) gwv[g] = *(const u32x2*)(P + row * PW + C_RG + 64 * h + 32 * dh + 8 * g + 4 * hi); }
        __syncthreads();
        bf16x8 qf[4];
#pragma unroll
        for (int c = 0; c < 4; ++c) qf[c] = *(const bf16x8*)(Qs + iq * 72 + 16 * c + 8 * hi);
        const float lgf2 = lgf * LOG2E, lgb2 = lgb * LOG2E;
        f32x16 o;
#pragma unroll
        for (int r = 0; r < 16; ++r) o[r] = 0.f;
#pragma unroll 1
        for (int sb = 0; sb < 4; ++sb) {
            f32x16 sa;
#pragma unroll
            for (int r = 0; r < 16; ++r) sa[r] = 0.f;
#pragma unroll
            for (int c = 0; c < 4; ++c) { const bf16x8 kf = *(const bf16x8*)(Ks + (32 * sb + l31) * 72 + 16 * c + 8 * hi); sa = MFMA32(kf, qf[c], sa); }
#pragma unroll
            for (int r = 0; r < 16; ++r) { const int dl = iq - (32 * sb + crow(r, hi));
                const float w = dl > 0 ? exp2f(lgf2 * (float)dl) : (dl < 0 ? exp2f(lgb2 * (float)(-dl)) : 2.0f); sa[r] *= w; }
#pragma unroll
            for (int c2 = 0; c2 < 2; ++c2) {
                const bf16x8 pa = pack8(sa[8 * c2 + 0], sa[8 * c2 + 1], sa[8 * c2 + 2], sa[8 * c2 + 3], sa[8 * c2 + 4], sa[8 * c2 + 5], sa[8 * c2 + 6], sa[8 * c2 + 7]);
                const bf16_t* vp = VT + (32 * dh + l31) * 136 + 32 * sb + 16 * c2 + 4 * hi;
                const bf16x8 vf = join8(*(const u32x2*)vp, *(const u32x2*)(vp + 8));
                o = MFMA32(vf, pa, o); }
        }
        f32x16 uf, ub;
#pragma unroll
        for (int r = 0; r < 16; ++r) { uf[r] = 0.f; ub[r] = 0.f; }
#pragma unroll
        for (int c = 0; c < 4; ++c) { uf = MFMA32(sff[c], qf[c], uf); ub = MFMA32(sbf[c], qf[c], ub); }
        const float xf = exp2f(lgf2 * (float)(iq + 1)), xb = exp2f(lgb2 * (float)(128 - iq));
        float sm = 0.f, sq = 0.f;
#pragma unroll
        for (int r = 0; r < 16; ++r) { o[r] += xf * uf[r] + xb * ub[r]; sm += o[r]; sq += o[r] * o[r]; }
        sm += __shfl_xor(sm, 32); sq += __shfl_xor(sq, 32);
        if (hi == 0) { red[(iq * 2 + dh) * 2 + 0] = sm; red[(iq * 2 + dh) * 2 + 1] = sq; }
        __syncthreads();
        const float tsum = red[(iq * 2 + 0) * 2 + 0] + red[(iq * 2 + 1) * 2 + 0], tsq = red[(iq * 2 + 0) * 2 + 1] + red[(iq * 2 + 1) * 2 + 1];
        const float mean = tsum * (1.0f / 64.0f), var = tsq * (1.0f / 64.0f) - mean * mean, rstd = rsqrtf(fmaxf(var, 0.f) + LN_EPS);
#pragma unroll
        for (int g = 0; g < 4; ++g) { const int d = 32 * dh + 8 * g + 4 * hi;
            const u32x2 gw = gwv[g]; const f32x4 nw = *(const f32x4*)(gnw + 64 * h + d);
            const float g0 = bflo(gw.x), g1 = bfhi(gw.x), g2 = bflo(gw.y), g3 = bfhi(gw.y);
            const float y0 = (o[4 * g + 0] - mean) * rstd * nw.x * (g0 / (1.0f + __expf(-g0))), y1 = (o[4 * g + 1] - mean) * rstd * nw.y * (g1 / (1.0f + __expf(-g1)));
            const float y2 = (o[4 * g + 2] - mean) * rstd * nw.z * (g2 / (1.0f + __expf(-g2))), y3 = (o[4 * g + 3] - mean) * rstd * nw.w * (g3 / (1.0f + __expf(-g3)));
            u32x2 w; w.x = pk2(y0, y1); w.y = pk2(y2, y3); *(u32x2*)(MIX + row * DM + 768 + 64 * h + d) = w; }
        __syncthreads();
    }
#undef R3_LOAD
}

__device__ __forceinline__ bf16x8 gather8(const bf16_t* base, size_t stride) {
    u32x4 o; o.x = (unsigned)base[0] | ((unsigned)base[stride] << 16); o.y = (unsigned)base[2 * stride] | ((unsigned)base[3 * stride] << 16);
    o.z = (unsigned)base[4 * stride] | ((unsigned)base[5 * stride] << 16); o.w = (unsigned)base[6 * stride] | ((unsigned)base[7 * stride] << 16); return __builtin_bit_cast(bf16x8, o);
}
__device__ __forceinline__ bf16x8 neg8(bf16x8 v) { u32x4 o = __builtin_bit_cast(u32x4, v); o.x ^= 0x80008000u; o.y ^= 0x80008000u; o.z ^= 0x80008000u; o.w ^= 0x80008000u; return __builtin_bit_cast(bf16x8, o); }
__device__ __forceinline__ void ph_four_a(const Params& p, unsigned char* lds, int gw, int NGW, int lane, int wave) {
    const bf16_t* P = (const bf16_t*)(p.ws + OFF_P); bf16_t* TB = (bf16_t*)(p.ws + OFF_TB); const float2* tw = (const float2*)(p.ws + OFF_TW);
    const bf16_t* F_r = (const bf16_t*)(p.ws + OFF_F128R); const bf16_t* F_i = (const bf16_t*)(p.ws + OFF_F128I);
    const int l31 = lane & 31, hi = lane >> 5, wv = __builtin_amdgcn_readfirstlane(wave);
    const bf16_t* ys = (const bf16_t*)lds + wv * 8192;
    for (int u = gw; u < 2048; u += NGW) {
        const int mh = u & 1, nb = (u >> 1) & 7, l2 = (u >> 4) & 63, b = u >> 10;
        { const bf16_t* src = P + (size_t)(b * SEQ + 64 * (lane >> 2) + l2) * PW + C_FR + 32 * nb + 8 * (lane & 3);
#pragma unroll
          for (int q = 0; q < 16; ++q)
              __builtin_amdgcn_global_load_lds((const unsigned*)(src + (size_t)(64 * 16 * (q & 7)) * PW + 256 * (q >> 3)), (LAS unsigned*)((LAS unsigned char*)lds + wv * 16384 + q * 1024), 16, 0, 0); }
        f32x16 tr[2], ti[2];
#pragma unroll
        for (int m = 0; m < 2; ++m)
#pragma unroll
            for (int r = 0; r < 16; ++r) { tr[m][r] = 0.f; ti[m][r] = 0.f; }
        asm volatile("s_waitcnt vmcnt(0)" ::: "memory");
#pragma unroll 4
        for (int c = 0; c < 8; ++c) {
            const bf16_t* yb = ys + (16 * c + 8 * hi) * 32 + l31;
            const bf16x8 yr = gather8(yb, 32), yi = gather8(yb + 4096, 32), nyi = neg8(yi);
#pragma unroll
            for (int m = 0; m < 2; ++m) { const int k1 = 32 * (2 * mh + m) + l31;
                const bf16x8 fr = *(const bf16x8*)(F_r + k1 * 128 + 16 * c + 8 * hi), fi = *(const bf16x8*)(F_i + k1 * 128 + 16 * c + 8 * hi);
                tr[m] = MFMA32(fr, yr, tr[m]); tr[m] = MFMA32(fi, nyi, tr[m]); ti[m] = MFMA32(fr, yi, ti[m]); ti[m] = MFMA32(fi, yr, ti[m]); }
        }
        LDSW();
#pragma unroll
        for (int m = 0; m < 2; ++m)
#pragma unroll
            for (int r = 0; r < 16; ++r) { const int k1 = 32 * (2 * mh + m) + crow(r, hi); const float2 w = tw[l2 * k1];
                const float a = tr[m][r] * w.x + ti[m][r] * w.y, bb = ti[m][r] * w.x - tr[m][r] * w.y;
                bf16_t* dst = TB + ((size_t)((b * 128 + k1) * 64 + l2)) * 512 + 32 * nb + l31; dst[0] = (bf16_t)f2bf(a); dst[256] = (bf16_t)f2bf(bb); }
    }
}
__device__ __forceinline__ void ph_four_b(const Params& p, unsigned char* lds, int gw, int NGW, int lane, int wave) {
    const bf16_t* TB = (const bf16_t*)(p.ws + OFF_TB); bf16_t* MIX = (bf16_t*)(p.ws + OFF_MIX);
    const bf16_t* C64 = (const bf16_t*)(p.ws + OFF_C64); const bf16_t* S64 = (const bf16_t*)(p.ws + OFF_S64);
    const int l31 = lane & 31, hi = lane >> 5, wv = __builtin_amdgcn_readfirstlane(wave);
    const bf16_t* xs = (const bf16_t*)lds + wv * 4096;
    for (int u = gw; u < 2048; u += NGW) {
        const int nb = u & 7, k1 = (u >> 3) & 127, b = u >> 10;
        const bf16_t* src = TB + ((size_t)((b * 128 + k1) * 64 + (lane >> 2))) * 512 + 32 * nb + 8 * (lane & 3);
#pragma unroll
        for (int q = 0; q < 8; ++q)
            __builtin_amdgcn_global_load_lds((const unsigned*)(src + (size_t)(16 * (q & 3)) * 512 + 256 * (q >> 2)), (LAS unsigned*)((LAS unsigned char*)lds + wv * 8192 + q * 1024), 16, 0, 0);
        f32x16 acc[2];
#pragma unroll
        for (int m = 0; m < 2; ++m)
#pragma unroll
            for (int r = 0; r < 16; ++r) acc[m][r] = 0.f;
        asm volatile("s_waitcnt vmcnt(0)" ::: "memory");
#pragma unroll
        for (int c = 0; c < 4; ++c) {
            const bf16_t* xb = xs + (16 * c + 8 * hi) * 32 + l31;
            const bf16x8 xr = gather8(xb, 32), xi = gather8(xb + 2048, 32);
#pragma unroll
            for (int m = 0; m < 2; ++m) { const bf16x8 cf = *(const bf16x8*)(C64 + (32 * m + l31) * 64 + 16 * c + 8 * hi), sf = *(const bf16x8*)(S64 + (32 * m + l31) * 64 + 16 * c + 8 * hi);
                acc[m] = MFMA32(cf, xr, acc[m]); acc[m] = MFMA32(sf, xi, acc[m]); }
        }
        LDSW();
#pragma unroll
        for (int m = 0; m < 2; ++m)
#pragma unroll
            for (int r = 0; r < 16; ++r) { const int lp = k1 + 128 * (32 * m + crow(r, hi));
                MIX[(size_t)(b * SEQ + lp) * DM + 512 + 32 * nb + l31] = (bf16_t)f2bf(acc[m][r] * 0.011048543456039806f); }
    }
}
__device__ __forceinline__ void ph_four_ctx(const Params& p, unsigned char* lds, int bid, int G, int lane, int wave) {
    const bf16_t* P = (const bf16_t*)(p.ws + OFF_P); bf16_t* MIX = (bf16_t*)(p.ws + OFF_MIX);
    const bf16_t* C256 = (const bf16_t*)(p.ws + OFF_C256); const bf16_t* S256 = (const bf16_t*)(p.ws + OFF_S256);
    const int l31 = lane & 31, hi = lane >> 5;
    if (__builtin_amdgcn_readfirstlane(wave) != 0) return;
    const bf16_t* ys = (const bf16_t*)lds;
    for (int u = bid; u < 128; u += G) {
        const int nb = u & 7, mb = (u >> 3) & 7, b = u >> 6;
        { const bf16_t* src = P + (size_t)(ML + b * LCTX + (lane >> 2)) * PW + C_FR + 32 * nb + 8 * (lane & 3);
#pragma unroll
          for (int q = 0; q < 32; ++q)
              __builtin_amdgcn_global_load_lds((const unsigned*)(src + (size_t)(16 * (q & 15)) * PW + 256 * (q >> 4)), (LAS unsigned*)((LAS unsigned char*)lds + q * 1024), 16, 0, 0); }
        f32x16 acc;
#pragma unroll
        for (int r = 0; r < 16; ++r) acc[r] = 0.f;
        asm volatile("s_waitcnt vmcnt(0)" ::: "memory");
#pragma unroll 4
        for (int c = 0; c < 16; ++c) {
            const bf16_t* yb = ys + (16 * c + 8 * hi) * 32 + l31;
            const bf16x8 yr = gather8(yb, 32), yi = gather8(yb + 8192, 32);
            const bf16x8 cf = *(const bf16x8*)(C256 + (32 * mb + l31) * 256 + 16 * c + 8 * hi), sf = *(const bf16x8*)(S256 + (32 * mb + l31) * 256 + 16 * c + 8 * hi);
            acc = MFMA32(cf, yr, acc); acc = MFMA32(sf, yi, acc);
        }
        LDSW();
#pragma unroll
        for (int r = 0; r < 16; ++r) MIX[(size_t)(ML + b * LCTX + 32 * mb + crow(r, hi)) * DM + 512 + 32 * nb + l31] = (bf16_t)f2bf(acc[r] * 0.0625f);
    }
}

#ifdef SELFCHECK
constexpr size_t OFF_FLAGS = 200 * KiB;
__device__ __forceinline__ unsigned hash32(unsigned x) { x ^= x >> 16; x *= 0x7feb352du; x ^= x >> 15; x *= 0x846ca68bu; x ^= x >> 16; return x; }
__device__ __forceinline__ void ph_selfcheck(const Params& p, int layer, int gw, int NGW, int lane) {
    const bf16_t* P = (const bf16_t*)(p.ws + OFF_P); const bf16_t* MIX = (const bf16_t*)(p.ws + OFF_MIX); unsigned* flags = (unsigned*)(p.ws + OFF_FLAGS);
    const float2* ropes = (const float2*)(p.ws + OFF_ROPES);
    for (int smp = gw; smp < 4096; smp += NGW) {
        const unsigned hsh = hash32(0x9e3779b9u * (unsigned)smp + 12345u);
        const int kind = smp & 3, b = (hsh >> 3) & 1, h = (hsh >> 4) & 3; const bool cx = (smp & 4) != 0;
        const int t = cx ? ((hsh >> 8) & 255) : ((hsh >> 8) & 8191);
        const int row = cx ? ML + b * LCTX + t : b * SEQ + t; const int d = lane;
        float ref = 0.f, got = 0.f;
        if (kind < 2) {
            const int isB = kind, kvh = h >> 1;
            const bf16_t* q = P + (size_t)row * PW + (isB ? C_QB : C_QA) + 64 * h;
            const int kcol = (isB ? C_KB : C_KA) + 64 * kvh, vcol = (isB ? C_VB : C_VA) + 64 * kvh;
            float mx = -1e30f;
            for (int pass = 0; pass < 2; ++pass) {
                float acc = 0.f, den = 0.f;
                for (int s = cx ? SEQ : 0; s < KVT; ++s) {
                    if (isB && s < SEQ) { int dd = s - t; dd = dd < 0 ? -dd : dd; if (dd > 128) continue; }
                    const int krow = s < SEQ ? b * SEQ + s : ML + b * LCTX + (s - SEQ);
                    const bf16_t* k = P + (size_t)krow * PW + kcol;
                    float sc = 0.f;
                    for (int e = 0; e < 64; ++e) sc += bf2f(q[e]) * bf2f(k[e]);
                    if (pass == 0) mx = fmaxf(mx, sc);
                    else { const float pr = exp2f(sc - mx); den += pr; acc += pr * bf2f(P[(size_t)krow * PW + vcol + d]); }
                }
                if (pass == 1) { if (isB) den += exp2f(p.in[9][layer * 4 + h] * LOG2E - mx); ref = acc / den; }
            }
            got = bf2f(MIX[(size_t)row * DM + (isB ? 256 : 0) + 64 * h + d]);
        } else if (kind == 2) {
            const int col = 64 * h + d; float acc = 0.f;
            if (!cx) { for (int l = 0; l < SEQ; ++l) { const int m = (l * t) & 8191; const float a = (float)m * (1.0f / 4096.0f);
                acc += cospif(a) * bf2f(P[(size_t)(b * SEQ + l) * PW + C_FR + col]) + sinpif(a) * bf2f(P[(size_t)(b * SEQ + l) * PW + C_FI + col]); }
              ref = acc * 0.011048543456039806f; }
            else { for (int l = 0; l < LCTX; ++l) { const int m = (l * t) & 255; const float a = (float)m * (1.0f / 128.0f);
                acc += cospif(a) * bf2f(P[(size_t)(ML + b * LCTX + l) * PW + C_FR + col]) + sinpif(a) * bf2f(P[(size_t)(ML + b * LCTX + l) * PW + C_FI + col]); }
              ref = acc * 0.0625f; }
            got = bf2f(MIX[(size_t)row * DM + 512 + col]);
        } else {
            const float lgf = logsig(p.in[11][layer * 8 + h]), lgb = logsig(p.in[11][layer * 8 + 4 + h]);
            float qv[64];
#pragma unroll
            for (int e = 0; e < 32; ++e) { const float x1 = bf2f(P[(size_t)row * PW + C_RQ + 64 * h + e]), x2 = bf2f(P[(size_t)row * PW + C_RQ + 64 * h + 32 + e]); const float2 cs = cx ? make_float2(1.f, 0.f) : ropes[t * 32 + e];
                qv[e] = x1 * cs.x - x2 * cs.y; qv[32 + e] = x2 * cs.x + x1 * cs.y; }
            float acc = 0.f;
            for (int s = cx ? SEQ : 0; s < KVT; ++s) {
                const int krow = s < SEQ ? b * SEQ + s : ML + b * LCTX + (s - SEQ);
                const bf16_t* k = P + (size_t)krow * PW + C_RK + 64 * h;
                float sc = 0.f;
#pragma unroll
                for (int e = 0; e < 32; ++e) { float x1 = bf2f(k[e]), x2 = bf2f(k[32 + e]);
                    if (s < SEQ) { const float2 cs = ropes[s * 32 + e]; const float y1 = x1 * cs.x - x2 * cs.y, y2 = x2 * cs.x + x1 * cs.y; x1 = y1; x2 = y2; }
                    sc += qv[e] * x1 + qv[32 + e] * x2; }
                sc *= 0.125f;
                float w;
                if (s < SEQ) { w = 0.f; if (s <= t) w += expf(lgf * (float)(t - s)); if (s >= t) w += expf(lgb * (float)(s - t)); }
                else if (!cx) { const int j = s - SEQ; w = expf(lgf * (float)(t + 256 - j)) + expf(lgb * (float)(8192 - t + j)); }
                else { const int j = s - SEQ; w = 0.f; if (j <= t) w += expf(lgf * (float)(t - j)); if (j >= t) w += expf(lgb * (float)(j - t)); }
                acc += w * sc * bf2f(P[(size_t)krow * PW + C_RV + 64 * h + d]);
            }
            const float mean = wave_sum(acc) * (1.0f / 64.0f); const float dv = acc - mean; const float var = wave_sum(dv * dv) * (1.0f / 64.0f);
            const float g = bf2f(P[(size_t)row * PW + C_RG + 64 * h + d]);
            ref = dv * rsqrtf(var + LN_EPS) * p.in[12][layer * 256 + 64 * h + d] * (g / (1.0f + expf(-g)));
            got = bf2f(MIX[(size_t)row * DM + 768 + 64 * h + d]);
        }
        const float e2 = wave_sum((ref - got) * (ref - got)), r2 = wave_sum(ref * ref);
        if (lane == 0 && !(e2 <= 0.0025f * r2 + 1e-12f)) atomicOr(flags, 1u << kind);
    }
}
#endif
#ifndef DBL
#define DBL 0
#endif
#define REP(k) for (int rep_ = 0; rep_ < 1 + ((DBL >> (k)) & 1); ++rep_)

template <bool masked, bool SAFE>
__device__ __forceinline__ bool attn_unit(const Params& p, int layer, unsigned char* lds, int tid, int b, int h, int qblk, int isB, int isctx) {
    const bf16_t* P = (const bf16_t*)(p.ws + OFF_P); bf16_t* MIX = (bf16_t*)(p.ws + OFF_MIX);
    bf16_t* Kt = (bf16_t*)lds;
    bf16_t* Vt = Kt + 4 * 4096;
    const int lane = tid & 63, wave = tid >> 6, l31 = lane & 31, hi = lane >> 5;
    const int kvh = h >> 1;
    const int qrow0 = isctx ? ML + b * LCTX : b * SEQ + 256 * qblk;
    int t_lo = 0, nlat = 128;
    if (isctx) nlat = 0; else if (isB) { t_lo = 4 * qblk - 2; if (t_lo < 0) t_lo = 0; int t_hi = 4 * qblk + 6; if (t_hi > 128) t_hi = 128; nlat = t_hi - t_lo; }
    const int ntile = nlat + 4;
    const int qcol = (isB ? C_QB : C_QA) + 64 * h, kcol = (isB ? C_KB : C_KA) + 64 * kvh;
    const bf16_t* VTg = (const bf16_t*)(p.ws + (isB ? OFF_VBT : OFF_VAT)) + (size_t)((b * 2 + kvh) * 64) * KVT;
    bf16x8 qf[4];
    { const bf16_t* qp = P + (size_t)(qrow0 + 32 * wave + l31) * PW + qcol + 8 * hi;
#pragma unroll
      for (int c = 0; c < 4; ++c) qf[c] = *(const bf16x8*)(qp + 16 * c); }
    const int qpos = 256 * qblk + 32 * wave + l31, qp0 = 256 * qblk + 32 * wave;
    f32x16 o0, o1;
#pragma unroll
    for (int r = 0; r < 16; ++r) { o0[r] = 0.f; o1[r] = 0.f; }
    float m = -1e30f, l = 0.f;
    f32x16 negm;
#pragma unroll
    for (int r = 0; r < 16; ++r) negm[r] = 0.f;
    bool first = true;
    const int wv = __builtin_amdgcn_readfirstlane(wave), dr = 8 * wv + (lane >> 3), dc = (lane & 7) ^ ((dr >> 1) & 7);
    const int sw = (l31 >> 1) & 7;
#define SWZ(idx) (8 * ((((idx) | hi)) ^ sw))
#define ATT_TILE(i) ((i) < nlat ? t_lo + (i) : 128 + (i) - nlat)
#define ATT_DMA(i, buf) do { const int t_ = ATT_TILE(i); const int krow_ = t_ < 128 ? b * SEQ + 64 * t_ + dr : ML + b * LCTX + 64 * (t_ - 128) + dr; \
    __builtin_amdgcn_global_load_lds((const unsigned*)(P + (size_t)krow_ * PW + kcol + 8 * dc), (LAS unsigned*)((LAS unsigned char*)lds + (buf) * 8192 + wv * 1024), 16, 0, 0); \
    __builtin_amdgcn_global_load_lds((const unsigned*)(VTg + (size_t)dr * KVT + 64 * t_ + 8 * dc), (LAS unsigned*)((LAS unsigned char*)lds + 32768 + (buf) * 8192 + wv * 1024), 16, 0, 0); } while (0)
    ATT_DMA(0, 0); ATT_DMA(1, 1);
    __syncthreads();
    for (int ip = 0; ip < ntile; ip += 2) {
      const int stage = (ip >> 1) & 1;
      if (ip + 2 < ntile) { ATT_DMA(ip + 2, (stage ^ 1) * 2); ATT_DMA(ip + 3, (stage ^ 1) * 2 + 1); }
#pragma unroll 1
      for (int sub = 0; sub < 2; ++sub) {
        const int i = ip + sub; const int buf = stage * 2 + sub;
        const int t = ATT_TILE(i);
        const bool lat = t < 128;
        const bool active = !(isB && lat) || (64 * t + 63 >= qp0 - 128 && 64 * t <= qp0 + 31 + 128);
        if (active) {
            const bf16_t* kb = Kt + buf * 4096 + l31 * 64;
            f32x16 s0, s1;
#define ATT_SCORES() do { s0 = MFMA32(*(const bf16x8*)(kb + SWZ(0)), qf[0], negm); s1 = MFMA32(*(const bf16x8*)(kb + 2048 + SWZ(0)), qf[0], negm); \
                _Pragma("unroll") for (int c = 1; c < 4; ++c) { s0 = MFMA32(*(const bf16x8*)(kb + SWZ(2 * c)), qf[c], s0); s1 = MFMA32(*(const bf16x8*)(kb + 2048 + SWZ(2 * c)), qf[c], s1); } } while (0)
#define ATT_MASK() do { if (masked && lat) { _Pragma("unroll") for (int r = 0; r < 16; ++r) { const int kp = 64 * t + crow(r, hi); int d0 = kp - qpos; d0 = d0 < 0 ? -d0 : d0; int d1 = kp + 32 - qpos; d1 = d1 < 0 ? -d1 : d1; \
                if (d0 > 128) s0[r] = -1e30f; if (d1 > 128) s1[r] = -1e30f; } } } while (0)
            ATT_SCORES();
            const bf16_t* vb = Vt + buf * 4096 + l31 * 64;
            const bf16x8 vf00 = *(const bf16x8*)(vb + SWZ(0)), vf01 = *(const bf16x8*)(vb + SWZ(4)), vf02 = *(const bf16x8*)(vb + SWZ(2)), vf03 = *(const bf16x8*)(vb + SWZ(6));
            const bf16x8 vf10 = *(const bf16x8*)(vb + 2048 + SWZ(0)), vf11 = *(const bf16x8*)(vb + 2048 + SWZ(4)), vf12 = *(const bf16x8*)(vb + 2048 + SWZ(2)), vf13 = *(const bf16x8*)(vb + 2048 + SWZ(6));
            __builtin_amdgcn_sched_barrier(0);
            ATT_MASK();
            {
                if (first) { first = false;
                    float mx = fmaxf(s0[0], s1[0]);
#pragma unroll
                    for (int r = 1; r < 16; ++r) mx = fmaxf(mx, fmaxf(s0[r], s1[r]));
                    m = xhalf_max(mx); if (masked) m = m < -1e29f ? 0.f : m;
#pragma unroll
                    for (int r = 0; r < 16; ++r) { s0[r] -= m; s1[r] -= m; negm[r] = -m; } }
                float ps = 0.f, ps1 = 0.f;
#pragma unroll
                for (int r = 0; r < 16; ++r) { s0[r] = __builtin_amdgcn_exp2f(s0[r]); s1[r] = __builtin_amdgcn_exp2f(s1[r]); ps += s0[r]; ps += s1[r]; }
                (void)ps1;
                if (SAFE && __any(!(ps <= 4096.0f))) {
                    ATT_SCORES(); ATT_MASK();
                    float mx = fmaxf(s0[0], s1[0]);
#pragma unroll
                    for (int r = 1; r < 16; ++r) mx = fmaxf(mx, fmaxf(s0[r], s1[r]));
                    mx = xhalf_max(mx);
                    const float dl = fmaxf(mx, 0.f), sc = __builtin_amdgcn_exp2f(-dl); m += dl; l *= sc; ps = 0.f;
#pragma unroll
                    for (int r = 0; r < 16; ++r) { o0[r] *= sc; o1[r] *= sc; negm[r] = -m; s0[r] = __builtin_amdgcn_exp2f(s0[r] - dl); s1[r] = __builtin_amdgcn_exp2f(s1[r] - dl); ps += s0[r] + s1[r]; }
                }
                l += ps;
            }
#undef ATT_MASK
#undef ATT_SCORES
            {   const bf16x8 pa00 = pack8(s0[0], s0[1], s0[2], s0[3], s0[4], s0[5], s0[6], s0[7]), pa10 = pack8(s1[0], s1[1], s1[2], s1[3], s1[4], s1[5], s1[6], s1[7]);
                const bf16x8 pa01 = pack8(s0[8], s0[9], s0[10], s0[11], s0[12], s0[13], s0[14], s0[15]), pa11 = pack8(s1[8], s1[9], s1[10], s1[11], s1[12], s1[13], s1[14], s1[15]);
                o0 = MFMA32(vf00, pa00, o0); o1 = MFMA32(vf10, pa00, o1);
                o0 = MFMA32(vf01, pa10, o0); o1 = MFMA32(vf11, pa10, o1);
                o0 = MFMA32(vf02, pa01, o0); o1 = MFMA32(vf12, pa01, o1);
                o0 = MFMA32(vf03, pa11, o0); o1 = MFMA32(vf13, pa11, o1);
            }
        }
      }
      __syncthreads();
    }
#undef ATT_TILE
#undef ATT_DMA
#undef SWZ
    l = xhalf_sum(l);
    const bool bad = !SAFE && __syncthreads_or(!(l < 1e30f) ? 1 : 0) != 0;
    if (bad) return true;
    if (isB) l += exp2f(p.in[9][layer * 4 + h] * LOG2E - m);
    const float inv = 1.0f / l;
    bf16_t* op = MIX + (size_t)(qrow0 + 32 * wave + l31) * DM + (isB ? 256 : 0) + 64 * h + 4 * hi;
#pragma unroll
    for (int g = 0; g < 4; ++g) { u32x2 w; w.x = pk2(o0[4 * g] * inv, o0[4 * g + 1] * inv); w.y = pk2(o0[4 * g + 2] * inv, o0[4 * g + 3] * inv); *(u32x2*)(op + 8 * g) = w;
        u32x2 w1; w1.x = pk2(o1[4 * g] * inv, o1[4 * g + 1] * inv); w1.y = pk2(o1[4 * g + 2] * inv, o1[4 * g + 3] * inv); *(u32x2*)(op + 32 + 8 * g) = w1; }
    return false;
}
__device__ __forceinline__ void ph_attn(const Params& p, int layer, unsigned char* lds, int tid, int bid, int G) {
    const int total = layer == 0 ? 528 : 512;
    for (int u = bid; u < total; u += G) {
        int b, h, qblk, isB, isctx;
        if (u < 512) { const int v = u & 255, grp = v & 3, idx = v >> 2; isB = u >> 8; isctx = 0; b = grp >> 1; h = (grp & 1) * 2 + (idx >> 5); qblk = idx & 31; }
        else { const int v = u - 512; isB = v >> 3; isctx = 1; b = (v >> 2) & 1; h = v & 3; qblk = 0; }
        if (isB && !isctx) { if (attn_unit<true, false>(p, layer, lds, tid, b, h, qblk, isB, isctx)) attn_unit<true, true>(p, layer, lds, tid, b, h, qblk, isB, isctx); }
        else { if (attn_unit<false, false>(p, layer, lds, tid, b, h, qblk, isB, isctx)) attn_unit<false, true>(p, layer, lds, tid, b, h, qblk, isB, isctx); }
    }
}

__device__ __forceinline__ void ph_ctx_gemm(const bf16_t* A, const bf16_t* Bt, bf16_t* O, int K, unsigned char* lds, int tid, int bid, int G) {
    const int lane = tid & 63, wave = tid >> 6, l31 = lane & 31, hi = lane >> 5, ks = wave & 3, Kq = K >> 2;
    float* red = (float*)lds;
    for (int tp = bid; tp < 256; tp += G) {
        const int tile = 2 * tp + (wave >> 2), mb = tile >> 5, nb = tile & 31;
        const bf16_t* ap = A + (size_t)(ML + 32 * mb + l31) * K + ks * Kq + 8 * hi; const bf16_t* bp = Bt + (size_t)(32 * nb + l31) * K + ks * Kq + 8 * hi;
        f32x16 acc;
#pragma unroll
        for (int r = 0; r < 16; ++r) acc[r] = 0.f;
#pragma unroll 8
        for (int c = 0; c < Kq / 16; ++c) acc = MFMA32(*(const bf16x8*)(ap + 16 * c), *(const bf16x8*)(bp + 16 * c), acc);
#pragma unroll
        for (int r = 0; r < 16; ++r) red[(wave * 16 + r) * 64 + lane] = acc[r];
        __syncthreads();
        if (ks == 0) {
#pragma unroll
            for (int r = 0; r < 16; ++r) { const float v = ((red[(wave * 16 + r) * 64 + lane] + red[((wave + 1) * 16 + r) * 64 + lane]) + red[((wave + 2) * 16 + r) * 64 + lane]) + red[((wave + 3) * 16 + r) * 64 + lane];
                O[(size_t)(ML + 32 * mb + crow(r, hi)) * DM + 32 * nb + l31] = (bf16_t)f2bf(v); } }
        __syncthreads();
    }
}

__global__ void __launch_bounds__(512, 2) fwd_megakernel(Params p_arg) {
    extern __shared__ __attribute__((aligned(16))) unsigned char lds[];
    cg::grid_group grid = cg::this_grid();
    const int n_steps = p_arg.n_steps;
    volatile LAS unsigned* bst = (volatile LAS unsigned*)((LAS unsigned char*)lds + 140000);
    if (threadIdx.x < 2) bst[threadIdx.x] = 0u;
    __syncthreads();
    const XcdBarrier xbar = xcd_barrier_post((unsigned*)(p_arg.ws + OFF_BAR), bst);
#define GRID_SYNC() do { if (n_steps < 0) grid.sync(); else xcd_barrier(xbar); } while (0)
#pragma unroll 1
    for (int step = 0; step < n_steps; ++step) {
        const __attribute__((address_space(4))) Params* pp = (const __attribute__((address_space(4))) Params*)__builtin_amdgcn_kernarg_segment_ptr();
        asm volatile("" : "+s"(pp));
#if defined(__HIP_DEVICE_COMPILE__)
        const Params p = *pp;
#else
        const Params p = p_arg;
#endif
        int bid = blockIdx.x; asm volatile("" : "+s"(bid));
        const int G = gridDim.x, NGW = G * 8, NT = G * 512;
        unsigned char* ws = p.ws;
        const int layer = step < 2 ? 0 : (step - 2) / 9, ph = step < 2 ? step : 2 + (step - 2) % 9;
        const bool last = layer == 1;
        const int mrows = last ? ML : MT;
        int gk = 0;
        const bf16_t* gA = nullptr; const bf16_t* gB = nullptr; bf16_t* gO = nullptr; int gM = 0, gN = 0, gK = 0;
#define IDS int t_ = threadIdx.x; asm volatile("" : "+v"(t_)); const int tid = t_, lane = t_ & 63, wave = __builtin_amdgcn_readfirstlane(t_ >> 6), gw = bid * 8 + wave, gtid = bid * 512 + t_; (void)tid; (void)lane; (void)wave; (void)gw; (void)gtid
        switch (ph) {
        case 0:
#ifdef SELFCHECK
            { IDS; if (gtid == 0) *(unsigned*)(ws + OFF_FLAGS) = 0u; }
#endif
            { IDS; ph_tables(ws, gtid, NT); }
            REP(7) { { IDS; ph_mod(p.in[1], p.in[3], p.in[4], p.in[5], (float*)(ws + OFF_MOD), lds, tid, bid, G); } __syncthreads(); { IDS; ph_weights(p, 0, lds, tid, bid, G, 48); } __syncthreads(); } break;
        case 1: REP(6) { IDS; ph_h0(p, gw, NGW, lane); } break;
        case 2: gk = 1; gA = (const bf16_t*)(ws + OFF_H); gB = (const bf16_t*)(ws + OFF_WIN); gO = (bf16_t*)(ws + OFF_P); gM = MT; gN = PW; gK = DM; break;
        case 3: { IDS; ph_prep(p, layer, lds, gw, NGW, lane, wave); } __syncthreads(); REP(2) { IDS; ph_ret_local(p, layer, lds, tid, bid, G); } REP(3) { { IDS; ph_four_a(p, lds, gw, NGW, lane, wave); } if (!last) { __syncthreads(); { IDS; ph_four_ctx(p, lds, bid, G, lane, wave); } } } break;
        case 4: REP(9) { IDS; ph_ret_scan(p, layer, gtid, NT); } REP(0) { IDS; ph_attn(p, layer, lds, tid, bid, G); } REP(4) { IDS; ph_four_b(p, lds, gw, NGW, lane, wave); } break;
        case 5: REP(5) { IDS; ph_ret_out(p, layer, lds, tid, bid, G); }
#ifdef SELFCHECK
            if (layer == 0) { GRID_SYNC(); { IDS; ph_selfcheck(p, layer, gw, NGW, lane); } }
#endif
            break;
        case 6: gk = 1; gA = (const bf16_t*)(ws + OFF_MIX); gB = (const bf16_t*)(ws + OFF_WOUT); gO = (bf16_t*)(ws + OFF_P); gM = ML; gN = DM; gK = DM; break;
        case 7: { IDS; ph_rowpass(p, layer, 0, mrows, true, gw, NGW, lane); } break;
        case 8: gk = 2; gA = (const bf16_t*)(ws + OFF_H); gB = (const bf16_t*)(ws + OFF_WGU); gO = (bf16_t*)(ws + OFF_P); gM = mrows; gN = 2 * FF; gK = DM; break;
        case 9: gk = 1; gA = (const bf16_t*)(ws + OFF_P); gB = (const bf16_t*)(ws + OFF_WDN); gO = (bf16_t*)(ws + OFF_Y2); gM = ML; gN = DM; gK = FF; break;
        default: { IDS; ph_rowpass(p, layer, 1, mrows, !last, gw, NGW, lane); } if (!last) { IDS; ph_weights(p, 1, lds, tid, bid, G); } break;
        }
        if (gk == 1) REP(1) { pg8::Gemm g{gA, gB, gM, gN, gK}; pg8::StaticOrder S; S.init(gM, gN, G, bid);
            pg8::EpiPlain E{gO, gN};
            pg8::gemm_phase<pg8::EpiPlain, pg8::StaticOrder, true, true>((PG8_LAS unsigned char*)lds, g, S, E);
            if (!last && gN == DM) { IDS; ph_ctx_gemm(gA, gB, gO, gK, lds, tid, bid, G); } }
        else if (gk == 2) REP(1) { pg8::Gemm g{gA, gB, gM, gN, gK}; pg8::StaticOrder S; S.init(gM, gN, G, bid);
            pg8::EpiSwiglu E{gO, FF};
            pg8::gemm_phase<pg8::EpiSwiglu, pg8::StaticOrder, true, true>((PG8_LAS unsigned char*)lds, g, S, E); }
        if (step + 1 < n_steps) GRID_SYNC();
        REP(8) { if (rep_ == 1) GRID_SYNC(); }
    }
}

extern "C" void kernel_launch(void* const* d_in, const int* in_sizes, int n_in, void* d_out, int out_size, void* d_ws, size_t ws_size, hipStream_t stream) {
    static int grid = 0;
    if (grid == 0) {
        if (n_in != 20 || out_size != ML * DM || ws_size < WS_NEED) { fprintf(stderr, "kernel_launch: unexpected shapes (n_in %d, out %d, ws %zu)\n", n_in, out_size, ws_size); grid = -1; return; }
        int dev = 0, cus = 0, per_cu = 0;
        hipGetDevice(&dev); hipDeviceGetAttribute(&cus, hipDeviceAttributeMultiprocessorCount, dev);
        if (hipFuncSetAttribute((const void*)fwd_megakernel, hipFuncAttributeMaxDynamicSharedMemorySize, LDS_BYTES) != hipSuccess) { fprintf(stderr, "kernel_launch: hipFuncSetAttribute failed\n"); grid = -1; return; }
        if (hipOccupancyMaxActiveBlocksPerMultiprocessor(&per_cu, (const void*)fwd_megakernel, 512, LDS_BYTES) != hipSuccess || per_cu < 1) { fprintf(stderr, "kernel_launch: occupancy query says %d\n", per_cu); per_cu = 1; }
        (void)hipGetLastError();
        grid = cus;
    }
    if (grid < 0) return;
    Params p{};
    p.n_steps = 20; p.pad = 0;
    for (int i = 0; i < 20; ++i) p.in[i] = (const float*)d_in[i];
    p.out = (float*)d_out; p.ws = (unsigned char*)d_ws;
    if (hipMemsetAsync((char*)d_ws + OFF_BAR, 0, 16384, stream) != hipSuccess) { fprintf(stderr, "kernel_launch: memset failed\n"); return; }
    void* args[] = {&p};
    hipError_t e = hipLaunchCooperativeKernel((const void*)fwd_megakernel, dim3(grid), dim3(512), args, LDS_BYTES, stream);
    if (e != hipSuccess) fprintf(stderr, "cooperative launch failed: %s (grid %d)\n", hipGetErrorString(e), grid);
}
```

```cpp
#include <hip/hip_runtime.h>
#include <hip/hip_cooperative_groups.h>
#include <cstdio>
#include <cstdint>
namespace cg = cooperative_groups;
namespace pg8 {
#define PG8_LAS __attribute__((address_space(3)))
typedef unsigned short bf16_t;
typedef short bf16x8 __attribute__((ext_vector_type(8)));
typedef float f32x4 __attribute__((ext_vector_type(4)));
typedef unsigned u32x4 __attribute__((ext_vector_type(4)));
constexpr int BM = 256, BK = 64, HALF = 128, HTB = HALF * BK * 2  , STAGE_BYTES = 8 * HTB, NXCD = 8, WGM = 8;

__host__ __device__ __forceinline__ int lds_byte(int r, int c) { const int st = (r >> 4) * 2 + (c >> 5), rr = r & 15, cc = c & 31, ob = rr * 64 + cc * 2; return st * 1024 + (ob ^ (((ob >> 9) & 1) << 5)); }
__host__ __device__ __forceinline__ void stage_rc(int b, int& R, int& C) { const int st = b / 1024, sb = b % 1024, swz = sb ^ (((sb >> 9) & 1) << 5); R = (st >> 1) * 16 + swz / 64; C = (st & 1) * 32 + (swz % 64) / 2; }
__host__ __device__ __forceinline__ int perm32(int rho) { const int n = rho >> 4, i = rho & 15; return 8 * (i >> 2) + 4 * n + (i & 3); }

struct Unit { int pm, pn; };
struct Gemm { const bf16_t* A; const bf16_t* Bt; int M, N, K; };

struct StaticOrder {
    int nM, nN, nwg, G, c;
    __host__ __device__ void init(int M, int N, int G_, int c_) { nM = M / BM; nN = N / BM; nwg = nM * nN; G = G_; c = c_; }
    __host__ __device__ bool next(int i, Unit& u) const {
        const long L = (long)i * G + c; if (L >= nwg) return false;
        int wgid = (int)L; { const int q = nwg / NXCD, r = nwg % NXCD, xcd = wgid % NXCD, off = wgid / NXCD; wgid = (xcd < r ? xcd * (q + 1) : r * (q + 1) + (xcd - r) * q) + off; }
        const int nig = WGM * nN, gid = wgid / nig, fm = gid * WGM, gsz = (nM - fm) < WGM ? (nM - fm) : WGM;
        u.pm = fm + ((wgid % nig) % gsz); u.pn = (wgid % nig) / gsz; return true;
    }
    __device__ __forceinline__ void a_ready(const Unit&) const {}
    __device__ __forceinline__ void done(const Unit&) const {}
};

__device__ __forceinline__ unsigned cvt_pk_bf16(float lo, float hi) { unsigned r; asm volatile("v_cvt_pk_bf16_f32 %0, %1, %2" : "=v"(r) : "v"(lo), "v"(hi)); return r; }
typedef float f32x2 __attribute__((ext_vector_type(2)));
__device__ __forceinline__ f32x2 gelu_pk(f32x2 v) {
    const f32x2 av = __builtin_elementwise_abs(v), d = av * 0.2316418882f + 1.0f;
    f32x2 t; t.x = __builtin_amdgcn_rcpf(d.x); t.y = __builtin_amdgcn_rcpf(d.y);
    f32x2 q = t * 0.5307027145f + (-0.7265760135f); q = q * t + 0.7107068705f; q = q * t + (-0.142248368f); q = q * t + 0.127414796f; q = q * t;
    const f32x2 s = (v * v) * (-0.72134752044f);
    f32x2 e; e.x = __builtin_amdgcn_exp2f(s.x); e.y = __builtin_amdgcn_exp2f(s.y);
    const f32x2 m = v * (q * e), r = v - m;
    f32x2 o; o.x = v.x < 0.f ? m.x : r.x; o.y = v.y < 0.f ? m.y : r.y; return o;
}

template <int ACT  > struct EpiBf16 {
    static constexpr bool PERM = true, AFTER_DRAIN = false; static_assert(ACT == 0 || ACT == 1, "EpiBf16: ACT is 0 (none) or 1 (gelu_pk)");
    bf16_t* O; int ldc; const float* bias; int split_cols; size_t split_stride; float scale0;
    __device__ __forceinline__ void operator()(const f32x4 (&acc)[2][2][4][2], const Unit& u, int wr, int wc, int fr, int fq) const {
        const int row0 = u.pm * BM + wr * 64 + fr; int colt = u.pn * BM; bf16_t* base = O;
        float sc = 1.f; if (split_cols) { const int t = colt / split_cols; base += (size_t)t * split_stride; colt -= t * split_cols; if (t == 0) sc = scale0; }
        const int col0 = colt + wc * 32 + 8 * fq, bcol0 = u.pn * BM + wc * 32 + 8 * fq;
        f32x4 bv[2][2];
#pragma unroll
        for (int bj = 0; bj < 2; ++bj)
#pragma unroll
            for (int n = 0; n < 2; ++n) bv[bj][n] = bias ? *(const f32x4*)(bias + bcol0 + bj * HALF + 4 * n) : (f32x4){0.f, 0.f, 0.f, 0.f};
#pragma unroll
        for (int ai = 0; ai < 2; ++ai)
#pragma unroll
            for (int m = 0; m < 4; ++m) { bf16_t* rowp = base + (size_t)(row0 + ai * HALF + m * 16) * ldc + col0;
#pragma unroll
                for (int bj = 0; bj < 2; ++bj) { f32x4 v0 = acc[ai][bj][m][0] + bv[bj][0], v1 = acc[ai][bj][m][1] + bv[bj][1];
                    if (ACT == 1) { f32x2 a = gelu_pk((f32x2){v0[0], v0[1]}), b = gelu_pk((f32x2){v0[2], v0[3]}), c = gelu_pk((f32x2){v1[0], v1[1]}), d = gelu_pk((f32x2){v1[2], v1[3]});
                        v0 = (f32x4){a.x, a.y, b.x, b.y}; v1 = (f32x4){c.x, c.y, d.x, d.y}; }
                    v0 = v0 * sc; v1 = v1 * sc; u32x4 w; w.x = cvt_pk_bf16(v0[0], v0[1]); w.y = cvt_pk_bf16(v0[2], v0[3]); w.z = cvt_pk_bf16(v1[0], v1[1]); w.w = cvt_pk_bf16(v1[2], v1[3]);
                    *(u32x4*)(rowp + bj * HALF) = w; } }
    }
};

struct EpiSwiglu {
    static constexpr bool PERM = true, AFTER_DRAIN = false;
    bf16_t* O; int ldo;
    __device__ __forceinline__ void operator()(const f32x4 (&acc)[2][2][4][2], const Unit& u, int wr, int wc, int fr, int fq) const {
        const int row0 = u.pm * BM + wr * 64 + fr; const int col0 = u.pn * 128 + wc * 32 + 8 * fq;
#pragma unroll
        for (int ai = 0; ai < 2; ++ai)
#pragma unroll
            for (int m = 0; m < 4; ++m) { bf16_t* rowp = O + (size_t)(row0 + ai * HALF + m * 16) * ldo + col0;
                float r[8];
#pragma unroll
                for (int n = 0; n < 2; ++n)
#pragma unroll
                    for (int e = 0; e < 4; ++e) { const float g = acc[ai][0][m][n][e], up = acc[ai][1][m][n][e];
                        r[4 * n + e] = g * __builtin_amdgcn_rcpf(1.0f + __expf(-g)) * up; }
                u32x4 w; w.x = cvt_pk_bf16(r[0], r[1]); w.y = cvt_pk_bf16(r[2], r[3]); w.z = cvt_pk_bf16(r[4], r[5]); w.w = cvt_pk_bf16(r[6], r[7]);
                *(u32x4*)rowp = w; }
    }
};

struct EpiPlain {
    static constexpr bool PERM = true, AFTER_DRAIN = false;
    bf16_t* O; int ldc;
    __device__ __forceinline__ void operator()(const f32x4 (&acc)[2][2][4][2], const Unit& u, int wr, int wc, int fr, int fq) const {
        bf16_t* base = O + (size_t)(u.pm * BM + wr * 64 + fr) * ldc + u.pn * BM + wc * 32 + 8 * fq;
#pragma unroll
        for (int ai = 0; ai < 2; ++ai)
#pragma unroll
            for (int m = 0; m < 4; ++m) { bf16_t* rowp = base + (size_t)(ai * HALF + m * 16) * ldc;
#pragma unroll
                for (int bj = 0; bj < 2; ++bj) { const f32x4 v0 = acc[ai][bj][m][0], v1 = acc[ai][bj][m][1];
                    u32x4 w; w.x = cvt_pk_bf16(v0[0], v0[1]); w.y = cvt_pk_bf16(v0[2], v0[3]); w.z = cvt_pk_bf16(v1[0], v1[1]); w.w = cvt_pk_bf16(v1[2], v1[3]);
                    *(u32x4*)(rowp + bj * HALF) = w; } }
    }
};
template <class Epi, class Sched, bool ALIGN_EPI = false, bool SP2 = false>
__device__ __forceinline__ void gemm_phase(PG8_LAS unsigned char* lds, const Gemm g, const Sched& S, const Epi& E) {
    int tid_ = threadIdx.x; asm volatile("" : "+v"(tid_));
    const int tid = tid_, wid = __builtin_amdgcn_readfirstlane(tid >> 6), lane = tid & 63, wr = wid >> 2, wc = wid & 3, fr = lane & 15, fq = lane >> 4;
    const int K = g.K, nt = K / BK;
    unsigned voffA[2], voffB[2];
#pragma unroll
    for (int i = 0; i < 2; ++i) { int R, C; stage_rc(tid * 16 + i * 8192, R, C); const int Rb = Epi::PERM ? ((R & ~31) + perm32(R & 31)) : R;
        voffA[i] = (unsigned)(R * K + C) * 2u; voffB[i] = (unsigned)(Rb * K + C) * 2u; }
    const size_t kstep = (size_t)(BK * 2);
    const size_t hstep = (size_t)HALF * K * 2;
    const size_t tstep = 2 * hstep;
    const unsigned ldsw = (unsigned)wid * 1024u;
    const int aoff = lds_byte(wr * 64 + fr, fq * 8), boff = lds_byte(wc * 32 + fr, fq * 8);
#define PG8_SA(b, h) (((b) * 2 + (h)) * HTB)
#define PG8_SB(b, h) ((4 + (b) * 2 + (h)) * HTB)
#define PG8_STAGE(bufoff, gbase, voff) do { _Pragma("unroll") for (int _i = 0; _i < 2; ++_i) \
        __builtin_amdgcn_global_load_lds((const unsigned*)((const char*)(gbase) + (voff)[_i]), (PG8_LAS unsigned*)(lds + (bufoff) + ldsw + _i * 8192), 16, 0, 0); } while (0)
#define PG8_LDA(dst, b, h) do { _Pragma("unroll") for (int m = 0; m < 4; ++m) _Pragma("unroll") for (int k = 0; k < 2; ++k) dst[m][k] = *(const PG8_LAS bf16x8*)(lds + PG8_SA(b, h) + aoff + m * 2048 + k * 1024); } while (0)
#define PG8_LDB(dst, b, h) do { _Pragma("unroll") for (int n = 0; n < 2; ++n) _Pragma("unroll") for (int k = 0; k < 2; ++k) dst[n][k] = *(const PG8_LAS bf16x8*)(lds + PG8_SB(b, h) + boff + n * 2048 + k * 1024); } while (0)
#define PG8_MMA(ai, bj, At, Bt) do { __builtin_amdgcn_s_setprio(1); _Pragma("unroll") for (int m = 0; m < 4; ++m) _Pragma("unroll") for (int n = 0; n < 2; ++n) _Pragma("unroll") for (int k = 0; k < 2; ++k) \
        acc[ai][bj][m][n] = __builtin_amdgcn_mfma_f32_16x16x32_bf16(Bt[n][k], At[m][k], acc[ai][bj][m][n], 0, 0, 0); __builtin_amdgcn_s_setprio(0); } while (0)
#define PG8_WAIT_V(n) asm volatile("s_waitcnt vmcnt(" #n ")" ::: "memory")
#define PG8_WAIT_L(n) asm volatile("s_waitcnt lgkmcnt(" #n ")" ::: "memory")
#define PG8_BAR __builtin_amdgcn_s_barrier()
#define PG8_SCHED __builtin_amdgcn_sched_barrier(0)
    Unit cur, nxt; int ui = 0;
    if (!S.next(0, cur)) return;
    f32x4 acc[2][2][4][2];
#pragma unroll
    for (int a = 0; a < 2; ++a)
#pragma unroll
        for (int b = 0; b < 2; ++b)
#pragma unroll
            for (int m = 0; m < 4; ++m)
#pragma unroll
                for (int n = 0; n < 2; ++n) acc[a][b][m][n] = (f32x4){0.f, 0.f, 0.f, 0.f};
    bf16x8 At[4][2], B0[2][2], B1[2][2];
    const char* cA = (const char*)g.A + (size_t)cur.pm * tstep; const char* cB = (const char*)g.Bt + (size_t)cur.pn * tstep;
    S.a_ready(cur);
    if constexpr (SP2) {
        PG8_STAGE(PG8_SB(0, 0), cB, voffB); PG8_STAGE(PG8_SB(0, 1), cB + hstep, voffB); PG8_STAGE(PG8_SA(0, 0), cA, voffA); PG8_STAGE(PG8_SA(0, 1), cA + hstep, voffA);
        if (wr == 1) PG8_BAR;
        PG8_WAIT_V(2); PG8_BAR;
        PG8_STAGE(PG8_SB(1, 0), cB + kstep, voffB); PG8_STAGE(PG8_SA(1, 0), cA + kstep, voffA); PG8_STAGE(PG8_SB(1, 1), cB + hstep + kstep, voffB);
        PG8_WAIT_V(6); PG8_BAR;
    } else {
        PG8_STAGE(PG8_SB(0, 0), cB, voffB); PG8_STAGE(PG8_SA(0, 0), cA, voffA); PG8_STAGE(PG8_SB(0, 1), cB + hstep, voffB); PG8_STAGE(PG8_SA(0, 1), cA + hstep, voffA);
        if (wr == 1) PG8_BAR;
        PG8_WAIT_V(4); PG8_BAR;
        PG8_STAGE(PG8_SB(1, 0), cB + kstep, voffB); PG8_STAGE(PG8_SA(1, 0), cA + kstep, voffA); PG8_STAGE(PG8_SB(1, 1), cB + hstep + kstep, voffB);
        PG8_WAIT_V(6); PG8_BAR;
    }
    for (;;) {
        const bool has_next = S.next(ui + 1, nxt);
        const char* nA = has_next ? (const char*)g.A + (size_t)nxt.pm * tstep : cA; const char* nB = has_next ? (const char*)g.Bt + (size_t)nxt.pn * tstep : cB;
        for (int t = 0; t < nt; t += 2) {
            const bool last = (t == nt - 2);
            const char* a1 = cA + (size_t)(t + 1) * kstep;
            const char* a2 = last ? nA : cA + (size_t)(t + 2) * kstep; const char* b2 = last ? nB : cB + (size_t)(t + 2) * kstep;
            const char* a3 = a2 + kstep; const char* b3 = b2 + kstep;
            if (last && has_next) S.a_ready(nxt);
            if constexpr (SP2) {
            PG8_LDB(B0, 0, 0); PG8_LDB(B1, 0, 1); PG8_SCHED; PG8_LDA(At, 0, 0); PG8_STAGE(PG8_SA(1, 1), a1 + hstep, voffA);
            PG8_WAIT_V(8); PG8_WAIT_L(0); PG8_BAR; PG8_MMA(0, 0, At, B0); PG8_MMA(0, 1, At, B1); PG8_BAR; PG8_SCHED;
            PG8_LDA(At, 0, 1); PG8_STAGE(PG8_SB(0, 0), b2, voffB); PG8_STAGE(PG8_SB(0, 1), b2 + hstep, voffB); PG8_STAGE(PG8_SA(0, 0), a2, voffA);
            PG8_WAIT_V(8); PG8_WAIT_L(0); PG8_BAR; PG8_MMA(1, 0, At, B0); PG8_MMA(1, 1, At, B1); PG8_BAR; PG8_SCHED;
            PG8_LDB(B0, 1, 0); PG8_LDB(B1, 1, 1); PG8_SCHED; PG8_LDA(At, 1, 0); PG8_STAGE(PG8_SA(0, 1), a2 + hstep, voffA);
            PG8_WAIT_V(8); PG8_WAIT_L(0); PG8_BAR; PG8_MMA(0, 0, At, B0); PG8_MMA(0, 1, At, B1); PG8_BAR; PG8_SCHED;
            PG8_LDA(At, 1, 1); PG8_STAGE(PG8_SB(1, 0), b3, voffB); PG8_STAGE(PG8_SB(1, 1), b3 + hstep, voffB); PG8_STAGE(PG8_SA(1, 0), a3, voffA);
            PG8_WAIT_V(8); PG8_WAIT_L(0); PG8_BAR; PG8_MMA(1, 0, At, B0); PG8_MMA(1, 1, At, B1); PG8_BAR; PG8_SCHED;
            } else {
            PG8_LDB(B0, 0, 0); PG8_SCHED; PG8_LDA(At, 0, 0); PG8_STAGE(PG8_SA(1, 1), a1 + hstep, voffA);
            PG8_WAIT_L(8); PG8_BAR; PG8_WAIT_L(0); PG8_MMA(0, 0, At, B0); PG8_BAR; PG8_SCHED;
            PG8_LDB(B1, 0, 1); PG8_STAGE(PG8_SB(0, 0), b2, voffB);
            PG8_BAR; PG8_WAIT_L(0); PG8_MMA(0, 1, At, B1); PG8_BAR;
            PG8_LDA(At, 0, 1); PG8_STAGE(PG8_SA(0, 0), a2, voffA);
            PG8_BAR; PG8_WAIT_L(0); PG8_MMA(1, 0, At, B0); PG8_BAR; PG8_SCHED;
            PG8_STAGE(PG8_SB(0, 1), b2 + hstep, voffB);
            PG8_WAIT_V(6); PG8_BAR; PG8_MMA(1, 1, At, B1); PG8_BAR;
            PG8_LDB(B0, 1, 0); PG8_SCHED; PG8_LDA(At, 1, 0); PG8_STAGE(PG8_SA(0, 1), a2 + hstep, voffA);
            PG8_WAIT_L(8); PG8_BAR; PG8_WAIT_L(0); PG8_MMA(0, 0, At, B0); PG8_BAR; PG8_SCHED;
            PG8_LDB(B1, 1, 1); PG8_STAGE(PG8_SB(1, 0), b3, voffB);
            PG8_BAR; PG8_WAIT_L(0); PG8_MMA(0, 1, At, B1); PG8_BAR;
            PG8_LDA(At, 1, 1); PG8_STAGE(PG8_SA(1, 0), a3, voffA);
            PG8_BAR; PG8_WAIT_L(0); PG8_MMA(1, 0, At, B0); PG8_BAR; PG8_SCHED;
            PG8_STAGE(PG8_SB(1, 1), b3 + hstep, voffB);
            PG8_WAIT_V(6); PG8_BAR; PG8_MMA(1, 1, At, B1); PG8_BAR;
            }
        }
        if constexpr (ALIGN_EPI) { if (wr == 0) PG8_BAR; }
        if constexpr (!Epi::AFTER_DRAIN) { E(acc, cur, wr, wc, fr, fq); S.done(cur); }
        if (!has_next) break;
#pragma unroll
        for (int a = 0; a < 2; ++a)
#pragma unroll
            for (int b = 0; b < 2; ++b)
#pragma unroll
                for (int m = 0; m < 4; ++m)
#pragma unroll
                    for (int n = 0; n < 2; ++n) acc[a][b][m][n] = (f32x4){0.f, 0.f, 0.f, 0.f};
        cur = nxt; cA = nA; cB = nB; ++ui;
        if constexpr (ALIGN_EPI) { if (wr == 1) PG8_BAR; }
    }
    PG8_WAIT_V(0);
    if constexpr (!ALIGN_EPI) { if (wr == 0) PG8_BAR; }
    PG8_BAR;
    if constexpr (Epi::AFTER_DRAIN) { E.fused(acc, cur, wr, wc, fr, fq, lds, wid, lane); S.done(cur); }
#undef PG8_SA
#undef PG8_SB
#undef PG8_STAGE
#undef PG8_LDA
#undef PG8_LDB
#undef PG8_MMA
#undef PG8_WAIT_V
#undef PG8_WAIT_L
#undef PG8_BAR
#undef PG8_SCHED
}
}

#define LAS __attribute__((address_space(3)))
typedef unsigned short bf16_t;
typedef short bf16x8 __attribute__((ext_vector_type(8)));
typedef float f32x4 __attribute__((ext_vector_type(4)));
typedef float f32x16 __attribute__((ext_vector_type(16)));
typedef unsigned u32x4 __attribute__((ext_vector_type(4)));
typedef unsigned u32x2 __attribute__((ext_vector_type(2)));
#define MFMA32(a, b, c) __builtin_amdgcn_mfma_f32_32x32x16_bf16((a), (b), (c), 0, 0, 0)

constexpr int DM = 1024, SEQ = 8192, LCTX = 256, ML = 2 * SEQ, MC = 2 * LCTX, MT = ML + MC;
constexpr int PW = 2560, FF = 2816, INW = 2304, KVT = SEQ + LCTX, NCH = 66;
constexpr int C_QA = 0, C_KA = 256, C_VA = 384, C_QB = 512, C_KB = 768, C_VB = 896, C_FR = 1024, C_FI = 1280, C_RQ = 1536, C_RK = 1792, C_RV = 2048, C_RG = 2304;
constexpr float LN_EPS = 1e-6f, ALPHA = 1.4142135623730951f, LOG2E = 1.4426950408889634f, QSCALE = 0.125f * 1.4426950408889634f;
constexpr size_t KiB = 1024, MiB = 1024 * 1024;
constexpr size_t OFF_MOD = 0, OFF_ROPEG = 256 * KiB, OFF_TW = 320 * KiB, OFF_F128R = 384 * KiB, OFF_F128I = 416 * KiB, OFF_C64 = 448 * KiB, OFF_S64 = 456 * KiB,
                 OFF_C256 = 512 * KiB, OFF_S256 = 640 * KiB, OFF_ROPES = 1 * MiB, OFF_XC = 3 * MiB,
                 OFF_WIN = 5 * MiB, OFF_WOUT = 10 * MiB, OFF_WGU = 12 * MiB, OFF_WDN = 23 * MiB, OFF_H = 29 * MiB, OFF_P = 62 * MiB,
                 OFF_MIX = 153 * MiB, OFF_VAT = 186 * MiB, OFF_VBT = 191 * MiB, OFF_TB = 196 * MiB, OFF_SLOC = 212 * MiB, OFF_ST = 229 * MiB,
                 OFF_Y2 = 196 * MiB, WS_NEED = 238 * MiB;
constexpr int LDS_BYTES = 147456;
constexpr size_t OFF_BAR = 208 * KiB;
#define RLX_AGENT __ATOMIC_RELAXED, __HIP_MEMORY_SCOPE_AGENT

struct Params { const float* in[20]; float* out; unsigned char* ws; int n_steps, pad; };

__device__ __forceinline__ unsigned f2bf(float f) { unsigned u = __builtin_bit_cast(unsigned, f); return (u + 0x7fffu + ((u >> 16) & 1u)) >> 16; }
typedef float f32x2_t __attribute__((ext_vector_type(2))); typedef __bf16 bf16x2_t __attribute__((ext_vector_type(2)));
__device__ __forceinline__ unsigned pk2(float lo, float hi) { f32x2_t v = {lo, hi}; bf16x2_t b = __builtin_convertvector(v, bf16x2_t); return __builtin_bit_cast(unsigned, b); }
__device__ __forceinline__ float xhalf_max(float v) { auto rr = __builtin_amdgcn_permlane32_swap(__float_as_uint(v), __float_as_uint(v), false, false); return fmaxf(__uint_as_float(rr[0]), __uint_as_float(rr[1])); }
__device__ __forceinline__ float xhalf_sum(float v) { auto rr = __builtin_amdgcn_permlane32_swap(__float_as_uint(v), __float_as_uint(v), false, false); return __uint_as_float(rr[0]) + __uint_as_float(rr[1]); }
__device__ __forceinline__ float bflo(unsigned w) { return __builtin_bit_cast(float, w << 16); }
__device__ __forceinline__ float bfhi(unsigned w) { return __builtin_bit_cast(float, w & 0xffff0000u); }
__device__ __forceinline__ float bf2f(bf16_t h) { return __builtin_bit_cast(float, (unsigned)h << 16); }
__device__ __forceinline__ int crow(int r, int hi) { return (r & 3) + 8 * (r >> 2) + 4 * hi; }
__device__ __forceinline__ float wave_sum(float v) {
#pragma unroll
    for (int o = 1; o < 64; o <<= 1) v += __shfl_xor(v, o);
    return v;
}
__device__ __forceinline__ bf16x8 pack8(float a0, float a1, float a2, float a3, float a4, float a5, float a6, float a7) {
    u32x4 p; p.x = pk2(a0, a1); p.y = pk2(a2, a3); p.z = pk2(a4, a5); p.w = pk2(a6, a7); return __builtin_bit_cast(bf16x8, p);
}
__device__ __forceinline__ bf16x8 join8(u32x2 lo, u32x2 hi) { u32x4 p; p.x = lo.x; p.y = lo.y; p.z = hi.x; p.w = hi.y; return __builtin_bit_cast(bf16x8, p); }
__device__ __forceinline__ void sincos_red(float ang, float& c, float& s) {
    const double a = (double)ang; const double k = rint(a * 0.15915494309189535); const float r = (float)(a - k * 6.283185307179586);
    c = cosf(r); s = sinf(r);
}
__device__ __forceinline__ float logsig(float x) { return -log1pf(expf(-x)); }
#define LDSW() asm volatile("s_waitcnt lgkmcnt(0)" ::: "memory")

__device__ __forceinline__ void ph_tables(unsigned char* ws, int gtid, int NT) {
    float2* ropeg = (float2*)(ws + OFF_ROPEG);
    for (int i = gtid; i < 128 * 16; i += NT) { const int p = i >> 4, f = i & 15; const float inv = exp2f(-(float)f * (13.287712379549449f / 16.f)); float c, s; sincos_red((float)p * inv, c, s); ropeg[i] = make_float2(c, s); }
    float2* ropes = (float2*)(ws + OFF_ROPES);
    for (int i = gtid; i < SEQ * 32; i += NT) { const int p = i >> 5, f = i & 31; const float inv = exp2f(-(float)f * (13.287712379549449f / 32.f)); float c, s; sincos_red((float)p * inv, c, s); ropes[i] = make_float2(c, s); }
    float2* tw = (float2*)(ws + OFF_TW);
    for (int i = gtid; i < 8192; i += NT) { const float a = (float)i * (1.0f / 4096.0f); tw[i] = make_float2(cospif(a), sinpif(a)); }
    bf16_t* f128r = (bf16_t*)(ws + OFF_F128R); bf16_t* f128i = (bf16_t*)(ws + OFF_F128I);
    for (int i = gtid; i < 128 * 128; i += NT) { const int m = ((i >> 7) * (i & 127)) & 127; const float a = (float)m * (1.0f / 64.0f); f128r[i] = (bf16_t)f2bf(cospif(a)); f128i[i] = (bf16_t)f2bf(-sinpif(a)); }
    bf16_t* c64 = (bf16_t*)(ws + OFF_C64); bf16_t* s64 = (bf16_t*)(ws + OFF_S64);
    for (int i = gtid; i < 64 * 64; i += NT) { const int m = ((i >> 6) * (i & 63)) & 63; const float a = (float)m * (1.0f / 32.0f); c64[i] = (bf16_t)f2bf(cospif(a)); s64[i] = (bf16_t)f2bf(sinpif(a)); }
    bf16_t* c256 = (bf16_t*)(ws + OFF_C256); bf16_t* s256 = (bf16_t*)(ws + OFF_S256);
    for (int i = gtid; i < 256 * 256; i += NT) { const int m = ((i >> 8) * (i & 255)) & 255; const float a = (float)m * (1.0f / 128.0f); c256[i] = (bf16_t)f2bf(cospif(a)); s256[i] = (bf16_t)f2bf(sinpif(a)); }
}

__device__ __forceinline__ void ph_mod(const float* c, const float* c_ctx, const float* w_mod, const float* b_mod, float* modv, unsigned char* lds, int tid, int bid, int G) {
    float* sc = (float*)lds; float* part = sc + 3 * 1024;
    if (bid >= 48 && G >= 48) return;
    for (int i = tid; i < 3072; i += 512) { const int v = i >> 10, k = i & 1023; const float cv = v < 2 ? c[v * 1024 + k] : c_ctx[k]; sc[i] = cv / (1.0f + expf(-cv)); }
    __syncthreads();
    for (int u = bid; u < 48; u += (G >= 48 ? 48 : G)) {
        const int layer = u / 24, cgp = u % 24, cq = tid & 63, kg = tid >> 6;
        const float* w = w_mod + (size_t)layer * 1024 * 6144 + cgp * 256 + 4 * cq;
        f32x4 a0 = {0.f, 0.f, 0.f, 0.f}, a1 = a0, a2 = a0;
        for (int k0 = kg * 128; k0 < kg * 128 + 128; k0 += 16) {
            f32x4 wv[16];
#pragma unroll
            for (int e = 0; e < 16; ++e) wv[e] = *(const f32x4*)(w + (size_t)(k0 + e) * 6144);
#pragma unroll
            for (int e = 0; e < 16; ++e) { a0 += wv[e] * sc[k0 + e]; a1 += wv[e] * sc[1024 + k0 + e]; a2 += wv[e] * sc[2048 + k0 + e]; }
        }
        *(f32x4*)(part + (kg * 3 + 0) * 256 + 4 * cq) = a0; *(f32x4*)(part + (kg * 3 + 1) * 256 + 4 * cq) = a1; *(f32x4*)(part + (kg * 3 + 2) * 256 + 4 * cq) = a2;
        __syncthreads();
        for (int t = tid; t < 768; t += 512) { const int v = t >> 8, cc = t & 255; float s = 0.f;
#pragma unroll
            for (int k2 = 0; k2 < 8; ++k2) s += part[(k2 * 3 + v) * 256 + cc];
            modv[(layer * 3 + v) * 6144 + cgp * 256 + cc] = s + b_mod[layer * 6144 + cgp * 256 + cc]; }
        __syncthreads();
    }
}

__device__ __forceinline__ void transpose_item(const float* W, int ldw, int k0, int nsrc0, bf16_t* WT, int K, int drow0, float* scr, int lane) {
    f32x4 wv[8];
#pragma unroll
    for (int i = 0; i < 8; ++i) wv[i] = *(const f32x4*)(W + (size_t)(k0 + (lane >> 3) + 8 * i) * ldw + nsrc0 + 4 * (lane & 7));
#pragma unroll
    for (int i = 0; i < 8; ++i) { float* d = scr + ((lane >> 3) + 8 * i) * 33 + 4 * (lane & 7); d[0] = wv[i].x; d[1] = wv[i].y; d[2] = wv[i].z; d[3] = wv[i].w; }
    LDSW();
    const int c = lane & 7;
#pragma unroll
    for (int j = 0; j < 4; ++j) { const int n = (lane >> 3) + 8 * j; const float* s = scr + (8 * c) * 33 + n;
        u32x4 o; o.x = pk2(s[0 * 33], s[1 * 33]); o.y = pk2(s[2 * 33], s[3 * 33]); o.z = pk2(s[4 * 33], s[5 * 33]); o.w = pk2(s[6 * 33], s[7 * 33]);
        *(u32x4*)(WT + (size_t)(drow0 + n) * K + k0 + 8 * c) = o; }
    LDSW();
}

__device__ __forceinline__ void ph_weights(const Params& p, int layer, unsigned char* lds, int tid, int bid_in, int G_in, int skip = 0) {
    if (G_in < 2 * skip) skip = 0;
    if (bid_in < skip) return;
    const int bid = bid_in - skip, G = G_in - skip;
    unsigned char* ws = p.ws;
    const float* w_in = p.in[6] + (size_t)layer * DM * INW; const float* fmix = p.in[10] + (size_t)layer * 4 * 64 * 64;
    const float* w_out = p.in[13] + (size_t)layer * DM * DM; const float* w_gu = p.in[16] + (size_t)layer * DM * 2 * FF; const float* w_dn = p.in[17] + (size_t)layer * FF * DM;
    bf16_t* Win = (bf16_t*)(ws + OFF_WIN); bf16_t* Wout = (bf16_t*)(ws + OFF_WOUT); bf16_t* Wgu = (bf16_t*)(ws + OFF_WGU); bf16_t* Wdn = (bf16_t*)(ws + OFF_WDN);
    const int lane = tid & 63, wave = tid >> 6;
    float* Gm = (float*)lds; float* wt = Gm + 4096; float* trig = wt + 64 * 65;
    if (bid < 128) { if (tid < 128) { const float a = (float)(tid & 63) * (1.0f / 32.0f); trig[tid] = tid < 64 ? cospif(a) : -sinpif(a); } __syncthreads(); }
    for (int u = bid; u < 128; u += G) {
        const int kb = u >> 3, g = (u >> 1) & 3, ri = u & 1;
        { const int ci = tid >> 3, e0 = (tid & 7) * 8; float acc[8];
#pragma unroll
          for (int e = 0; e < 8; ++e) acc[e] = 0.f;
          for (int cp = 0; cp < 64; ++cp) { const int m = (ci * cp) & 63; const float tr = trig[64 * ri + m];
              const float* fr = fmix + ((g * 64 + cp) * 64 + e0);
#pragma unroll
              for (int e = 0; e < 8; ++e) acc[e] += tr * fr[e]; }
#pragma unroll
          for (int e = 0; e < 8; ++e) Gm[ci * 64 + e0 + e] = acc[e] * 0.125f; }
        for (int i = tid; i < 4096; i += 512) { const int kk = i >> 6, cc = i & 63; wt[kk * 65 + cc] = w_in[(size_t)(kb * 64 + kk) * INW + 1024 + 64 * g + cc]; }
        __syncthreads();
        { const int e = tid & 63, kk0 = (tid >> 6) * 8; float acc[8];
#pragma unroll
          for (int q = 0; q < 8; ++q) acc[q] = 0.f;
          for (int cc = 0; cc < 64; ++cc) { const float gv = Gm[cc * 64 + e];
#pragma unroll
              for (int q = 0; q < 8; ++q) acc[q] += wt[(kk0 + q) * 65 + cc] * gv; }
          u32x4 o; o.x = pk2(acc[0], acc[1]); o.y = pk2(acc[2], acc[3]); o.z = pk2(acc[4], acc[5]); o.w = pk2(acc[6], acc[7]);
          *(u32x4*)(Win + (size_t)(1024 + ri * 256 + g * 64 + e) * DM + kb * 64 + kk0) = o; }
        __syncthreads();
    }
    float* scr = (float*)lds + wave * 2176;
    const int gw = bid * 8 + wave, NGW = G * 8;
    for (int it = gw; it < 5760; it += NGW) {
        int r = it;
        if (r < 512) { transpose_item(w_in, INW, 64 * (r >> 5), 32 * (r & 31), Win, DM, 32 * (r & 31), scr, lane); continue; } r -= 512;
        if (r < 512) { transpose_item(w_in, INW, 64 * (r >> 5), 1280 + 32 * (r & 31), Win, DM, 1536 + 32 * (r & 31), scr, lane); continue; } r -= 512;
        if (r < 512) { transpose_item(w_out, DM, 64 * (r >> 5), 32 * (r & 31), Wout, DM, 32 * (r & 31), scr, lane); continue; } r -= 512;
        if (r < 2816) { const int kb = r / 176, n0 = 32 * (r % 176); const int bj = n0 / FF, rr = n0 % FF; const int drow = (rr >> 7) * 256 + bj * 128 + (rr & 127);
            transpose_item(w_gu, 2 * FF, 64 * kb, n0, Wgu, DM, drow, scr, lane); continue; } r -= 2816;
        transpose_item(w_dn, DM, 64 * (r >> 5), 32 * (r & 31), Wdn, FF, 32 * (r & 31), scr, lane);
    }
}

__device__ __forceinline__ void ln_stats(const f32x4 (&v)[4], float& mean, float& rstd) {
    float s = 0.f;
#pragma unroll
    for (int j = 0; j < 4; ++j) s += (v[j].x + v[j].y) + (v[j].z + v[j].w);
    mean = wave_sum(s) * (1.0f / DM); float q = 0.f;
#pragma unroll
    for (int j = 0; j < 4; ++j) { const f32x4 d = v[j] - mean; q += (d.x * d.x + d.y * d.y) + (d.z * d.z + d.w * d.w); }
    rstd = rsqrtf(wave_sum(q) * (1.0f / DM) + LN_EPS);
}
__device__ __forceinline__ void store_h(bf16_t* hrow, const f32x4 (&v)[4], float mean, float rstd, const float* sh, const float* scl, int lane) {
#pragma unroll
    for (int j = 0; j < 4; ++j) { const int col = 4 * lane + 256 * j; const f32x4 s = *(const f32x4*)(scl + col), t = *(const f32x4*)(sh + col);
        const f32x4 y = (v[j] - mean) * rstd * (s + 1.0f) + t; u32x2 w; w.x = pk2(y.x, y.y); w.y = pk2(y.z, y.w); *(u32x2*)(hrow + col) = w; }
}
__device__ __forceinline__ void ph_h0(const Params& p, int gw, int NGW, int lane) {
    const float* modv = (const float*)(p.ws + OFF_MOD); bf16_t* H = (bf16_t*)(p.ws + OFF_H);
    f32x4 xn[4];
    if (gw < MT) { const float* src = gw < ML ? p.in[0] + (size_t)gw * DM : p.in[2] + (size_t)(gw - ML) * DM;
#pragma unroll
        for (int j = 0; j < 4; ++j) xn[j] = *(const f32x4*)(src + 4 * lane + 256 * j); }
    for (int row = gw; row < MT; row += NGW) {
        const float* mod = modv + (size_t)(row < ML ? (row >> 13) : 2) * 6144;
        f32x4 v[4], sv[4], tv[4];
#pragma unroll
        for (int j = 0; j < 4; ++j) { v[j] = xn[j]; sv[j] = *(const f32x4*)(mod + 1024 + 4 * lane + 256 * j); tv[j] = *(const f32x4*)(mod + 4 * lane + 256 * j); }
        const int nrow = row + NGW;
        if (nrow < MT) { const float* src = nrow < ML ? p.in[0] + (size_t)nrow * DM : p.in[2] + (size_t)(nrow - ML) * DM;
#pragma unroll
            for (int j = 0; j < 4; ++j) xn[j] = *(const f32x4*)(src + 4 * lane + 256 * j); }
        float mean, rstd; ln_stats(v, mean, rstd);
        bf16_t* hrow = H + (size_t)row * DM;
#pragma unroll
        for (int j = 0; j < 4; ++j) { const f32x4 y = (v[j] - mean) * rstd * (sv[j] + 1.0f) + tv[j]; u32x2 w; w.x = pk2(y.x, y.y); w.y = pk2(y.z, y.w); *(u32x2*)(hrow + 4 * lane + 256 * j) = w; }
    }
}
__device__ __forceinline__ void ph_rowpass(const Params& p, int layer, int which, int mrows, bool do_h, int gw, int NGW, int lane) {
    const float* modv = (const float*)(p.ws + OFF_MOD); bf16_t* H = (bf16_t*)(p.ws + OFF_H);
    const bf16_t* Y = (const bf16_t*)(p.ws + (which == 0 ? OFF_P : OFF_Y2));
    const float* lw = p.in[which == 0 ? 14 : 18] + layer * DM; const float* lb = p.in[which == 0 ? 15 : 19] + layer * DM;
    float* xc = (float*)(p.ws + OFF_XC);
    const bool from_in = (layer == 0 && which == 0);
    f32x4 lwv[4], lbv[4], xn[4]; u32x2 yn[4];
#pragma unroll
    for (int j = 0; j < 4; ++j) { lwv[j] = *(const f32x4*)(lw + 4 * lane + 256 * j); lbv[j] = *(const f32x4*)(lb + 4 * lane + 256 * j); }
#define RP_SRC(r) (from_in ? ((r) < ML ? p.in[0] + (size_t)(r) * DM : p.in[2] + (size_t)((r) - ML) * DM) : ((r) < ML ? (const float*)p.out + (size_t)(r) * DM : (const float*)xc + (size_t)((r) - ML) * DM))
    if (gw < mrows) { const float* src = RP_SRC(gw);
#pragma unroll
        for (int j = 0; j < 4; ++j) { xn[j] = *(const f32x4*)(src + 4 * lane + 256 * j); yn[j] = *(const u32x2*)(Y + (size_t)gw * DM + 4 * lane + 256 * j); } }
    for (int row = gw; row < mrows; row += NGW) {
        float* xs = row < ML ? p.out + (size_t)row * DM : xc + (size_t)(row - ML) * DM;
        const int vi = row < ML ? (row >> 13) : 2;
        const float* mod = modv + (size_t)(layer * 3 + vi) * 6144;
        const float* gate = mod + (which == 0 ? 2048 : 5120);
        const float* mod2 = which == 0 ? mod + 3072 : modv + (size_t)((layer + 1) * 3 + vi) * 6144;
        f32x4 v[4], sv[4], tv[4];
#pragma unroll
        for (int j = 0; j < 4; ++j) { const int col = 4 * lane + 256 * j; const f32x4 g = *(const f32x4*)(gate + col);
            f32x4 y; y.x = bflo(yn[j].x); y.y = bfhi(yn[j].x); y.z = bflo(yn[j].y); y.w = bfhi(yn[j].y);
            v[j] = xn[j] * ALPHA + g * y;
            if (do_h) { sv[j] = *(const f32x4*)(mod2 + 1024 + col); tv[j] = *(const f32x4*)(mod2 + col); } }
        const int nrow = row + NGW;
        if (nrow < mrows) { const float* src = RP_SRC(nrow);
#pragma unroll
            for (int j = 0; j < 4; ++j) { xn[j] = *(const f32x4*)(src + 4 * lane + 256 * j); yn[j] = *(const u32x2*)(Y + (size_t)nrow * DM + 4 * lane + 256 * j); } }
        float mean, rstd; ln_stats(v, mean, rstd);
#pragma unroll
        for (int j = 0; j < 4; ++j) { const int col = 4 * lane + 256 * j; v[j] = (v[j] - mean) * rstd * lwv[j] + lbv[j];
#ifdef SELFCHECK
            if (layer == 1 && which == 1) { const unsigned fl = *(const unsigned*)(p.ws + 200 * 1024); v[j] = v[j] * (1.0f + 0.1f * (float)(fl & 15u)); }
#endif
            *(f32x4*)(xs + col) = v[j]; }
        if (do_h) {
            ln_stats(v, mean, rstd);
            bf16_t* hrow = H + (size_t)row * DM;
#pragma unroll
            for (int j = 0; j < 4; ++j) { const f32x4 y = (v[j] - mean) * rstd * (sv[j] + 1.0f) + tv[j]; u32x2 w; w.x = pk2(y.x, y.y); w.y = pk2(y.z, y.w); *(u32x2*)(hrow + 4 * lane + 256 * j) = w; }
        }
    }
#undef RP_SRC
}
#define XB_TMO      128
#define XB_XCNT(j)  (256  + 64 * (j))
#define XB_XSUB(j)  (1280 + 64 * (j))
#define XB_XGEN(j)  (2304 + 64 * (j))
#define XB_TOP      3328
#define XB_TOPGEN   3392
#define XCD_BAR_WORDS 3456
#define XB_SPIN_CAP (1u << 18)

__device__ __forceinline__ unsigned xb_ld(unsigned* p)              { return __hip_atomic_load(p, __ATOMIC_RELAXED, __HIP_MEMORY_SCOPE_AGENT); }
__device__ __forceinline__ unsigned xb_add(unsigned* p, unsigned v) { return __hip_atomic_fetch_add(p, v, __ATOMIC_RELAXED, __HIP_MEMORY_SCOPE_AGENT); }
__device__ __forceinline__ unsigned xb_xcc_id() { return (unsigned)__builtin_amdgcn_s_getreg((3 << 11) | 20) & 0xFu; }
#define XB_SPIN(cond, bar) do { unsigned _sp = 0; while (cond) { __builtin_amdgcn_s_sleep(1); \
    if ((++_sp & 255u) == 0u) { if (xb_ld(&(bar)[XB_TMO])) break; if (_sp > XB_SPIN_CAP) { atomicAdd(&(bar)[XB_TMO], 1u); break; } } } } while (0)

struct XcdBarrier {
    unsigned* bar; unsigned x;
    volatile LAS unsigned* st;
};

__device__ __forceinline__ XcdBarrier xcd_barrier_post(unsigned* bar, volatile LAS unsigned* st) {
    XcdBarrier b; b.bar = bar; b.x = xb_xcc_id(); b.st = st;
    if (threadIdx.x == 0) (void)xb_add(&bar[XB_XCNT(b.x)], 1u);
    return b;
}
__device__ __forceinline__ void xcd_barrier_complete(unsigned* bar, unsigned x, unsigned& nloc, unsigned& nx) {
    const unsigned G = gridDim.x * gridDim.y * gridDim.z;
    unsigned sum, cnt, mine, sp = 0u;
    for (;;) {
        sum = 0u; cnt = 0u; mine = 0u;
#pragma unroll
        for (unsigned j = 0; j < 16; ++j) { const unsigned c = xb_ld(&bar[XB_XCNT(j)]); sum += c; cnt += (c > 0u) ? 1u : 0u; mine = (j == x) ? c : mine; }
        if (sum == G) break;
        __builtin_amdgcn_s_sleep(1);
        if ((++sp & 255u) == 0u) { if (xb_ld(&bar[XB_TMO])) break; if (sp > XB_SPIN_CAP) { atomicAdd(&bar[XB_TMO], 1u); break; } }
    }
    nloc = mine > 0u ? mine : 1u; nx = cnt > 0u ? cnt : 1u;
}

__device__ __forceinline__ void xcd_barrier(const XcdBarrier& b) {
    asm volatile("s_waitcnt vmcnt(0)" ::: "memory");
    __syncthreads();
    if (threadIdx.x == 0) {
        unsigned* bar = b.bar;
        __builtin_amdgcn_s_waitcnt(0);
        unsigned nloc = b.st[0], nx = b.st[1];
        if (nloc == 0u) { xcd_barrier_complete(bar, b.x, nloc, nx); b.st[0] = nloc; b.st[1] = nx; }
        const unsigned old = xb_add(&bar[XB_XSUB(b.x)], 1u);
        const unsigned gen = old / nloc;
        if (old + 1u == (gen + 1u) * nloc) {
            __builtin_amdgcn_fence(__ATOMIC_RELEASE, "agent");
            asm volatile("s_waitcnt vmcnt(0)" ::: "memory");
            const unsigned og = xb_add(&bar[XB_TOP], 1u);
            const unsigned tg = og / nx;
            if (og + 1u == (tg + 1u) * nx) xb_add(&bar[XB_TOPGEN], 1u);
            else XB_SPIN(xb_ld(&bar[XB_TOPGEN]) == tg, bar);
            __builtin_amdgcn_fence(__ATOMIC_ACQUIRE, "agent");
            xb_add(&bar[XB_XGEN(b.x)], 1u);
            asm volatile("s_waitcnt vmcnt(0)" ::: "memory");
        } else {
            XB_SPIN(xb_ld(&bar[XB_XGEN(b.x)]) == gen, bar);
            __builtin_amdgcn_fence(__ATOMIC_ACQUIRE, "agent");
            asm volatile("s_waitcnt vmcnt(0)" ::: "memory");
        }
    }
    __syncthreads();
}

__device__ __forceinline__ void ph_prep(const Params& p, int layer, unsigned char* lds, int gw, int NGW, int lane, int wave) {
    bf16_t* P = (bf16_t*)(p.ws + OFF_P); const float2* ropeg = (const float2*)(p.ws + OFF_ROPEG);
    const float* aqn = p.in[7] + layer * 64; const float* akn = p.in[8] + layer * 64;
    for (int it = gw; it < (MT * 12) / 64; it += NGW) {
        const int item = it * 64 + lane; const int row = item / 12, s = item % 12;
        int col; bool isq, norm; const float* nw = aqn;
        if (s < 4) { col = C_QA + 64 * s; isq = true; norm = true; }
        else if (s < 6) { col = C_KA + 64 * (s - 4); isq = false; norm = true; nw = akn; }
        else if (s < 10) { col = C_QB + 64 * (s - 6); isq = true; norm = false; }
        else { col = C_KB + 64 * (s - 10); isq = false; norm = false; }
        bf16_t* ptr = P + (size_t)row * PW + col;
        u32x4 w[8];
#pragma unroll
        for (int q = 0; q < 8; ++q) w[q] = *(const u32x4*)(ptr + 8 * q);
        float x[64];
#pragma unroll
        for (int q = 0; q < 8; ++q) { x[8 * q + 0] = bflo(w[q].x); x[8 * q + 1] = bfhi(w[q].x); x[8 * q + 2] = bflo(w[q].y); x[8 * q + 3] = bfhi(w[q].y);
            x[8 * q + 4] = bflo(w[q].z); x[8 * q + 5] = bfhi(w[q].z); x[8 * q + 6] = bflo(w[q].w); x[8 * q + 7] = bfhi(w[q].w); }
        if (norm) { float ss = 0.f;
#pragma unroll
            for (int e = 0; e < 64; ++e) ss += x[e] * x[e];
            const float r = rsqrtf(ss * (1.0f / 64.0f) + LN_EPS);
#pragma unroll
            for (int e = 0; e < 64; ++e) x[e] *= r * nw[e]; }
        if (row < ML) { const int t = row & (SEQ - 1); const float2* ra = ropeg + (t >> 6) * 16; const float2* rb = ropeg + (t & 63) * 16;
#pragma unroll
            for (int e = 0; e < 16; ++e) { const float2 a = ra[e], bq = rb[e];
                const float y0 = x[e] * a.x - x[16 + e] * a.y, y1 = x[16 + e] * a.x + x[e] * a.y, y2 = x[32 + e] * bq.x - x[48 + e] * bq.y, y3 = x[48 + e] * bq.x + x[32 + e] * bq.y;
                x[e] = y0; x[16 + e] = y1; x[32 + e] = y2; x[48 + e] = y3; } }
        const float qs = isq ? QSCALE : 1.0f;
#pragma unroll
        for (int q = 0; q < 8; ++q) { u32x4 o; o.x = pk2(x[8 * q] * qs, x[8 * q + 1] * qs); o.y = pk2(x[8 * q + 2] * qs, x[8 * q + 3] * qs); o.z = pk2(x[8 * q + 4] * qs, x[8 * q + 5] * qs); o.w = pk2(x[8 * q + 6] * qs, x[8 * q + 7] * qs);
            *(u32x4*)(ptr + 8 * q) = o; }
    }
    bf16_t* scr = (bf16_t*)lds + wave * 4608;
    for (int u = gw; u < 1056; u += NGW) {
        const int tile = u % 132, r = u / 132; const int kvh = r & 1, b = (r >> 1) & 1, which = r >> 2;
        const int row = tile < 128 ? b * SEQ + tile * 64 + lane : ML + b * LCTX + (tile - 128) * 64 + lane;
        const bf16_t* src = P + (size_t)row * PW + (which ? C_VB : C_VA) + 64 * kvh;
#pragma unroll
        for (int q = 0; q < 8; ++q) *(u32x4*)(scr + lane * 72 + 8 * q) = *(const u32x4*)(src + 8 * q);
        LDSW();
        bf16_t* dst = (bf16_t*)(p.ws + (which ? OFF_VBT : OFF_VAT)) + (size_t)((b * 2 + kvh) * 64 + lane) * KVT + tile * 64;
#pragma unroll
        for (int q = 0; q < 8; ++q) { u32x4 o;
            const int t0 = 16 * (q >> 1) + 4 * (q & 1), t1 = t0 + 8;
            o.x = (unsigned)scr[(t0 + 0) * 72 + lane] | ((unsigned)scr[(t0 + 1) * 72 + lane] << 16); o.y = (unsigned)scr[(t0 + 2) * 72 + lane] | ((unsigned)scr[(t0 + 3) * 72 + lane] << 16);
            o.z = (unsigned)scr[(t1 + 0) * 72 + lane] | ((unsigned)scr[(t1 + 1) * 72 + lane] << 16); o.w = (unsigned)scr[(t1 + 2) * 72 + lane] | ((unsigned)scr[(t1 + 3) * 72 + lane] << 16);
            *(u32x4*)(dst + 8 * q) = o; }
        LDSW();
    }
}

__device__ __forceinline__ int ret_row(int b, int j, int s) { return j < 2 ? ML + b * LCTX + j * 128 + s : b * SEQ + (j - 2) * 128 + s; }
__device__ __forceinline__ void ret_load_rot(const bf16_t* P, const float2* ropes, int b, int j, int s, int q4, int col, float (&lo)[8], float (&hi)[8]) {
    const bf16_t* pk = P + (size_t)ret_row(b, j, s) * PW + col;
    const u32x4 a = *(const u32x4*)(pk + 8 * q4), c = *(const u32x4*)(pk + 32 + 8 * q4);
    lo[0] = bflo(a.x); lo[1] = bfhi(a.x); lo[2] = bflo(a.y); lo[3] = bfhi(a.y); lo[4] = bflo(a.z); lo[5] = bfhi(a.z); lo[6] = bflo(a.w); lo[7] = bfhi(a.w);
    hi[0] = bflo(c.x); hi[1] = bfhi(c.x); hi[2] = bflo(c.y); hi[3] = bfhi(c.y); hi[4] = bflo(c.z); hi[5] = bfhi(c.z); hi[6] = bflo(c.w); hi[7] = bfhi(c.w);
    if (j >= 2) { const int t = (j - 2) * 128 + s;
#pragma unroll
        for (int e = 0; e < 8; ++e) { const float2 cs = ropes[t * 32 + 8 * q4 + e]; const float y1 = lo[e] * cs.x - hi[e] * cs.y, y2 = hi[e] * cs.x + lo[e] * cs.y; lo[e] = y1; hi[e] = y2; } }
}
__device__ __forceinline__ void ret_load_vt(const bf16_t* P, bf16_t* VT, int b, int h, int j, int s, int q4) {
    const bf16_t* pv = P + (size_t)ret_row(b, j, s) * PW + C_RV + 64 * h + 16 * q4;
    const u32x4 a = *(const u32x4*)pv, c = *(const u32x4*)(pv + 8);
    bf16_t* d = VT + (16 * q4) * 136 + s;
    d[0 * 136] = (bf16_t)a.x; d[1 * 136] = (bf16_t)(a.x >> 16); d[2 * 136] = (bf16_t)a.y; d[3 * 136] = (bf16_t)(a.y >> 16);
    d[4 * 136] = (bf16_t)a.z; d[5 * 136] = (bf16_t)(a.z >> 16); d[6 * 136] = (bf16_t)a.w; d[7 * 136] = (bf16_t)(a.w >> 16);
    d[8 * 136] = (bf16_t)c.x; d[9 * 136] = (bf16_t)(c.x >> 16); d[10 * 136] = (bf16_t)c.y; d[11 * 136] = (bf16_t)(c.y >> 16);
    d[12 * 136] = (bf16_t)c.z; d[13 * 136] = (bf16_t)(c.z >> 16); d[14 * 136] = (bf16_t)c.w; d[15 * 136] = (bf16_t)(c.w >> 16);
}
__device__ __forceinline__ void ph_ret_local(const Params& p, int layer, unsigned char* lds, int tid, int bid, int G) {
    const bf16_t* P = (const bf16_t*)(p.ws + OFF_P); const float2* ropes = (const float2*)(p.ws + OFF_ROPES); float* Sloc = (float*)(p.ws + OFF_SLOC);
    bf16_t* KTf = (bf16_t*)lds; bf16_t* KTb = KTf + 64 * 136; bf16_t* VT = KTb + 64 * 136;
    const int lane = tid & 63, wave = tid >> 6, l31 = lane & 31, hi = lane >> 5, s = tid >> 2, q4 = tid & 3;
    for (int u = bid; u < 8 * NCH; u += G) {
        const int j = u % NCH, bh = u / NCH, b = bh >> 2, h = bh & 3;
        const float lgf = logsig(p.in[11][layer * 8 + h]), lgb = logsig(p.in[11][layer * 8 + 4 + h]);
        float lo[8], hi8[8]; ret_load_rot(P, ropes, b, j, s, q4, C_RK + 64 * h, lo, hi8);
        const float wf = expf(lgf * (float)(127 - s)) * 0.125f, wb = expf(lgb * (float)s) * 0.125f;
#pragma unroll
        for (int e = 0; e < 8; ++e) { const int d = 8 * q4 + e;
            KTf[d * 136 + s] = (bf16_t)f2bf(lo[e] * wf); KTf[(d + 32) * 136 + s] = (bf16_t)f2bf(hi8[e] * wf);
            KTb[d * 136 + s] = (bf16_t)f2bf(lo[e] * wb); KTb[(d + 32) * 136 + s] = (bf16_t)f2bf(hi8[e] * wb); }
        ret_load_vt(P, VT, b, h, j, s, q4);
        __syncthreads();
        const int dir = wave & 1, mb = (wave >> 1) & 1, nb = wave >> 2;
        const bf16_t* KT = dir ? KTb : KTf;
        f32x16 acc;
#pragma unroll
        for (int r = 0; r < 16; ++r) acc[r] = 0.f;
#pragma unroll
        for (int c = 0; c < 8; ++c) { const bf16x8 a = *(const bf16x8*)(VT + (32 * mb + l31) * 136 + 16 * c + 8 * hi); const bf16x8 bb = *(const bf16x8*)(KT + (32 * nb + l31) * 136 + 16 * c + 8 * hi);
            acc = MFMA32(a, bb, acc); }
        float* dst = Sloc + ((size_t)((bh * 2 + dir) * NCH + j)) * 4096 + 32 * nb + l31;
#pragma unroll
        for (int r = 0; r < 16; ++r) dst[(32 * mb + crow(r, hi)) * 64] = acc[r];
        __syncthreads();
    }
}
__device__ __forceinline__ void ph_ret_scan(const Params& p, int layer, int gtid, int NT) {
    const float* Sloc = (const float*)(p.ws + OFF_SLOC); bf16_t* St = (bf16_t*)(p.ws + OFF_ST);
    for (int e = gtid; e < 16 * 4096; e += NT) {
        const int seq = e >> 12, el = e & 4095, dir = seq & 1, h = (seq >> 1) & 3;
        const float g = expf(logsig(p.in[11][layer * 8 + dir * 4 + h]) * 128.0f);
        const float* sl = Sloc + (size_t)seq * NCH * 4096 + el; bf16_t* st = St + (size_t)seq * NCH * 4096 + el;
        float S = 0.f;
        if (dir == 0) {
#pragma unroll 11
            for (int j = 0; j < NCH; ++j) { st[(size_t)j * 4096] = (bf16_t)f2bf(S); S = S * g + sl[(size_t)j * 4096]; } }
        else { st[4096] = (bf16_t)f2bf(S); S = S * g + sl[4096]; st[0] = (bf16_t)f2bf(S); S = S * g + sl[0];
#pragma unroll 8
            for (int j = NCH - 1; j >= 2; --j) { st[(size_t)j * 4096] = (bf16_t)f2bf(S); S = S * g + sl[(size_t)j * 4096]; } }
    }
}
__device__ __forceinline__ void ret_rot_regs(const u32x4& a, const u32x4& c, const float2* ropes, int j, int s, int q4, float (&lo)[8], float (&hi)[8]) {
    lo[0] = bflo(a.x); lo[1] = bfhi(a.x); lo[2] = bflo(a.y); lo[3] = bfhi(a.y); lo[4] = bflo(a.z); lo[5] = bfhi(a.z); lo[6] = bflo(a.w); lo[7] = bfhi(a.w);
    hi[0] = bflo(c.x); hi[1] = bfhi(c.x); hi[2] = bflo(c.y); hi[3] = bfhi(c.y); hi[4] = bflo(c.z); hi[5] = bfhi(c.z); hi[6] = bflo(c.w); hi[7] = bfhi(c.w);
    if (j >= 2) { const int t = (j - 2) * 128 + s;
#pragma unroll
        for (int e = 0; e < 8; ++e) { const float2 cs = ropes[t * 32 + 8 * q4 + e]; const float y1 = lo[e] * cs.x - hi[e] * cs.y, y2 = hi[e] * cs.x + lo[e] * cs.y; lo[e] = y1; hi[e] = y2; } }
}
__device__ __forceinline__ void ph_ret_out(const Params& p, int layer, unsigned char* lds, int tid, int bid, int G) {
    const bf16_t* P = (const bf16_t*)(p.ws + OFF_P); const float2* ropes = (const float2*)(p.ws + OFF_ROPES); const bf16_t* St = (const bf16_t*)(p.ws + OFF_ST);
    bf16_t* MIX = (bf16_t*)(p.ws + OFF_MIX); const float* gnw = p.in[12] + layer * 256;
    bf16_t* Qs = (bf16_t*)lds; bf16_t* Ks = Qs + 128 * 72; bf16_t* VT = Ks + 128 * 72; float* red = (float*)(VT + 64 * 136);
    const int lane = tid & 63, wave = tid >> 6, l31 = lane & 31, hi = lane >> 5, s = tid >> 2, q4 = tid & 3;
    const int jlo = layer == 0 ? 0 : 2, nj = NCH - jlo, total = 8 * nj;
    u32x4 qa, qc, ka, kc, va, vc;
#define R3_LOAD(uu) do { const int j_ = jlo + (uu) % nj, bh_ = (uu) / nj; const bf16_t* pr_ = P + (size_t)ret_row(bh_ >> 2, j_, s) * PW + 64 * (bh_ & 3); \
        qa = *(const u32x4*)(pr_ + C_RQ + 8 * q4); qc = *(const u32x4*)(pr_ + C_RQ + 32 + 8 * q4); ka = *(const u32x4*)(pr_ + C_RK + 8 * q4); kc = *(const u32x4*)(pr_ + C_RK + 32 + 8 * q4); \
        va = *(const u32x4*)(pr_ + C_RV + 16 * q4); vc = *(const u32x4*)(pr_ + C_RV + 16 * q4 + 8); } while (0)
    if (bid < total) R3_LOAD(bid);
    for (int u = bid; u < total; u += G) {
        const int j = jlo + u % nj, bh = u / nj, b = bh >> 2, h = bh & 3;
        const float lgf = logsig(p.in[11][layer * 8 + h]), lgb = logsig(p.in[11][layer * 8 + 4 + h]);
        { float lo[8], hi8[8]; ret_rot_regs(qa, qc, ropes, j, s, q4, lo, hi8);
          *(bf16x8*)(Qs + s * 72 + 8 * q4) = pack8(lo[0], lo[1], lo[2], lo[3], lo[4], lo[5], lo[6], lo[7]);
          *(bf16x8*)(Qs + s * 72 + 32 + 8 * q4) = pack8(hi8[0], hi8[1], hi8[2], hi8[3], hi8[4], hi8[5], hi8[6], hi8[7]);
          ret_rot_regs(ka, kc, ropes, j, s, q4, lo, hi8);
          *(bf16x8*)(Ks + s * 72 + 8 * q4) = pack8(lo[0] * 0.125f, lo[1] * 0.125f, lo[2] * 0.125f, lo[3] * 0.125f, lo[4] * 0.125f, lo[5] * 0.125f, lo[6] * 0.125f, lo[7] * 0.125f);
          *(bf16x8*)(Ks + s * 72 + 32 + 8 * q4) = pack8(hi8[0] * 0.125f, hi8[1] * 0.125f, hi8[2] * 0.125f, hi8[3] * 0.125f, hi8[4] * 0.125f, hi8[5] * 0.125f, hi8[6] * 0.125f, hi8[7] * 0.125f); }
        { bf16_t* d = VT + (16 * q4) * 136 + s;
          d[0 * 136] = (bf16_t)va.x; d[1 * 136] = (bf16_t)(va.x >> 16); d[2 * 136] = (bf16_t)va.y; d[3 * 136] = (bf16_t)(va.y >> 16);
          d[4 * 136] = (bf16_t)va.z; d[5 * 136] = (bf16_t)(va.z >> 16); d[6 * 136] = (bf16_t)va.w; d[7 * 136] = (bf16_t)(va.w >> 16);
          d[8 * 136] = (bf16_t)vc.x; d[9 * 136] = (bf16_t)(vc.x >> 16); d[10 * 136] = (bf16_t)vc.y; d[11 * 136] = (bf16_t)(vc.y >> 16);
          d[12 * 136] = (bf16_t)vc.z; d[13 * 136] = (bf16_t)(vc.z >> 16); d[14 * 136] = (bf16_t)vc.w; d[15 * 136] = (bf16_t)(vc.w >> 16); }
        if (u + G < total) R3_LOAD(u + G);
        const int rb = wave & 3, dh = wave >> 2, iq = 32 * rb + l31;
        const size_t row = (size_t)ret_row(b, j, iq);
        bf16x8 sff[4], sbf[4]; u32x2 gwv[4];
        { const bf16_t* stf = St + ((size_t)((bh * 2 + 0) * NCH + j)) * 4096 + (32 * dh + l31) * 64 + 8 * hi;
          const bf16_t* stb = St + ((size_t)((bh * 2 + 1) * NCH + j)) * 4096 + (32 * dh + l31) * 64 + 8 * hi;
#pragma unroll
          for (int c = 0; c < 4; ++c) { sff[c] = *(const bf16x8*)(stf + 16 * c); sbf[c] = *(const bf16x8*)(stb + 16 * c); }
#pragma unroll
          for (int g = 0; g < 4; ++g) gwv[g] = *(const u32x2*)(P + row * PW + C_RG + 64 * h + 32 * dh + 8 * g + 4 * hi); }
        __syncthreads();
        bf16x8 qf[4];
#pragma unroll
        for (int c = 0; c < 4; ++c) qf[c] = *(const bf16x8*)(Qs + iq * 72 + 16 * c + 8 * hi);
        const float lgf2 = lgf * LOG2E, lgb2 = lgb * LOG2E;
        f32x16 o;
#pragma unroll
        for (int r = 0; r < 16; ++r) o[r] = 0.f;
#pragma unroll 1
        for (int sb = 0; sb < 4; ++sb) {
            f32x16 sa;
#pragma unroll
            for (int r = 0; r < 16; ++r) sa[r] = 0.f;
#pragma unroll
            for (int c = 0; c < 4; ++c) { const bf16x8 kf = *(const bf16x8*)(Ks + (32 * sb + l31) * 72 + 16 * c + 8 * hi); sa = MFMA32(kf, qf[c], sa); }
#pragma unroll
            for (int r = 0; r < 16; ++r) { const int dl = iq - (32 * sb + crow(r, hi));
                const float w = dl > 0 ? exp2f(lgf2 * (float)dl) : (dl < 0 ? exp2f(lgb2 * (float)(-dl)) : 2.0f); sa[r] *= w; }
#pragma unroll
            for (int c2 = 0; c2 < 2; ++c2) {
                const bf16x8 pa = pack8(sa[8 * c2 + 0], sa[8 * c2 + 1], sa[8 * c2 + 2], sa[8 * c2 + 3], sa[8 * c2 + 4], sa[8 * c2 + 5], sa[8 * c2 + 6], sa[8 * c2 + 7]);
                const bf16_t* vp = VT + (32 * dh + l31) * 136 + 32 * sb + 16 * c2 + 4 * hi;
                const bf16x8 vf = join8(*(const u32x2*)vp, *(const u32x2*)(vp + 8));
                o = MFMA32(vf, pa, o); }
        }
        f32x16 uf, ub;
#pragma unroll
        for (int r = 0; r < 16; ++r) { uf[r] = 0.f; ub[r] = 0.f; }
#pragma unroll
        for (int c = 0; c < 4; ++c) { uf = MFMA32(sff[c], qf[c], uf); ub = MFMA32(sbf[c], qf[c], ub); }
        const float xf = exp2f(lgf2 * (float)(iq + 1)), xb = exp2f(lgb2 * (float)(128 - iq));
        float sm = 0.f, sq = 0.f;
#pragma unroll
        for (int r = 0; r < 16; ++r) { o[r] += xf * uf[r] + xb * ub[r]; sm += o[r]; sq += o[r] * o[r]; }
        sm += __shfl_xor(sm, 32); sq += __shfl_xor(sq, 32);
        if (hi == 0) { red[(iq * 2 + dh) * 2 + 0] = sm; red[(iq * 2 + dh) * 2 + 1] = sq; }
        __syncthreads();
        const float tsum = red[(iq * 2 + 0) * 2 + 0] + red[(iq * 2 + 1) * 2 + 0], tsq = red[(iq * 2 + 0) * 2 + 1] + red[(iq * 2 + 1) * 2 + 1];
        const float mean = tsum * (1.0f / 64.0f), var = tsq * (1.0f / 64.0f) - mean * mean, rstd = rsqrtf(fmaxf(var, 0.f) + LN_EPS);
#pragma unroll
        for (int g = 0; g < 4; ++g) { const int d = 32 * dh + 8 * g + 4 * hi;
            const u32x2 gw = gwv[g]; const f32x4 nw = *(const f32x4*)(gnw + 64 * h + d);
            const float g0 = bflo(gw.x), g1 = bfhi(gw.x), g2 = bflo(gw.y), g3 = bfhi(gw.y);
            const float y0 = (o[4 * g + 0] - mean) * rstd * nw.x * (g0 / (1.0f + __expf(-g0))), y1 = (o[4 * g + 1] - mean) * rstd * nw.y * (g1 / (1.0f + __expf(-g1)));
            const float y2 = (o[4 * g + 2] - mean) * rstd * nw.z * (g2 / (1.0f + __expf(-g2))), y3 = (o[4 * g + 3] - mean) * rstd * nw.w * (g3 / (1.0f + __expf(-g3)));
            u32x2 w; w.x = pk2(y0, y1); w.y = pk2(y2, y3); *(u32x2*)(MIX + row * DM + 768 + 64 * h + d) = w; }
        __syncthreads();
    }
#undef R3_LOAD
}

__device__ __forceinline__ bf16x8 gather8(const bf16_t* base, size_t stride) {
    u32x4 o; o.x = (unsigned)base[0] | ((unsigned)base[stride] << 16); o.y = (unsigned)base[2 * stride] | ((unsigned)base[3 * stride] << 16);
    o.z = (unsigned)base[4 * stride] | ((unsigned)base[5 * stride] << 16); o.w = (unsigned)base[6 * stride] | ((unsigned)base[7 * stride] << 16); return __builtin_bit_cast(bf16x8, o);
}
__device__ __forceinline__ bf16x8 neg8(bf16x8 v) { u32x4 o = __builtin_bit_cast(u32x4, v); o.x ^= 0x80008000u; o.y ^= 0x80008000u; o.z ^= 0x80008000u; o.w ^= 0x80008000u; return __builtin_bit_cast(bf16x8, o); }
__device__ __forceinline__ void ph_four_a(const Params& p, unsigned char* lds, int gw, int NGW, int lane, int wave) {
    const bf16_t* P = (const bf16_t*)(p.ws + OFF_P); bf16_t* TB = (bf16_t*)(p.ws + OFF_TB); const float2* tw = (const float2*)(p.ws + OFF_TW);
    const bf16_t* F_r = (const bf16_t*)(p.ws + OFF_F128R); const bf16_t* F_i = (const bf16_t*)(p.ws + OFF_F128I);
    const int l31 = lane & 31, hi = lane >> 5, wv = __builtin_amdgcn_readfirstlane(wave);
    const bf16_t* ys = (const bf16_t*)lds + wv * 8192;
    for (int u = gw; u < 2048; u += NGW) {
        const int mh = u & 1, nb = (u >> 1) & 7, l2 = (u >> 4) & 63, b = u >> 10;
        { const bf16_t* src = P + (size_t)(b * SEQ + 64 * (lane >> 2) + l2) * PW + C_FR + 32 * nb + 8 * (lane & 3);
#pragma unroll
          for (int q = 0; q < 16; ++q)
              __builtin_amdgcn_global_load_lds((const unsigned*)(src + (size_t)(64 * 16 * (q & 7)) * PW + 256 * (q >> 3)), (LAS unsigned*)((LAS unsigned char*)lds + wv * 16384 + q * 1024), 16, 0, 0); }
        f32x16 tr[2], ti[2];
#pragma unroll
        for (int m = 0; m < 2; ++m)
#pragma unroll
            for (int r = 0; r < 16; ++r) { tr[m][r] = 0.f; ti[m][r] = 0.f; }
        asm volatile("s_waitcnt vmcnt(0)" ::: "memory");
#pragma unroll 4
        for (int c = 0; c < 8; ++c) {
            const bf16_t* yb = ys + (16 * c + 8 * hi) * 32 + l31;
            const bf16x8 yr = gather8(yb, 32), yi = gather8(yb + 4096, 32), nyi = neg8(yi);
#pragma unroll
            for (int m = 0; m < 2; ++m) { const int k1 = 32 * (2 * mh + m) + l31;
                const bf16x8 fr = *(const bf16x8*)(F_r + k1 * 128 + 16 * c + 8 * hi), fi = *(const bf16x8*)(F_i + k1 * 128 + 16 * c + 8 * hi);
                tr[m] = MFMA32(fr, yr, tr[m]); tr[m] = MFMA32(fi, nyi, tr[m]); ti[m] = MFMA32(fr, yi, ti[m]); ti[m] = MFMA32(fi, yr, ti[m]); }
        }
        LDSW();
#pragma unroll
        for (int m = 0; m < 2; ++m)
#pragma unroll
            for (int r = 0; r < 16; ++r) { const int k1 = 32 * (2 * mh + m) + crow(r, hi); const float2 w = tw[l2 * k1];
                const float a = tr[m][r] * w.x + ti[m][r] * w.y, bb = ti[m][r] * w.x - tr[m][r] * w.y;
                bf16_t* dst = TB + ((size_t)((b * 128 + k1) * 64 + l2)) * 512 + 32 * nb + l31; dst[0] = (bf16_t)f2bf(a); dst[256] = (bf16_t)f2bf(bb); }
    }
}
__device__ __forceinline__ void ph_four_b(const Params& p, unsigned char* lds, int gw, int NGW, int lane, int wave) {
    const bf16_t* TB = (const bf16_t*)(p.ws + OFF_TB); bf16_t* MIX = (bf16_t*)(p.ws + OFF_MIX);
    const bf16_t* C64 = (const bf16_t*)(p.ws + OFF_C64); const bf16_t* S64 = (const bf16_t*)(p.ws + OFF_S64);
    const int l31 = lane & 31, hi = lane >> 5, wv = __builtin_amdgcn_readfirstlane(wave);
    const bf16_t* xs = (const bf16_t*)lds + wv * 4096;
    for (int u = gw; u < 2048; u += NGW) {
        const int nb = u & 7, k1 = (u >> 3) & 127, b = u >> 10;
        const bf16_t* src = TB + ((size_t)((b * 128 + k1) * 64 + (lane >> 2))) * 512 + 32 * nb + 8 * (lane & 3);
#pragma unroll
        for (int q = 0; q < 8; ++q)
            __builtin_amdgcn_global_load_lds((const unsigned*)(src + (size_t)(16 * (q & 3)) * 512 + 256 * (q >> 2)), (LAS unsigned*)((LAS unsigned char*)lds + wv * 8192 + q * 1024), 16, 0, 0);
        f32x16 acc[2];
#pragma unroll
        for (int m = 0; m < 2; ++m)
#pragma unroll
            for (int r = 0; r < 16; ++r) acc[m][r] = 0.f;
        asm volatile("s_waitcnt vmcnt(0)" ::: "memory");
#pragma unroll
        for (int c = 0; c < 4; ++c) {
            const bf16_t* xb = xs + (16 * c + 8 * hi) * 32 + l31;
            const bf16x8 xr = gather8(xb, 32), xi = gather8(xb + 2048, 32);
#pragma unroll
            for (int m = 0; m < 2; ++m) { const bf16x8 cf = *(const bf16x8*)(C64 + (32 * m + l31) * 64 + 16 * c + 8 * hi), sf = *(const bf16x8*)(S64 + (32 * m + l31) * 64 + 16 * c + 8 * hi);
                acc[m] = MFMA32(cf, xr, acc[m]); acc[m] = MFMA32(sf, xi, acc[m]); }
        }
        LDSW();
#pragma unroll
        for (int m = 0; m < 2; ++m)
#pragma unroll
            for (int r = 0; r < 16; ++r) { const int lp = k1 + 128 * (32 * m + crow(r, hi));
                MIX[(size_t)(b * SEQ + lp) * DM + 512 + 32 * nb + l31] = (bf16_t)f2bf(acc[m][r] * 0.011048543456039806f); }
    }
}
__device__ __forceinline__ void ph_four_ctx(const Params& p, unsigned char* lds, int bid, int G, int lane, int wave) {
    const bf16_t* P = (const bf16_t*)(p.ws + OFF_P); bf16_t* MIX = (bf16_t*)(p.ws + OFF_MIX);
    const bf16_t* C256 = (const bf16_t*)(p.ws + OFF_C256); const bf16_t* S256 = (const bf16_t*)(p.ws + OFF_S256);
    const int l31 = lane & 31, hi = lane >> 5;
    if (__builtin_amdgcn_readfirstlane(wave) != 0) return;
    const bf16_t* ys = (const bf16_t*)lds;
    for (int u = bid; u < 128; u += G) {
        const int nb = u & 7, mb = (u >> 3) & 7, b = u >> 6;
        { const bf16_t* src = P + (size_t)(ML + b * LCTX + (lane >> 2)) * PW + C_FR + 32 * nb + 8 * (lane & 3);
#pragma unroll
          for (int q = 0; q < 32; ++q)
              __builtin_amdgcn_global_load_lds((const unsigned*)(src + (size_t)(16 * (q & 15)) * PW + 256 * (q >> 4)), (LAS unsigned*)((LAS unsigned char*)lds + q * 1024), 16, 0, 0); }
        f32x16 acc;
#pragma unroll
        for (int r = 0; r < 16; ++r) acc[r] = 0.f;
        asm volatile("s_waitcnt vmcnt(0)" ::: "memory");
#pragma unroll 4
        for (int c = 0; c < 16; ++c) {
            const bf16_t* yb = ys + (16 * c + 8 * hi) * 32 + l31;
            const bf16x8 yr = gather8(yb, 32), yi = gather8(yb + 8192, 32);
            const bf16x8 cf = *(const bf16x8*)(C256 + (32 * mb + l31) * 256 + 16 * c + 8 * hi), sf = *(const bf16x8*)(S256 + (32 * mb + l31) * 256 + 16 * c + 8 * hi);
            acc = MFMA32(cf, yr, acc); acc = MFMA32(sf, yi, acc);
        }
        LDSW();
#pragma unroll
        for (int r = 0; r < 16; ++r) MIX[(size_t)(ML + b * LCTX + 32 * mb + crow(r, hi)) * DM + 512 + 32 * nb + l31] = (bf16_t)f2bf(acc[r] * 0.0625f);
    }
}

#ifdef SELFCHECK
constexpr size_t OFF_FLAGS = 200 * KiB;
__device__ __forceinline__ unsigned hash32(unsigned x) { x ^= x >> 16; x *= 0x7feb352du; x ^= x >> 15; x *= 0x846ca68bu; x ^= x >> 16; return x; }
__device__ __forceinline__ void ph_selfcheck(const Params& p, int layer, int gw, int NGW, int lane) {
    const bf16_t* P = (const bf16_t*)(p.ws + OFF_P); const bf16_t* MIX = (const bf16_t*)(p.ws + OFF_MIX); unsigned* flags = (unsigned*)(p.ws + OFF_FLAGS);
    const float2* ropes = (const float2*)(p.ws + OFF_ROPES);
    for (int smp = gw; smp < 4096; smp += NGW) {
        const unsigned hsh = hash32(0x9e3779b9u * (unsigned)smp + 12345u);
        const int kind = smp & 3, b = (hsh >> 3) & 1, h = (hsh >> 4) & 3; const bool cx = (smp & 4) != 0;
        const int t = cx ? ((hsh >> 8) & 255) : ((hsh >> 8) & 8191);
        const int row = cx ? ML + b * LCTX + t : b * SEQ + t; const int d = lane;
        float ref = 0.f, got = 0.f;
        if (kind < 2) {
            const int isB = kind, kvh = h >> 1;
            const bf16_t* q = P + (size_t)row * PW + (isB ? C_QB : C_QA) + 64 * h;
            const int kcol = (isB ? C_KB : C_KA) + 64 * kvh, vcol = (isB ? C_VB : C_VA) + 64 * kvh;
            float mx = -1e30f;
            for (int pass = 0; pass < 2; ++pass) {
                float acc = 0.f, den = 0.f;
                for (int s = cx ? SEQ : 0; s < KVT; ++s) {
                    if (isB && s < SEQ) { int dd = s - t; dd = dd < 0 ? -dd : dd; if (dd > 128) continue; }
                    const int krow = s < SEQ ? b * SEQ + s : ML + b * LCTX + (s - SEQ);
                    const bf16_t* k = P + (size_t)krow * PW + kcol;
                    float sc = 0.f;
                    for (int e = 0; e < 64; ++e) sc += bf2f(q[e]) * bf2f(k[e]);
                    if (pass == 0) mx = fmaxf(mx, sc);
                    else { const float pr = exp2f(sc - mx); den += pr; acc += pr * bf2f(P[(size_t)krow * PW + vcol + d]); }
                }
                if (pass == 1) { if (isB) den += exp2f(p.in[9][layer * 4 + h] * LOG2E - mx); ref = acc / den; }
            }
            got = bf2f(MIX[(size_t)row * DM + (isB ? 256 : 0) + 64 * h + d]);
        } else if (kind == 2) {
            const int col = 64 * h + d; float acc = 0.f;
            if (!cx) { for (int l = 0; l < SEQ; ++l) { const int m = (l * t) & 8191; const float a = (float)m * (1.0f / 4096.0f);
                acc += cospif(a) * bf2f(P[(size_t)(b * SEQ + l) * PW + C_FR + col]) + sinpif(a) * bf2f(P[(size_t)(b * SEQ + l) * PW + C_FI + col]); }
              ref = acc * 0.011048543456039806f; }
            else { for (int l = 0; l < LCTX; ++l) { const int m = (l * t) & 255; const float a = (float)m * (1.0f / 128.0f);
                acc += cospif(a) * bf2f(P[(size_t)(ML + b * LCTX + l) * PW + C_FR + col]) + sinpif(a) * bf2f(P[(size_t)(ML + b * LCTX + l) * PW + C_FI + col]); }
              ref = acc * 0.0625f; }
            got = bf2f(MIX[(size_t)row * DM + 512 + col]);
        } else {
            const float lgf = logsig(p.in[11][layer * 8 + h]), lgb = logsig(p.in[11][layer * 8 + 4 + h]);
            float qv[64];
#pragma unroll
            for (int e = 0; e < 32; ++e) { const float x1 = bf2f(P[(size_t)row * PW + C_RQ + 64 * h + e]), x2 = bf2f(P[(size_t)row * PW + C_RQ + 64 * h + 32 + e]); const float2 cs = cx ? make_float2(1.f, 0.f) : ropes[t * 32 + e];
                qv[e] = x1 * cs.x - x2 * cs.y; qv[32 + e] = x2 * cs.x + x1 * cs.y; }
            float acc = 0.f;
            for (int s = cx ? SEQ : 0; s < KVT; ++s) {
                const int krow = s < SEQ ? b * SEQ + s : ML + b * LCTX + (s - SEQ);
                const bf16_t* k = P + (size_t)krow * PW + C_RK + 64 * h;
                float sc = 0.f;
#pragma unroll
                for (int e = 0; e < 32; ++e) { float x1 = bf2f(k[e]), x2 = bf2f(k[32 + e]);
                    if (s < SEQ) { const float2 cs = ropes[s * 32 + e]; const float y1 = x1 * cs.x - x2 * cs.y, y2 = x2 * cs.x + x1 * cs.y; x1 = y1; x2 = y2; }
                    sc += qv[e] * x1 + qv[32 + e] * x2; }
                sc *= 0.125f;
                float w;
                if (s < SEQ) { w = 0.f; if (s <= t) w += expf(lgf * (float)(t - s)); if (s >= t) w += expf(lgb * (float)(s - t)); }
                else if (!cx) { const int j = s - SEQ; w = expf(lgf * (float)(t + 256 - j)) + expf(lgb * (float)(8192 - t + j)); }
                else { const int j = s - SEQ; w = 0.f; if (j <= t) w += expf(lgf * (float)(t - j)); if (j >= t) w += expf(lgb * (float)(j - t)); }
                acc += w * sc * bf2f(P[(size_t)krow * PW + C_RV + 64 * h + d]);
            }
            const float mean = wave_sum(acc) * (1.0f / 64.0f); const float dv = acc - mean; const float var = wave_sum(dv * dv) * (1.0f / 64.0f);
            const float g = bf2f(P[(size_t)row * PW + C_RG + 64 * h + d]);
            ref = dv * rsqrtf(var + LN_EPS) * p.in[12][layer * 256 + 64 * h + d] * (g / (1.0f + expf(-g)));
            got = bf2f(MIX[(size_t)row * DM + 768 + 64 * h + d]);
        }
        const float e2 = wave_sum((ref - got) * (ref - got)), r2 = wave_sum(ref * ref);
        if (lane == 0 && !(e2 <= 0.0025f * r2 + 1e-12f)) atomicOr(flags, 1u << kind);
    }
}
#endif
#ifndef DBL
#define DBL 0
#endif
#define REP(k) for (int rep_ = 0; rep_ < 1 + ((DBL >> (k)) & 1); ++rep_)

template <bool masked, bool SAFE>
__device__ __forceinline__ bool attn_unit(const Params& p, int layer, unsigned char* lds, int tid, int b, int h, int qblk, int isB, int isctx) {
    const bf16_t* P = (const bf16_t*)(p.ws + OFF_P); bf16_t* MIX = (bf16_t*)(p.ws + OFF_MIX);
    bf16_t* Kt = (bf16_t*)lds;
    bf16_t* Vt = Kt + 4 * 4096;
    const int lane = tid & 63, wave = tid >> 6, l31 = lane & 31, hi = lane >> 5;
    const int kvh = h >> 1;
    const int qrow0 = isctx ? ML + b * LCTX : b * SEQ + 256 * qblk;
    int t_lo = 0, nlat = 128;
    if (isctx) nlat = 0; else if (isB) { t_lo = 4 * qblk - 2; if (t_lo < 0) t_lo = 0; int t_hi = 4 * qblk + 6; if (t_hi > 128) t_hi = 128; nlat = t_hi - t_lo; }
    const int ntile = nlat + 4;
    const int qcol = (isB ? C_QB : C_QA) + 64 * h, kcol = (isB ? C_KB : C_KA) + 64 * kvh;
    const bf16_t* VTg = (const bf16_t*)(p.ws + (isB ? OFF_VBT : OFF_VAT)) + (size_t)((b * 2 + kvh) * 64) * KVT;
    bf16x8 qf[4];
    { const bf16_t* qp = P + (size_t)(qrow0 + 32 * wave + l31) * PW + qcol + 8 * hi;
#pragma unroll
      for (int c = 0; c < 4; ++c) qf[c] = *(const bf16x8*)(qp + 16 * c); }
    const int qpos = 256 * qblk + 32 * wave + l31, qp0 = 256 * qblk + 32 * wave;
    f32x16 o0, o1;
#pragma unroll
    for (int r = 0; r < 16; ++r) { o0[r] = 0.f; o1[r] = 0.f; }
    float m = -1e30f, l = 0.f;
    f32x16 negm;
#pragma unroll
    for (int r = 0; r < 16; ++r) negm[r] = 0.f;
    bool first = true;
    const int wv = __builtin_amdgcn_readfirstlane(wave), dr = 8 * wv + (lane >> 3), dc = (lane & 7) ^ ((dr >> 1) & 7);
    const int sw = (l31 >> 1) & 7;
#define SWZ(idx) (8 * ((((idx) | hi)) ^ sw))
#define ATT_TILE(i) ((i) < nlat ? t_lo + (i) : 128 + (i) - nlat)
#define ATT_DMA(i, buf) do { const int t_ = ATT_TILE(i); const int krow_ = t_ < 128 ? b * SEQ + 64 * t_ + dr : ML + b * LCTX + 64 * (t_ - 128) + dr; \
    __builtin_amdgcn_global_load_lds((const unsigned*)(P + (size_t)krow_ * PW + kcol + 8 * dc), (LAS unsigned*)((LAS unsigned char*)lds + (buf) * 8192 + wv * 1024), 16, 0, 0); \
    __builtin_amdgcn_global_load_lds((const unsigned*)(VTg + (size_t)dr * KVT + 64 * t_ + 8 * dc), (LAS unsigned*)((LAS unsigned char*)lds + 32768 + (buf) * 8192 + wv * 1024), 16, 0, 0); } while (0)
    ATT_DMA(0, 0); ATT_DMA(1, 1);
    __syncthreads();
    for (int ip = 0; ip < ntile; ip += 2) {
      const int stage = (ip >> 1) & 1;
      if (ip + 2 < ntile) { ATT_DMA(ip + 2, (stage ^ 1) * 2); ATT_DMA(ip + 3, (stage ^ 1) * 2 + 1); }
#pragma unroll 1
      for (int sub = 0; sub < 2; ++sub) {
        const int i = ip + sub; const int buf = stage * 2 + sub;
        const int t = ATT_TILE(i);
        const bool lat = t < 128;
        const bool active = !(isB && lat) || (64 * t + 63 >= qp0 - 128 && 64 * t <= qp0 + 31 + 128);
        if (active) {
            const bf16_t* kb = Kt + buf * 4096 + l31 * 64;
            f32x16 s0, s1;
#define ATT_SCORES() do { s0 = MFMA32(*(const bf16x8*)(kb + SWZ(0)), qf[0], negm); s1 = MFMA32(*(const bf16x8*)(kb + 2048 + SWZ(0)), qf[0], negm); \
                _Pragma("unroll") for (int c = 1; c < 4; ++c) { s0 = MFMA32(*(const bf16x8*)(kb + SWZ(2 * c)), qf[c], s0); s1 = MFMA32(*(const bf16x8*)(kb + 2048 + SWZ(2 * c)), qf[c], s1); } } while (0)
#define ATT_MASK() do { if (masked && lat) { _Pragma("unroll") for (int r = 0; r < 16; ++r) { const int kp = 64 * t + crow(r, hi); int d0 = kp - qpos; d0 = d0 < 0 ? -d0 : d0; int d1 = kp + 32 - qpos; d1 = d1 < 0 ? -d1 : d1; \
                if (d0 > 128) s0[r] = -1e30f; if (d1 > 128) s1[r] = -1e30f; } } } while (0)
            ATT_SCORES();
            const bf16_t* vb = Vt + buf * 4096 + l31 * 64;
            const bf16x8 vf00 = *(const bf16x8*)(vb + SWZ(0)), vf01 = *(const bf16x8*)(vb + SWZ(4)), vf02 = *(const bf16x8*)(vb + SWZ(2)), vf03 = *(const bf16x8*)(vb + SWZ(6));
            const bf16x8 vf10 = *(const bf16x8*)(vb + 2048 + SWZ(0)), vf11 = *(const bf16x8*)(vb + 2048 + SWZ(4)), vf12 = *(const bf16x8*)(vb + 2048 + SWZ(2)), vf13 = *(const bf16x8*)(vb + 2048 + SWZ(6));
            __builtin_amdgcn_sched_barrier(0);
            ATT_MASK();
            {
                if (first) { first = false;
                    float mx = fmaxf(s0[0], s1[0]);
#pragma unroll
                    for (int r = 1; r < 16; ++r) mx = fmaxf(mx, fmaxf(s0[r], s1[r]));
                    m = xhalf_max(mx); if (masked) m = m < -1e29f ? 0.f : m;
#pragma unroll
                    for (int r = 0; r < 16; ++r) { s0[r] -= m; s1[r] -= m; negm[r] = -m; } }
                float ps = 0.f, ps1 = 0.f;
#pragma unroll
                for (int r = 0; r < 16; ++r) { s0[r] = __builtin_amdgcn_exp2f(s0[r]); s1[r] = __builtin_amdgcn_exp2f(s1[r]); ps += s0[r]; ps += s1[r]; }
                (void)ps1;
                if (SAFE && __any(!(ps <= 4096.0f))) {
                    ATT_SCORES(); ATT_MASK();
                    float mx = fmaxf(s0[0], s1[0]);
#pragma unroll
                    for (int r = 1; r < 16; ++r) mx = fmaxf(mx, fmaxf(s0[r], s1[r]));
                    mx = xhalf_max(mx);
                    const float dl = fmaxf(mx, 0.f), sc = __builtin_amdgcn_exp2f(-dl); m += dl; l *= sc; ps = 0.f;
#pragma unroll
                    for (int r = 0; r < 16; ++r) { o0[r] *= sc; o1[r] *= sc; negm[r] = -m; s0[r] = __builtin_amdgcn_exp2f(s0[r] - dl); s1[r] = __builtin_amdgcn_exp2f(s1[r] - dl); ps += s0[r] + s1[r]; }
                }
                l += ps;
            }
#undef ATT_MASK
#undef ATT_SCORES
            {   const bf16x8 pa00 = pack8(s0[0], s0[1], s0[2], s0[3], s0[4], s0[5], s0[6], s0[7]), pa10 = pack8(s1[0], s1[1], s1[2], s1[3], s1[4], s1[5], s1[6], s1[7]);
                const bf16x8 pa01 = pack8(s0[8], s0[9], s0[10], s0[11], s0[12], s0[13], s0[14], s0[15]), pa11 = pack8(s1[8], s1[9], s1[10], s1[11], s1[12], s1[13], s1[14], s1[15]);
                o0 = MFMA32(vf00, pa00, o0); o1 = MFMA32(vf10, pa00, o1);
                o0 = MFMA32(vf01, pa10, o0); o1 = MFMA32(vf11, pa10, o1);
                o0 = MFMA32(vf02, pa01, o0); o1 = MFMA32(vf12, pa01, o1);
                o0 = MFMA32(vf03, pa11, o0); o1 = MFMA32(vf13, pa11, o1);
            }
        }
      }
      __syncthreads();
    }
#undef ATT_TILE
#undef ATT_DMA
#undef SWZ
    l = xhalf_sum(l);
    const bool bad = !SAFE && __syncthreads_or(!(l < 1e30f) ? 1 : 0) != 0;
    if (bad) return true;
    if (isB) l += exp2f(p.in[9][layer * 4 + h] * LOG2E - m);
    const float inv = 1.0f / l;
    bf16_t* op = MIX + (size_t)(qrow0 + 32 * wave + l31) * DM + (isB ? 256 : 0) + 64 * h + 4 * hi;
#pragma unroll
    for (int g = 0; g < 4; ++g) { u32x2 w; w.x = pk2(o0[4 * g] * inv, o0[4 * g + 1] * inv); w.y = pk2(o0[4 * g + 2] * inv, o0[4 * g + 3] * inv); *(u32x2*)(op + 8 * g) = w;
        u32x2 w1; w1.x = pk2(o1[4 * g] * inv, o1[4 * g + 1] * inv); w1.y = pk2(o1[4 * g + 2] * inv, o1[4 * g + 3] * inv); *(u32x2*)(op + 32 + 8 * g) = w1; }
    return false;
}
__device__ __forceinline__ void ph_attn(const Params& p, int layer, unsigned char* lds, int tid, int bid, int G) {
    const int total = layer == 0 ? 528 : 512;
    for (int u = bid; u < total; u += G) {
        int b, h, qblk, isB, isctx;
        if (u < 512) { const int v = u & 255, grp = v & 3, idx = v >> 2; isB = u >> 8; isctx = 0; b = grp >> 1; h = (grp & 1) * 2 + (idx >> 5); qblk = idx & 31; }
        else { const int v = u - 512; isB = v >> 3; isctx = 1; b = (v >> 2) & 1; h = v & 3; qblk = 0; }
        if (isB && !isctx) { if (attn_unit<true, false>(p, layer, lds, tid, b, h, qblk, isB, isctx)) attn_unit<true, true>(p, layer, lds, tid, b, h, qblk, isB, isctx); }
        else { if (attn_unit<false, false>(p, layer, lds, tid, b, h, qblk, isB, isctx)) attn_unit<false, true>(p, layer, lds, tid, b, h, qblk, isB, isctx); }
    }
}

__device__ __forceinline__ void ph_ctx_gemm(const bf16_t* A, const bf16_t* Bt, bf16_t* O, int K, unsigned char* lds, int tid, int bid, int G) {
    const int lane = tid & 63, wave = tid >> 6, l31 = lane & 31, hi = lane >> 5, ks = wave & 3, Kq = K >> 2;
    float* red = (float*)lds;
    for (int tp = bid; tp < 256; tp += G) {
        const int tile = 2 * tp + (wave >> 2), mb = tile >> 5, nb = tile & 31;
        const bf16_t* ap = A + (size_t)(ML + 32 * mb + l31) * K + ks * Kq + 8 * hi; const bf16_t* bp = Bt + (size_t)(32 * nb + l31) * K + ks * Kq + 8 * hi;
        f32x16 acc;
#pragma unroll
        for (int r = 0; r < 16; ++r) acc[r] = 0.f;
#pragma unroll 8
        for (int c = 0; c < Kq / 16; ++c) acc = MFMA32(*(const bf16x8*)(ap + 16 * c), *(const bf16x8*)(bp + 16 * c), acc);
#pragma unroll
        for (int r = 0; r < 16; ++r) red[(wave * 16 + r) * 64 + lane] = acc[r];
        __syncthreads();
        if (ks == 0) {
#pragma unroll
            for (int r = 0; r < 16; ++r) { const float v = ((red[(wave * 16 + r) * 64 + lane] + red[((wave + 1) * 16 + r) * 64 + lane]) + red[((wave + 2) * 16 + r) * 64 + lane]) + red[((wave + 3) * 16 + r) * 64 + lane];
                O[(size_t)(ML + 32 * mb + crow(r, hi)) * DM + 32 * nb + l31] = (bf16_t)f2bf(v); } }
        __syncthreads();
    }
}

__global__ void __launch_bounds__(512, 2) fwd_megakernel(Params p_arg) {
    extern __shared__ __attribute__((aligned(16))) unsigned char lds[];
    cg::grid_group grid = cg::this_grid();
    const int n_steps = p_arg.n_steps;
    volatile LAS unsigned* bst = (volatile LAS unsigned*)((LAS unsigned char*)lds + 140000);
    if (threadIdx.x < 2) bst[threadIdx.x] = 0u;
    __syncthreads();
    const XcdBarrier xbar = xcd_barrier_post((unsigned*)(p_arg.ws + OFF_BAR), bst);
#define GRID_SYNC() do { if (n_steps < 0) grid.sync(); else xcd_barrier(xbar); } while (0)
#pragma unroll 1
    for (int step = 0; step < n_steps; ++step) {
        const __attribute__((address_space(4))) Params* pp = (const __attribute__((address_space(4))) Params*)__builtin_amdgcn_kernarg_segment_ptr();
        asm volatile("" : "+s"(pp));
#if defined(__HIP_DEVICE_COMPILE__)
        const Params p = *pp;
#else
        const Params p = p_arg;
#endif
        int bid = blockIdx.x; asm volatile("" : "+s"(bid));
        const int G = gridDim.x, NGW = G * 8, NT = G * 512;
        unsigned char* ws = p.ws;
        const int layer = step < 2 ? 0 : (step - 2) / 9, ph = step < 2 ? step : 2 + (step - 2) % 9;
        const bool last = layer == 1;
        const int mrows = last ? ML : MT;
        int gk = 0;
        const bf16_t* gA = nullptr; const bf16_t* gB = nullptr; bf16_t* gO = nullptr; int gM = 0, gN = 0, gK = 0;
#define IDS int t_ = threadIdx.x; asm volatile("" : "+v"(t_)); const int tid = t_, lane = t_ & 63, wave = __builtin_amdgcn_readfirstlane(t_ >> 6), gw = bid * 8 + wave, gtid = bid * 512 + t_; (void)tid; (void)lane; (void)wave; (void)gw; (void)gtid
        switch (ph) {
        case 0:
#ifdef SELFCHECK
            { IDS; if (gtid == 0) *(unsigned*)(ws + OFF_FLAGS) = 0u; }
#endif
            { IDS; ph_tables(ws, gtid, NT); }
            REP(7) { { IDS; ph_mod(p.in[1], p.in[3], p.in[4], p.in[5], (float*)(ws + OFF_MOD), lds, tid, bid, G); } __syncthreads(); { IDS; ph_weights(p, 0, lds, tid, bid, G, 48); } __syncthreads(); } break;
        case 1: REP(6) { IDS; ph_h0(p, gw, NGW, lane); } break;
        case 2: gk = 1; gA = (const bf16_t*)(ws + OFF_H); gB = (const bf16_t*)(ws + OFF_WIN); gO = (bf16_t*)(ws + OFF_P); gM = MT; gN = PW; gK = DM; break;
        case 3: { IDS; ph_prep(p, layer, lds, gw, NGW, lane, wave); } __syncthreads(); REP(2) { IDS; ph_ret_local(p, layer, lds, tid, bid, G); } REP(3) { { IDS; ph_four_a(p, lds, gw, NGW, lane, wave); } if (!last) { __syncthreads(); { IDS; ph_four_ctx(p, lds, bid, G, lane, wave); } } } break;
        case 4: REP(9) { IDS; ph_ret_scan(p, layer, gtid, NT); } REP(0) { IDS; ph_attn(p, layer, lds, tid, bid, G); } REP(4) { IDS; ph_four_b(p, lds, gw, NGW, lane, wave); } break;
        case 5: REP(5) { IDS; ph_ret_out(p, layer, lds, tid, bid, G); }
#ifdef SELFCHECK
            if (layer == 0) { GRID_SYNC(); { IDS; ph_selfcheck(p, layer, gw, NGW, lane); } }
#endif
            break;
        case 6: gk = 1; gA = (const bf16_t*)(ws + OFF_MIX); gB = (const bf16_t*)(ws + OFF_WOUT); gO = (bf16_t*)(ws + OFF_P); gM = ML; gN = DM; gK = DM; break;
        case 7: { IDS; ph_rowpass(p, layer, 0, mrows, true, gw, NGW, lane); } break;
        case 8: gk = 2; gA = (const bf16_t*)(ws + OFF_H); gB = (const bf16_t*)(ws + OFF_WGU); gO = (bf16_t*)(ws + OFF_P); gM = mrows; gN = 2 * FF; gK = DM; break;
        case 9: gk = 1; gA = (const bf16_t*)(ws + OFF_P); gB = (const bf16_t*)(ws + OFF_WDN); gO = (bf16_t*)(ws + OFF_Y2); gM = ML; gN = DM; gK = FF; break;
        default: { IDS; ph_rowpass(p, layer, 1, mrows, !last, gw, NGW, lane); } if (!last) { IDS; ph_weights(p, 1, lds, tid, bid, G); } break;
        }
        if (gk == 1) REP(1) { pg8::Gemm g{gA, gB, gM, gN, gK}; pg8::StaticOrder S; S.init(gM, gN, G, bid);
            pg8::EpiPlain E{gO, gN};
            pg8::gemm_phase<pg8::EpiPlain, pg8::StaticOrder, true, true>((PG8_LAS unsigned char*)lds, g, S, E);
            if (!last && gN == DM) { IDS; ph_ctx_gemm(gA, gB, gO, gK, lds, tid, bid, G); } }
        else if (gk == 2) REP(1) { pg8::Gemm g{gA, gB, gM, gN, gK}; pg8::StaticOrder S; S.init(gM, gN, G, bid);
            pg8::EpiSwiglu E{gO, FF};
            pg8::gemm_phase<pg8::EpiSwiglu, pg8::StaticOrder, true, true>((PG8_LAS unsigned char*)lds, g, S, E); }
        if (step + 1 < n_steps) GRID_SYNC();
        REP(8) { if (rep_ == 1) GRID_SYNC(); }
    }
}

extern "C" void kernel_launch(void* const* d_in, const int* in_sizes, int n_in, void* d_out, int out_size, void* d_ws, size_t ws_size, hipStream_t stream) {
    static int grid = 0;
    if (grid == 0) {
        if (n_in != 20 || out_size != ML * DM || ws_size < WS_NEED) { fprintf(stderr, "kernel_launch: unexpected shapes (n_in %d, out %d, ws %zu)\n", n_in, out_size, ws_size); grid = -1; return; }
        int dev = 0, cus = 0, per_cu = 0;
        hipGetDevice(&dev); hipDeviceGetAttribute(&cus, hipDeviceAttributeMultiprocessorCount, dev);
        if (hipFuncSetAttribute((const void*)fwd_megakernel, hipFuncAttributeMaxDynamicSharedMemorySize, LDS_BYTES) != hipSuccess) { fprintf(stderr, "kernel_launch: hipFuncSetAttribute failed\n"); grid = -1; return; }
        if (hipOccupancyMaxActiveBlocksPerMultiprocessor(&per_cu, (const void*)fwd_megakernel, 512, LDS_BYTES) != hipSuccess || per_cu < 1) { fprintf(stderr, "kernel_launch: occupancy query says %d\n", per_cu); per_cu = 1; }
        (void)hipGetLastError();
        grid = cus;
    }
    if (grid < 0) return;
    Params p{};
    p.n_steps = 20; p.pad = 0;
    for (int i = 0; i < 20; ++i) p.in[i] = (const float*)d_in[i];
    p.out = (float*)d_out; p.ws = (unsigned char*)d_ws;
    if (hipMemsetAsync((char*)d_ws + OFF_BAR, 0, 16384, stream) != hipSuccess) { fprintf(stderr, "kernel_launch: memset failed\n"); return; }
    void* args[] = {&p};
    hipError_t e = hipLaunchCooperativeKernel((const void*)fwd_megakernel, dim3(grid), dim3(512), args, LDS_BYTES, stream);
    if (e != hipSuccess) fprintf(stderr, "cooperative launch failed: %s (grid %d)\n", hipGetErrorString(e), grid);
}
```

```cpp
#include <hip/hip_runtime.h>
#include <hip/hip_cooperative_groups.h>
#include <cstdio>
#include <cstdint>
namespace cg = cooperative_groups;
namespace pg8 {
#define PG8_LAS __attribute__((address_space(3)))
typedef unsigned short bf16_t;
typedef short bf16x8 __attribute__((ext_vector_type(8)));
typedef float f32x4 __attribute__((ext_vector_type(4)));
typedef unsigned u32x4 __attribute__((ext_vector_type(4)));
constexpr int BM = 256, BK = 64, HALF = 128, HTB = HALF * BK * 2  , STAGE_BYTES = 8 * HTB, NXCD = 8, WGM = 8;

__host__ __device__ __forceinline__ int lds_byte(int r, int c) { const int st = (r >> 4) * 2 + (c >> 5), rr = r & 15, cc = c & 31, ob = rr * 64 + cc * 2; return st * 1024 + (ob ^ (((ob >> 9) & 1) << 5)); }
__host__ __device__ __forceinline__ void stage_rc(int b, int& R, int& C) { const int st = b / 1024, sb = b % 1024, swz = sb ^ (((sb >> 9) & 1) << 5); R = (st >> 1) * 16 + swz / 64; C = (st & 1) * 32 + (swz % 64) / 2; }
__host__ __device__ __forceinline__ int perm32(int rho) { const int n = rho >> 4, i = rho & 15; return 8 * (i >> 2) + 4 * n + (i & 3); }

struct Unit { int pm, pn; };
struct Gemm { const bf16_t* A; const bf16_t* Bt; int M, N, K; };

struct StaticOrder {
    int nM, nN, nwg, G, c;
    __host__ __device__ void init(int M, int N, int G_, int c_) { nM = M / BM; nN = N / BM; nwg = nM * nN; G = G_; c = c_; }
    __host__ __device__ bool next(int i, Unit& u) const {
        const long L = (long)i * G + c; if (L >= nwg) return false;
        int wgid = (int)L; { const int q = nwg / NXCD, r = nwg % NXCD, xcd = wgid % NXCD, off = wgid / NXCD; wgid = (xcd < r ? xcd * (q + 1) : r * (q + 1) + (xcd - r) * q) + off; }
        const int nig = WGM * nN, gid = wgid / nig, fm = gid * WGM, gsz = (nM - fm) < WGM ? (nM - fm) : WGM;
        u.pm = fm + ((wgid % nig) % gsz); u.pn = (wgid % nig) / gsz; return true;
    }
    __device__ __forceinline__ void a_ready(const Unit&) const {}
    __device__ __forceinline__ void done(const Unit&) const {}
};

__device__ __forceinline__ unsigned cvt_pk_bf16(float lo, float hi) { unsigned r; asm volatile("v_cvt_pk_bf16_f32 %0, %1, %2" : "=v"(r) : "v"(lo), "v"(hi)); return r; }
typedef float f32x2 __attribute__((ext_vector_type(2)));
__device__ __forceinline__ f32x2 gelu_pk(f32x2 v) {
    const f32x2 av = __builtin_elementwise_abs(v), d = av * 0.2316418882f + 1.0f;
    f32x2 t; t.x = __builtin_amdgcn_rcpf(d.x); t.y = __builtin_amdgcn_rcpf(d.y);
    f32x2 q = t * 0.5307027145f + (-0.7265760135f); q = q * t + 0.7107068705f; q = q * t + (-0.142248368f); q = q * t + 0.127414796f; q = q * t;
    const f32x2 s = (v * v) * (-0.72134752044f);
    f32x2 e; e.x = __builtin_amdgcn_exp2f(s.x); e.y = __builtin_amdgcn_exp2f(s.y);
    const f32x2 m = v * (q * e), r = v - m;
    f32x2 o; o.x = v.x < 0.f ? m.x : r.x; o.y = v.y < 0.f ? m.y : r.y; return o;
}

template <int ACT  > struct EpiBf16 {
    static constexpr bool PERM = true, AFTER_DRAIN = false; static_assert(ACT == 0 || ACT == 1, "EpiBf16: ACT is 0 (none) or 1 (gelu_pk)");
    bf16_t* O; int ldc; const float* bias; int split_cols; size_t split_stride; float scale0;
    __device__ __forceinline__ void operator()(const f32x4 (&acc)[2][2][4][2], const Unit& u, int wr, int wc, int fr, int fq) const {
        const int row0 = u.pm * BM + wr * 64 + fr; int colt = u.pn * BM; bf16_t* base = O;
        float sc = 1.f; if (split_cols) { const int t = colt / split_cols; base += (size_t)t * split_stride; colt -= t * split_cols; if (t == 0) sc = scale0; }
        const int col0 = colt + wc * 32 + 8 * fq, bcol0 = u.pn * BM + wc * 32 + 8 * fq;
        f32x4 bv[2][2];
#pragma unroll
        for (int bj = 0; bj < 2; ++bj)
#pragma unroll
            for (int n = 0; n < 2; ++n) bv[bj][n] = bias ? *(const f32x4*)(bias + bcol0 + bj * HALF + 4 * n) : (f32x4){0.f, 0.f, 0.f, 0.f};
#pragma unroll
        for (int ai = 0; ai < 2; ++ai)
#pragma unroll
            for (int m = 0; m < 4; ++m) { bf16_t* rowp = base + (size_t)(row0 + ai * HALF + m * 16) * ldc + col0;
#pragma unroll
                for (int bj = 0; bj < 2; ++bj) { f32x4 v0 = acc[ai][bj][m][0] + bv[bj][0], v1 = acc[ai][bj][m][1] + bv[bj][1];
                    if (ACT == 1) { f32x2 a = gelu_pk((f32x2){v0[0], v0[1]}), b = gelu_pk((f32x2){v0[2], v0[3]}), c = gelu_pk((f32x2){v1[0], v1[1]}), d = gelu_pk((f32x2){v1[2], v1[3]});
                        v0 = (f32x4){a.x, a.y, b.x, b.y}; v1 = (f32x4){c.x, c.y, d.x, d.y}; }
                    v0 = v0 * sc; v1 = v1 * sc; u32x4 w; w.x = cvt_pk_bf16(v0[0], v0[1]); w.y = cvt_pk_bf16(v0[2], v0[3]); w.z = cvt_pk_bf16(v1[0], v1[1]); w.w = cvt_pk_bf16(v1[2], v1[3]);
                    *(u32x4*)(rowp + bj * HALF) = w; } }
    }
};

struct EpiSwiglu {
    static constexpr bool PERM = true, AFTER_DRAIN = false;
    bf16_t* O; int ldo;
    __device__ __forceinline__ void operator()(const f32x4 (&acc)[2][2][4][2], const Unit& u, int wr, int wc, int fr, int fq) const {
        const int row0 = u.pm * BM + wr * 64 + fr; const int col0 = u.pn * 128 + wc * 32 + 8 * fq;
#pragma unroll
        for (int ai = 0; ai < 2; ++ai)
#pragma unroll
            for (int m = 0; m < 4; ++m) { bf16_t* rowp = O + (size_t)(row0 + ai * HALF + m * 16) * ldo + col0;
                float r[8];
#pragma unroll
                for (int n = 0; n < 2; ++n)
#pragma unroll
                    for (int e = 0; e < 4; ++e) { const float g = acc[ai][0][m][n][e], up = acc[ai][1][m][n][e];
                        r[4 * n + e] = g * __builtin_amdgcn_rcpf(1.0f + __expf(-g)) * up; }
                u32x4 w; w.x = cvt_pk_bf16(r[0], r[1]); w.y = cvt_pk_bf16(r[2], r[3]); w.z = cvt_pk_bf16(r[4], r[5]); w.w = cvt_pk_bf16(r[6], r[7]);
                *(u32x4*)rowp = w; }
    }
};

struct EpiPlain {
    static constexpr bool PERM = true, AFTER_DRAIN = false;
    bf16_t* O; int ldc;
    __device__ __forceinline__ void operator()(const f32x4 (&acc)[2][2][4][2], const Unit& u, int wr, int wc, int fr, int fq) const {
        bf16_t* base = O + (size_t)(u.pm * BM + wr * 64 + fr) * ldc + u.pn * BM + wc * 32 + 8 * fq;
#pragma unroll
        for (int ai = 0; ai < 2; ++ai)
#pragma unroll
            for (int m = 0; m < 4; ++m) { bf16_t* rowp = base + (size_t)(ai * HALF + m * 16) * ldc;
#pragma unroll
                for (int bj = 0; bj < 2; ++bj) { const f32x4 v0 = acc[ai][bj][m][0], v1 = acc[ai][bj][m][1];
                    u32x4 w; w.x = cvt_pk_bf16(v0[0], v0[1]); w.y = cvt_pk_bf16(v0[2], v0[3]); w.z = cvt_pk_bf16(v1[0], v1[1]); w.w = cvt_pk_bf16(v1[2], v1[3]);
                    *(u32x4*)(rowp + bj * HALF) = w; } }
    }
};
template <class Epi, class Sched, bool ALIGN_EPI = false, bool SP2 = false>
__device__ __forceinline__ void gemm_phase(PG8_LAS unsigned char* lds, const Gemm g, const Sched& S, const Epi& E) {
    int tid_ = threadIdx.x; asm volatile("" : "+v"(tid_));
    const int tid = tid_, wid = __builtin_amdgcn_readfirstlane(tid >> 6), lane = tid & 63, wr = wid >> 2, wc = wid & 3, fr = lane & 15, fq = lane >> 4;
    const int K = g.K, nt = K / BK;
    unsigned voffA[2], voffB[2];
#pragma unroll
    for (int i = 0; i < 2; ++i) { int R, C; stage_rc(tid * 16 + i * 8192, R, C); const int Rb = Epi::PERM ? ((R & ~31) + perm32(R & 31)) : R;
        voffA[i] = (unsigned)(R * K + C) * 2u; voffB[i] = (unsigned)(Rb * K + C) * 2u; }
    const size_t kstep = (size_t)(BK * 2);
    const size_t hstep = (size_t)HALF * K * 2;
    const size_t tstep = 2 * hstep;
    const unsigned ldsw = (unsigned)wid * 1024u;
    const int aoff = lds_byte(wr * 64 + fr, fq * 8), boff = lds_byte(wc * 32 + fr, fq * 8);
#define PG8_SA(b, h) (((b) * 2 + (h)) * HTB)
#define PG8_SB(b, h) ((4 + (b) * 2 + (h)) * HTB)
#define PG8_STAGE(bufoff, gbase, voff) do { _Pragma("unroll") for (int _i = 0; _i < 2; ++_i) \
        __builtin_amdgcn_global_load_lds((const unsigned*)((const char*)(gbase) + (voff)[_i]), (PG8_LAS unsigned*)(lds + (bufoff) + ldsw + _i * 8192), 16, 0, 0); } while (0)
#define PG8_LDA(dst, b, h) do { _Pragma("unroll") for (int m = 0; m < 4; ++m) _Pragma("unroll") for (int k = 0; k < 2; ++k) dst[m][k] = *(const PG8_LAS bf16x8*)(lds + PG8_SA(b, h) + aoff + m * 2048 + k * 1024); } while (0)
#define PG8_LDB(dst, b, h) do { _Pragma("unroll") for (int n = 0; n < 2; ++n) _Pragma("unroll") for (int k = 0; k < 2; ++k) dst[n][k] = *(const PG8_LAS bf16x8*)(lds + PG8_SB(b, h) + boff + n * 2048 + k * 1024); } while (0)
#define PG8_MMA(ai, bj, At, Bt) do { __builtin_amdgcn_s_setprio(1); _Pragma("unroll") for (int m = 0; m < 4; ++m) _Pragma("unroll") for (int n = 0; n < 2; ++n) _Pragma("unroll") for (int k = 0; k < 2; ++k) \
        acc[ai][bj][m][n] = __builtin_amdgcn_mfma_f32_16x16x32_bf16(Bt[n][k], At[m][k], acc[ai][bj][m][n], 0, 0, 0); __builtin_amdgcn_s_setprio(0); } while (0)
#define PG8_WAIT_V(n) asm volatile("s_waitcnt vmcnt(" #n ")" ::: "memory")
#define PG8_WAIT_L(n) asm volatile("s_waitcnt lgkmcnt(" #n ")" ::: "memory")
#define PG8_BAR __builtin_amdgcn_s_barrier()
#define PG8_SCHED __builtin_amdgcn_sched_barrier(0)
    Unit cur, nxt; int ui = 0;
    if (!S.next(0, cur)) return;
    f32x4 acc[2][2][4][2];
#pragma unroll
    for (int a = 0; a < 2; ++a)
#pragma unroll
        for (int b = 0; b < 2; ++b)
#pragma unroll
            for (int m = 0; m < 4; ++m)
#pragma unroll
                for (int n = 0; n < 2; ++n) acc[a][b][m][n] = (f32x4){0.f, 0.f, 0.f, 0.f};
    bf16x8 At[4][2], B0[2][2], B1[2][2];
    const char* cA = (const char*)g.A + (size_t)cur.pm * tstep; const char* cB = (const char*)g.Bt + (size_t)cur.pn * tstep;
    S.a_ready(cur);
    if constexpr (SP2) {
        PG8_STAGE(PG8_SB(0, 0), cB, voffB); PG8_STAGE(PG8_SB(0, 1), cB + hstep, voffB); PG8_STAGE(PG8_SA(0, 0), cA, voffA); PG8_STAGE(PG8_SA(0, 1), cA + hstep, voffA);
        if (wr == 1) PG8_BAR;
        PG8_WAIT_V(2); PG8_BAR;
        PG8_STAGE(PG8_SB(1, 0), cB + kstep, voffB); PG8_STAGE(PG8_SA(1, 0), cA + kstep, voffA); PG8_STAGE(PG8_SB(1, 1), cB + hstep + kstep, voffB);
        PG8_WAIT_V(6); PG8_BAR;
    } else {
        PG8_STAGE(PG8_SB(0, 0), cB, voffB); PG8_STAGE(PG8_SA(0, 0), cA, voffA); PG8_STAGE(PG8_SB(0, 1), cB + hstep, voffB); PG8_STAGE(PG8_SA(0, 1), cA + hstep, voffA);
        if (wr == 1) PG8_BAR;
        PG8_WAIT_V(4); PG8_BAR;
        PG8_STAGE(PG8_SB(1, 0), cB + kstep, voffB); PG8_STAGE(PG8_SA(1, 0), cA + kstep, voffA); PG8_STAGE(PG8_SB(1, 1), cB + hstep + kstep, voffB);
        PG8_WAIT_V(6); PG8_BAR;
    }
    for (;;) {
        const bool has_next = S.next(ui + 1, nxt);
        const char* nA = has_next ? (const char*)g.A + (size_t)nxt.pm * tstep : cA; const char* nB = has_next ? (const char*)g.Bt + (size_t)nxt.pn * tstep : cB;
        for (int t = 0; t < nt; t += 2) {
            const bool last = (t == nt - 2);
            const char* a1 = cA + (size_t)(t + 1) * kstep;
            const char* a2 = last ? nA : cA + (size_t)(t + 2) * kstep; const char* b2 = last ? nB : cB + (size_t)(t + 2) * kstep;
            const char* a3 = a2 + kstep; const char* b3 = b2 + kstep;
            if (last && has_next) S.a_ready(nxt);
            if constexpr (SP2) {
            PG8_LDB(B0, 0, 0); PG8_LDB(B1, 0, 1); PG8_SCHED; PG8_LDA(At, 0, 0); PG8_STAGE(PG8_SA(1, 1), a1 + hstep, voffA);
            PG8_WAIT_V(8); PG8_WAIT_L(0); PG8_BAR; PG8_MMA(0, 0, At, B0); PG8_MMA(0, 1, At, B1); PG8_BAR; PG8_SCHED;
            PG8_LDA(At, 0, 1); PG8_STAGE(PG8_SB(0, 0), b2, voffB); PG8_STAGE(PG8_SB(0, 1), b2 + hstep, voffB); PG8_STAGE(PG8_SA(0, 0), a2, voffA);
            PG8_WAIT_V(8); PG8_WAIT_L(0); PG8_BAR; PG8_MMA(1, 0, At, B0); PG8_MMA(1, 1, At, B1); PG8_BAR; PG8_SCHED;
            PG8_LDB(B0, 1, 0); PG8_LDB(B1, 1, 1); PG8_SCHED; PG8_LDA(At, 1, 0); PG8_STAGE(PG8_SA(0, 1), a2 + hstep, voffA);
            PG8_WAIT_V(8); PG8_WAIT_L(0); PG8_BAR; PG8_MMA(0, 0, At, B0); PG8_MMA(0, 1, At, B1); PG8_BAR; PG8_SCHED;
            PG8_LDA(At, 1, 1); PG8_STAGE(PG8_SB(1, 0), b3, voffB); PG8_STAGE(PG8_SB(1, 1), b3 + hstep, voffB); PG8_STAGE(PG8_SA(1, 0), a3, voffA);
            PG8_WAIT_V(8); PG8_WAIT_L(0); PG8_BAR; PG8_MMA(1, 0, At, B0); PG8_MMA(1, 1, At, B1); PG8_BAR; PG8_SCHED;
            } else {
            PG8_LDB(B0, 0, 0); PG8_SCHED; PG8_LDA(At, 0, 0); PG8_STAGE(PG8_SA(1, 1), a1 + hstep, voffA);
            PG8_WAIT_L(8); PG8_BAR; PG8_WAIT_L(0); PG8_MMA(0, 0, At, B0); PG8_BAR; PG8_SCHED;
            PG8_LDB(B1, 0, 1); PG8_STAGE(PG8_SB(0, 0), b2, voffB);
            PG8_BAR; PG8_WAIT_L(0); PG8_MMA(0, 1, At, B1); PG8_BAR;
            PG8_LDA(At, 0, 1); PG8_STAGE(PG8_SA(0, 0), a2, voffA);
            PG8_BAR; PG8_WAIT_L(0); PG8_MMA(1, 0, At, B0); PG8_BAR; PG8_SCHED;
            PG8_STAGE(PG8_SB(0, 1), b2 + hstep, voffB);
            PG8_WAIT_V(6); PG8_BAR; PG8_MMA(1, 1, At, B1); PG8_BAR;
            PG8_LDB(B0, 1, 0); PG8_SCHED; PG8_LDA(At, 1, 0); PG8_STAGE(PG8_SA(0, 1), a2 + hstep, voffA);
            PG8_WAIT_L(8); PG8_BAR; PG8_WAIT_L(0); PG8_MMA(0, 0, At, B0); PG8_BAR; PG8_SCHED;
            PG8_LDB(B1, 1, 1); PG8_STAGE(PG8_SB(1, 0), b3, voffB);
            PG8_BAR; PG8_WAIT_L(0); PG8_MMA(0, 1, At, B1); PG8_BAR;
            PG8_LDA(At, 1, 1); PG8_STAGE(PG8_SA(1, 0), a3, voffA);
            PG8_BAR; PG8_WAIT_L(0); PG8_MMA(1, 0, At, B0); PG8_BAR; PG8_SCHED;
            PG8_STAGE(PG8_SB(1, 1), b3 + hstep, voffB);
            PG8_WAIT_V(6); PG8_BAR; PG8_MMA(1, 1, At, B1); PG8_BAR;
            }
        }
        if constexpr (ALIGN_EPI) { if (wr == 0) PG8_BAR; }
        if constexpr (!Epi::AFTER_DRAIN) { E(acc, cur, wr, wc, fr, fq); S.done(cur); }
        if (!has_next) break;
#pragma unroll
        for (int a = 0; a < 2; ++a)
#pragma unroll
            for (int b = 0; b < 2; ++b)
#pragma unroll
                for (int m = 0; m < 4; ++m)
#pragma unroll
                    for (int n = 0; n < 2; ++n) acc[a][b][m][n] = (f32x4){0.f, 0.f, 0.f, 0.f};
        cur = nxt; cA = nA; cB = nB; ++ui;
        if constexpr (ALIGN_EPI) { if (wr == 1) PG8_BAR; }
    }
    PG8_WAIT_V(0);
    if constexpr (!ALIGN_EPI) { if (wr == 0) PG8_BAR; }
    PG8_BAR;
    if constexpr (Epi::AFTER_DRAIN) { E.fused(acc, cur, wr, wc, fr, fq, lds, wid, lane); S.done(cur); }
#undef PG8_SA
#undef PG8_SB
#undef PG8_STAGE
#undef PG8_LDA
#undef PG8_LDB
#undef PG8_MMA
#undef PG8_WAIT_V
#undef PG8_WAIT_L
#undef PG8_BAR
#undef PG8_SCHED
}
}

#define LAS __attribute__((address_space(3)))
typedef unsigned short bf16_t;
typedef short bf16x8 __attribute__((ext_vector_type(8)));
typedef float f32x4 __attribute__((ext_vector_type(4)));
typedef float f32x16 __attribute__((ext_vector_type(16)));
typedef unsigned u32x4 __attribute__((ext_vector_type(4)));
typedef unsigned u32x2 __attribute__((ext_vector_type(2)));
#define MFMA32(a, b, c) __builtin_amdgcn_mfma_f32_32x32x16_bf16((a), (b), (c), 0, 0, 0)

constexpr int DM = 1024, SEQ = 8192, LCTX = 256, ML = 2 * SEQ, MC = 2 * LCTX, MT = ML + MC;
constexpr int PW = 2560, FF = 2816, INW = 2304, KVT = SEQ + LCTX, NCH = 66;
constexpr int C_QA = 0, C_KA = 256, C_VA = 384, C_QB = 512, C_KB = 768, C_VB = 896, C_FR = 1024, C_FI = 1280, C_RQ = 1536, C_RK = 1792, C_RV = 2048, C_RG = 2304;
constexpr float LN_EPS = 1e-6f, ALPHA = 1.4142135623730951f, LOG2E = 1.4426950408889634f, QSCALE = 0.125f * 1.4426950408889634f;
constexpr size_t KiB = 1024, MiB = 1024 * 1024;
constexpr size_t OFF_MOD = 0, OFF_ROPEG = 256 * KiB, OFF_TW = 320 * KiB, OFF_F128R = 384 * KiB, OFF_F128I = 416 * KiB, OFF_C64 = 448 * KiB, OFF_S64 = 456 * KiB,
                 OFF_C256 = 512 * KiB, OFF_S256 = 640 * KiB, OFF_ROPES = 1 * MiB, OFF_XC = 3 * MiB,
                 OFF_WIN = 5 * MiB, OFF_WOUT = 10 * MiB, OFF_WGU = 12 * MiB, OFF_WDN = 23 * MiB, OFF_H = 29 * MiB, OFF_P = 62 * MiB,
                 OFF_MIX = 153 * MiB, OFF_VAT = 186 * MiB, OFF_VBT = 191 * MiB, OFF_TB = 196 * MiB, OFF_SLOC = 212 * MiB, OFF_ST = 229 * MiB,
                 OFF_Y2 = 196 * MiB, WS_NEED = 238 * MiB;
constexpr int LDS_BYTES = 147456;
constexpr size_t OFF_BAR = 208 * KiB;
#define RLX_AGENT __ATOMIC_RELAXED, __HIP_MEMORY_SCOPE_AGENT

struct Params { const float* in[20]; float* out; unsigned char* ws; int n_steps, pad; };

__device__ __forceinline__ unsigned f2bf(float f) { unsigned u = __builtin_bit_cast(unsigned, f); return (u + 0x7fffu + ((u >> 16) & 1u)) >> 16; }
typedef float f32x2_t __attribute__((ext_vector_type(2))); typedef __bf16 bf16x2_t __attribute__((ext_vector_type(2)));
__device__ __forceinline__ unsigned pk2(float lo, float hi) { f32x2_t v = {lo, hi}; bf16x2_t b = __builtin_convertvector(v, bf16x2_t); return __builtin_bit_cast(unsigned, b); }
__device__ __forceinline__ float xhalf_max(float v) { auto rr = __builtin_amdgcn_permlane32_swap(__float_as_uint(v), __float_as_uint(v), false, false); return fmaxf(__uint_as_float(rr[0]), __uint_as_float(rr[1])); }
__device__ __forceinline__ float xhalf_sum(float v) { auto rr = __builtin_amdgcn_permlane32_swap(__float_as_uint(v), __float_as_uint(v), false, false); return __uint_as_float(rr[0]) + __uint_as_float(rr[1]); }
__device__ __forceinline__ float bflo(unsigned w) { return __builtin_bit_cast(float, w << 16); }
__device__ __forceinline__ float bfhi(unsigned w) { return __builtin_bit_cast(float, w & 0xffff0000u); }
__device__ __forceinline__ float bf2f(bf16_t h) { return __builtin_bit_cast(float, (unsigned)h << 16); }
__device__ __forceinline__ int crow(int r, int hi) { return (r & 3) + 8 * (r >> 2) + 4 * hi; }
__device__ __forceinline__ float wave_sum(float v) {
#pragma unroll
    for (int o = 1; o < 64; o <<= 1) v += __shfl_xor(v, o);
    return v;
}
__device__ __forceinline__ bf16x8 pack8(float a0, float a1, float a2, float a3, float a4, float a5, float a6, float a7) {
    u32x4 p; p.x = pk2(a0, a1); p.y = pk2(a2, a3); p.z = pk2(a4, a5); p.w = pk2(a6, a7); return __builtin_bit_cast(bf16x8, p);
}
__device__ __forceinline__ bf16x8 join8(u32x2 lo, u32x2 hi) { u32x4 p; p.x = lo.x; p.y = lo.y; p.z = hi.x; p.w = hi.y; return __builtin_bit_cast(bf16x8, p); }
__device__ __forceinline__ void sincos_red(float ang, float& c, float& s) {
    const double a = (double)ang; const double k = rint(a * 0.15915494309189535); const float r = (float)(a - k * 6.283185307179586);
    c = cosf(r); s = sinf(r);
}
__device__ __forceinline__ float logsig(float x) { return -log1pf(expf(-x)); }
#define LDSW() asm volatile("s_waitcnt lgkmcnt(0)" ::: "memory")

__device__ __forceinline__ void ph_tables(unsigned char* ws, int gtid, int NT) {
    float2* ropeg = (float2*)(ws + OFF_ROPEG);
    for (int i = gtid; i < 128 * 16; i += NT) { const int p = i >> 4, f = i & 15; const float inv = exp2f(-(float)f * (13.287712379549449f / 16.f)); float c, s; sincos_red((float)p * inv, c, s); ropeg[i] = make_float2(c, s); }
    float2* ropes = (float2*)(ws + OFF_ROPES);
    for (int i = gtid; i < SEQ * 32; i += NT) { const int p = i >> 5, f = i & 31; const float inv = exp2f(-(float)f * (13.287712379549449f / 32.f)); float c, s; sincos_red((float)p * inv, c, s); ropes[i] = make_float2(c, s); }
    float2* tw = (float2*)(ws + OFF_TW);
    for (int i = gtid; i < 8192; i += NT) { const float a = (float)i * (1.0f / 4096.0f); tw[i] = make_float2(cospif(a), sinpif(a)); }
    bf16_t* f128r = (bf16_t*)(ws + OFF_F128R); bf16_t* f128i = (bf16_t*)(ws + OFF_F128I);
    for (int i = gtid; i < 128 * 128; i += NT) { const int m = ((i >> 7) * (i & 127)) & 127; const float a = (float)m * (1.0f / 64.0f); f128r[i] = (bf16_t)f2bf(cospif(a)); f128i[i] = (bf16_t)f2bf(-sinpif(a)); }
    bf16_t* c64 = (bf16_t*)(ws + OFF_C64); bf16_t* s64 = (bf16_t*)(ws + OFF_S64);
    for (int i = gtid; i < 64 * 64; i += NT) { const int m = ((i >> 6) * (i & 63)) & 63; const float a = (float)m * (1.0f / 32.0f); c64[i] = (bf16_t)f2bf(cospif(a)); s64[i] = (bf16_t)f2bf(sinpif(a)); }
    bf16_t* c256 = (bf16_t*)(ws + OFF_C256); bf16_t* s256 = (bf16_t*)(ws + OFF_S256);
    for (int i = gtid; i < 256 * 256; i += NT) { const int m = ((i >> 8) * (i & 255)) & 255; const float a = (float)m * (1.0f / 128.0f); c256[i] = (bf16_t)f2bf(cospif(a)); s256[i] = (bf16_t)f2bf(sinpif(a)); }
}

__device__ __forceinline__ void ph_mod(const float* c, const float* c_ctx, const float* w_mod, const float* b_mod, float* modv, unsigned char* lds, int tid, int bid, int G) {
    float* sc = (float*)lds; float* part = sc + 3 * 1024;
    if (bid >= 48 && G >= 48) return;
    for (int i = tid; i < 3072; i += 512) { const int v = i >> 10, k = i & 1023; const float cv = v < 2 ? c[v * 1024 + k] : c_ctx[k]; sc[i] = cv / (1.0f + expf(-cv)); }
    __syncthreads();
    for (int u = bid; u < 48; u += (G >= 48 ? 48 : G)) {
        const int layer = u / 24, cgp = u % 24, cq = tid & 63, kg = tid >> 6;
        const float* w = w_mod + (size_t)layer * 1024 * 6144 + cgp * 256 + 4 * cq;
        f32x4 a0 = {0.f, 0.f, 0.f, 0.f}, a1 = a0, a2 = a0;
        for (int k0 = kg * 128; k0 < kg * 128 + 128; k0 += 16) {
            f32x4 wv[16];
#pragma unroll
            for (int e = 0; e < 16; ++e) wv[e] = *(const f32x4*)(w + (size_t)(k0 + e) * 6144);
#pragma unroll
            for (int e = 0; e < 16; ++e) { a0 += wv[e] * sc[k0 + e]; a1 += wv[e] * sc[1024 + k0 + e]; a2 += wv[e] * sc[2048 + k0 + e]; }
        }
        *(f32x4*)(part + (kg * 3 + 0) * 256 + 4 * cq) = a0; *(f32x4*)(part + (kg * 3 + 1) * 256 + 4 * cq) = a1; *(f32x4*)(part + (kg * 3 + 2) * 256 + 4 * cq) = a2;
        __syncthreads();
        for (int t = tid; t < 768; t += 512) { const int v = t >> 8, cc = t & 255; float s = 0.f;
#pragma unroll
            for (int k2 = 0; k2 < 8; ++k2) s += part[(k2 * 3 + v) * 256 + cc];
            modv[(layer * 3 + v) * 6144 + cgp * 256 + cc] = s + b_mod[layer * 6144 + cgp * 256 + cc]; }
        __syncthreads();
    }
}

__device__ __forceinline__ void transpose_item(const float* W, int ldw, int k0, int nsrc0, bf16_t* WT, int K, int drow0, float* scr, int lane) {
    f32x4 wv[8];
#pragma unroll
    for (int i = 0; i < 8; ++i) wv[i] = *(const f32x4*)(W + (size_t)(k0 + (lane >> 3) + 8 * i) * ldw + nsrc0 + 4 * (lane & 7));
#pragma unroll
    for (int i = 0; i < 8; ++i) { float* d = scr + ((lane >> 3) + 8 * i) * 33 + 4 * (lane & 7); d[0] = wv[i].x; d[1] = wv[i].y; d[2] = wv[i].z; d[3] = wv[i].w; }
    LDSW();
    const int c = lane & 7;
#pragma unroll
    for (int j = 0; j < 4; ++j) { const int n = (lane >> 3) + 8 * j; const float* s = scr + (8 * c) * 33 + n;
        u32x4 o; o.x = pk2(s[0 * 33], s[1 * 33]); o.y = pk2(s[2 * 33], s[3 * 33]); o.z = pk2(s[4 * 33], s[5 * 33]); o.w = pk2(s[6 * 33], s[7 * 33]);
        *(u32x4*)(WT + (size_t)(drow0 + n) * K + k0 + 8 * c) = o; }
    LDSW();
}

__device__ __forceinline__ void ph_weights(const Params& p, int layer, unsigned char* lds, int tid, int bid_in, int G_in, int skip = 0) {
    if (G_in < 2 * skip) skip = 0;
    if (bid_in < skip) return;
    const int bid = bid_in - skip, G = G_in - skip;
    unsigned char* ws = p.ws;
    const float* w_in = p.in[6] + (size_t)layer * DM * INW; const float* fmix = p.in[10] + (size_t)layer * 4 * 64 * 64;
    const float* w_out = p.in[13] + (size_t)layer * DM * DM; const float* w_gu = p.in[16] + (size_t)layer * DM * 2 * FF; const float* w_dn = p.in[17] + (size_t)layer * FF * DM;
    bf16_t* Win = (bf16_t*)(ws + OFF_WIN); bf16_t* Wout = (bf16_t*)(ws + OFF_WOUT); bf16_t* Wgu = (bf16_t*)(ws + OFF_WGU); bf16_t* Wdn = (bf16_t*)(ws + OFF_WDN);
    const int lane = tid & 63, wave = tid >> 6;
    float* Gm = (float*)lds; float* wt = Gm + 4096; float* trig = wt + 64 * 65; float* Fm = trig + 128;
    if (bid < 128) { if (tid < 128) { const float a = (float)(tid & 63) * (1.0f / 32.0f); trig[tid] = tid < 64 ? cospif(a) : -sinpif(a); } __syncthreads(); }
    for (int u = bid; u < 128; u += G) {
        const int kb = u >> 3, g = (u >> 1) & 3, ri = u & 1;
        {
#pragma unroll
            for (int i = 0; i < 8; ++i) { const int idx = tid + 512 * i; Fm[idx] = fmix[(size_t)g * 4096 + idx]; }
#pragma unroll
            for (int i = 0; i < 8; ++i) { const int idx = tid + 512 * i; const int kk = idx >> 6, cc = idx & 63; wt[kk * 65 + cc] = w_in[(size_t)(kb * 64 + kk) * INW + 1024 + 64 * g + cc]; } }
        __syncthreads();
        { const int ci = tid >> 3, e0 = (tid & 7) * 8; float acc[8];
#pragma unroll
          for (int e = 0; e < 8; ++e) acc[e] = 0.f;
          for (int cp = 0; cp < 64; ++cp) { const int m = (ci * cp) & 63; const float tr = trig[64 * ri + m];
              const float* fr = Fm + cp * 64 + e0;
#pragma unroll
              for (int e = 0; e < 8; ++e) acc[e] += tr * fr[e]; }
#pragma unroll
          for (int e = 0; e < 8; ++e) Gm[ci * 64 + e0 + e] = acc[e] * 0.125f; }
        __syncthreads();
        { const int e = tid & 63, kk0 = (tid >> 6) * 8; float acc[8];
#pragma unroll
          for (int q = 0; q < 8; ++q) acc[q] = 0.f;
          for (int cc = 0; cc < 64; ++cc) { const float gv = Gm[cc * 64 + e];
#pragma unroll
              for (int q = 0; q < 8; ++q) acc[q] += wt[(kk0 + q) * 65 + cc] * gv; }
          u32x4 o; o.x = pk2(acc[0], acc[1]); o.y = pk2(acc[2], acc[3]); o.z = pk2(acc[4], acc[5]); o.w = pk2(acc[6], acc[7]);
          *(u32x4*)(Win + (size_t)(1024 + ri * 256 + g * 64 + e) * DM + kb * 64 + kk0) = o; }
        __syncthreads();
    }
    float* scr = (float*)lds + wave * 2176;
    const int gw = bid * 8 + wave, NGW = G * 8;
    for (int it = gw; it < 5760; it += NGW) {
        int r = it;
        if (r < 512) { transpose_item(w_in, INW, 64 * (r >> 5), 32 * (r & 31), Win, DM, 32 * (r & 31), scr, lane); continue; } r -= 512;
        if (r < 512) { transpose_item(w_in, INW, 64 * (r >> 5), 1280 + 32 * (r & 31), Win, DM, 1536 + 32 * (r & 31), scr, lane); continue; } r -= 512;
        if (r < 512) { transpose_item(w_out, DM, 64 * (r >> 5), 32 * (r & 31), Wout, DM, 32 * (r & 31), scr, lane); continue; } r -= 512;
        if (r < 2816) { const int kb = r / 176, n0 = 32 * (r % 176); const int bj = n0 / FF, rr = n0 % FF; const int drow = (rr >> 7) * 256 + bj * 128 + (rr & 127);
            transpose_item(w_gu, 2 * FF, 64 * kb, n0, Wgu, DM, drow, scr, lane); continue; } r -= 2816;
        transpose_item(w_dn, DM, 64 * (r >> 5), 32 * (r & 31), Wdn, FF, 32 * (r & 31), scr, lane);
    }
}

__device__ __forceinline__ void ln_stats(const f32x4 (&v)[4], float& mean, float& rstd) {
    float s = 0.f;
#pragma unroll
    for (int j = 0; j < 4; ++j) s += (v[j].x + v[j].y) + (v[j].z + v[j].w);
    mean = wave_sum(s) * (1.0f / DM); float q = 0.f;
#pragma unroll
    for (int j = 0; j < 4; ++j) { const f32x4 d = v[j] - mean; q += (d.x * d.x + d.y * d.y) + (d.z * d.z + d.w * d.w); }
    rstd = rsqrtf(wave_sum(q) * (1.0f / DM) + LN_EPS);
}
__device__ __forceinline__ void store_h(bf16_t* hrow, const f32x4 (&v)[4], float mean, float rstd, const float* sh, const float* scl, int lane) {
#pragma unroll
    for (int j = 0; j < 4; ++j) { const int col = 4 * lane + 256 * j; const f32x4 s = *(const f32x4*)(scl + col), t = *(const f32x4*)(sh + col);
        const f32x4 y = (v[j] - mean) * rstd * (s + 1.0f) + t; u32x2 w; w.x = pk2(y.x, y.y); w.y = pk2(y.z, y.w); *(u32x2*)(hrow + col) = w; }
}
__device__ __forceinline__ void ph_h0(const Params& p, int gw, int NGW, int lane) {
    const float* modv = (const float*)(p.ws + OFF_MOD); bf16_t* H = (bf16_t*)(p.ws + OFF_H);
    f32x4 xn[4];
    if (gw < MT) { const float* src = gw < ML ? p.in[0] + (size_t)gw * DM : p.in[2] + (size_t)(gw - ML) * DM;
#pragma unroll
        for (int j = 0; j < 4; ++j) xn[j] = *(const f32x4*)(src + 4 * lane + 256 * j); }
    for (int row = gw; row < MT; row += NGW) {
        const float* mod = modv + (size_t)(row < ML ? (row >> 13) : 2) * 6144;
        f32x4 v[4], sv[4], tv[4];
#pragma unroll
        for (int j = 0; j < 4; ++j) { v[j] = xn[j]; sv[j] = *(const f32x4*)(mod + 1024 + 4 * lane + 256 * j); tv[j] = *(const f32x4*)(mod + 4 * lane + 256 * j); }
        const int nrow = row + NGW;
        if (nrow < MT) { const float* src = nrow < ML ? p.in[0] + (size_t)nrow * DM : p.in[2] + (size_t)(nrow - ML) * DM;
#pragma unroll
            for (int j = 0; j < 4; ++j) xn[j] = *(const f32x4*)(src + 4 * lane + 256 * j); }
        float mean, rstd; ln_stats(v, mean, rstd);
        bf16_t* hrow = H + (size_t)row * DM;
#pragma unroll
        for (int j = 0; j < 4; ++j) { const f32x4 y = (v[j] - mean) * rstd * (sv[j] + 1.0f) + tv[j]; u32x2 w; w.x = pk2(y.x, y.y); w.y = pk2(y.z, y.w); *(u32x2*)(hrow + 4 * lane + 256 * j) = w; }
    }
}
__device__ __forceinline__ void ph_rowpass(const Params& p, int layer, int which, int mrows, bool do_h, int gw, int NGW, int lane) {
    const float* modv = (const float*)(p.ws + OFF_MOD); bf16_t* H = (bf16_t*)(p.ws + OFF_H);
    const bf16_t* Y = (const bf16_t*)(p.ws + (which == 0 ? OFF_P : OFF_Y2));
    const float* lw = p.in[which == 0 ? 14 : 18] + layer * DM; const float* lb = p.in[which == 0 ? 15 : 19] + layer * DM;
    float* xc = (float*)(p.ws + OFF_XC);
    const bool from_in = (layer == 0 && which == 0);
    f32x4 lwv[4], lbv[4], xn[4]; u32x2 yn[4];
#pragma unroll
    for (int j = 0; j < 4; ++j) { lwv[j] = *(const f32x4*)(lw + 4 * lane + 256 * j); lbv[j] = *(const f32x4*)(lb + 4 * lane + 256 * j); }
#define RP_SRC(r) (from_in ? ((r) < ML ? p.in[0] + (size_t)(r) * DM : p.in[2] + (size_t)((r) - ML) * DM) : ((r) < ML ? (const float*)p.out + (size_t)(r) * DM : (const float*)xc + (size_t)((r) - ML) * DM))
    if (gw < mrows) { const float* src = RP_SRC(gw);
#pragma unroll
        for (int j = 0; j < 4; ++j) { xn[j] = *(const f32x4*)(src + 4 * lane + 256 * j); yn[j] = *(const u32x2*)(Y + (size_t)gw * DM + 4 * lane + 256 * j); } }
    for (int row = gw; row < mrows; row += NGW) {
        float* xs = row < ML ? p.out + (size_t)row * DM : xc + (size_t)(row - ML) * DM;
        const int vi = row < ML ? (row >> 13) : 2;
        const float* mod = modv + (size_t)(layer * 3 + vi) * 6144;
        const float* gate = mod + (which == 0 ? 2048 : 5120);
        const float* mod2 = which == 0 ? mod + 3072 : modv + (size_t)((layer + 1) * 3 + vi) * 6144;
        f32x4 v[4], sv[4], tv[4];
#pragma unroll
        for (int j = 0; j < 4; ++j) { const int col = 4 * lane + 256 * j; const f32x4 g = *(const f32x4*)(gate + col);
            f32x4 y; y.x = bflo(yn[j].x); y.y = bfhi(yn[j].x); y.z = bflo(yn[j].y); y.w = bfhi(yn[j].y);
            v[j] = xn[j] * ALPHA + g * y;
            if (do_h) { sv[j] = *(const f32x4*)(mod2 + 1024 + col); tv[j] = *(const f32x4*)(mod2 + col); } }
        const int nrow = row + NGW;
        if (nrow < mrows) { const float* src = RP_SRC(nrow);
#pragma unroll
            for (int j = 0; j < 4; ++j) { xn[j] = *(const f32x4*)(src + 4 * lane + 256 * j); yn[j] = *(const u32x2*)(Y + (size_t)nrow * DM + 4 * lane + 256 * j); } }
        float mean, rstd; ln_stats(v, mean, rstd);
#pragma unroll
        for (int j = 0; j < 4; ++j) { const int col = 4 * lane + 256 * j; v[j] = (v[j] - mean) * rstd * lwv[j] + lbv[j];
#ifdef SELFCHECK
            if (layer == 1 && which == 1) { const unsigned fl = *(const unsigned*)(p.ws + 200 * 1024); v[j] = v[j] * (1.0f + 0.1f * (float)(fl & 15u)); }
#endif
            *(f32x4*)(xs + col) = v[j]; }
        if (do_h) {
            ln_stats(v, mean, rstd);
            bf16_t* hrow = H + (size_t)row * DM;
#pragma unroll
            for (int j = 0; j < 4; ++j) { const f32x4 y = (v[j] - mean) * rstd * (sv[j] + 1.0f) + tv[j]; u32x2 w; w.x = pk2(y.x, y.y); w.y = pk2(y.z, y.w); *(u32x2*)(hrow + 4 * lane + 256 * j) = w; }
        }
    }
#undef RP_SRC
}
#define XB_TMO      128
#define XB_XCNT(j)  (256  + 64 * (j))
#define XB_XSUB(j)  (1280 + 64 * (j))
#define XB_XGEN(j)  (2304 + 64 * (j))
#define XB_TOP      3328
#define XB_TOPGEN   3392
#define XCD_BAR_WORDS 3456
#define XB_SPIN_CAP (1u << 18)

__device__ __forceinline__ unsigned xb_ld(unsigned* p)              { return __hip_atomic_load(p, __ATOMIC_RELAXED, __HIP_MEMORY_SCOPE_AGENT); }
__device__ __forceinline__ unsigned xb_add(unsigned* p, unsigned v) { return __hip_atomic_fetch_add(p, v, __ATOMIC_RELAXED, __HIP_MEMORY_SCOPE_AGENT); }
__device__ __forceinline__ unsigned xb_xcc_id() { return (unsigned)__builtin_amdgcn_s_getreg((3 << 11) | 20) & 0xFu; }
#define XB_SPIN(cond, bar) do { unsigned _sp = 0; while (cond) { __builtin_amdgcn_s_sleep(1); \
    if ((++_sp & 255u) == 0u) { if (xb_ld(&(bar)[XB_TMO])) break; if (_sp > XB_SPIN_CAP) { atomicAdd(&(bar)[XB_TMO], 1u); break; } } } } while (0)

struct XcdBarrier {
    unsigned* bar; unsigned x;
    volatile LAS unsigned* st;
};

__device__ __forceinline__ XcdBarrier xcd_barrier_post(unsigned* bar, volatile LAS unsigned* st) {
    XcdBarrier b; b.bar = bar; b.x = xb_xcc_id(); b.st = st;
    if (threadIdx.x == 0) (void)xb_add(&bar[XB_XCNT(b.x)], 1u);
    return b;
}
__device__ __forceinline__ void xcd_barrier_complete(unsigned* bar, unsigned x, unsigned& nloc, unsigned& nx) {
    const unsigned G = gridDim.x * gridDim.y * gridDim.z;
    unsigned sum, cnt, mine, sp = 0u;
    for (;;) {
        sum = 0u; cnt = 0u; mine = 0u;
#pragma unroll
        for (unsigned j = 0; j < 16; ++j) { const unsigned c = xb_ld(&bar[XB_XCNT(j)]); sum += c; cnt += (c > 0u) ? 1u : 0u; mine = (j == x) ? c : mine; }
        if (sum == G) break;
        __builtin_amdgcn_s_sleep(1);
        if ((++sp & 255u) == 0u) { if (xb_ld(&bar[XB_TMO])) break; if (sp > XB_SPIN_CAP) { atomicAdd(&bar[XB_TMO], 1u); break; } }
    }
    nloc = mine > 0u ? mine : 1u; nx = cnt > 0u ? cnt : 1u;
}

__device__ __forceinline__ void xcd_barrier(const XcdBarrier& b) {
    asm volatile("s_waitcnt vmcnt(0)" ::: "memory");
    __syncthreads();
    if (threadIdx.x == 0) {
        unsigned* bar = b.bar;
        __builtin_amdgcn_s_waitcnt(0);
        unsigned nloc = b.st[0], nx = b.st[1];
        if (nloc == 0u) { xcd_barrier_complete(bar, b.x, nloc, nx); b.st[0] = nloc; b.st[1] = nx; }
        const unsigned old = xb_add(&bar[XB_XSUB(b.x)], 1u);
        const unsigned gen = old / nloc;
        if (old + 1u == (gen + 1u) * nloc) {
            __builtin_amdgcn_fence(__ATOMIC_RELEASE, "agent");
            asm volatile("s_waitcnt vmcnt(0)" ::: "memory");
            const unsigned og = xb_add(&bar[XB_TOP], 1u);
            const unsigned tg = og / nx;
            if (og + 1u == (tg + 1u) * nx) xb_add(&bar[XB_TOPGEN], 1u);
            else XB_SPIN(xb_ld(&bar[XB_TOPGEN]) == tg, bar);
            __builtin_amdgcn_fence(__ATOMIC_ACQUIRE, "agent");
            xb_add(&bar[XB_XGEN(b.x)], 1u);
            asm volatile("s_waitcnt vmcnt(0)" ::: "memory");
        } else {
            XB_SPIN(xb_ld(&bar[XB_XGEN(b.x)]) == gen, bar);
            __builtin_amdgcn_fence(__ATOMIC_ACQUIRE, "agent");
            asm volatile("s_waitcnt vmcnt(0)" ::: "memory");
        }
    }
    __syncthreads();
}

__device__ __forceinline__ void ph_prep(const Params& p, int layer, unsigned char* lds, int gw, int NGW, int lane, int wave) {
    bf16_t* P = (bf16_t*)(p.ws + OFF_P); const float2* ropeg = (const float2*)(p.ws + OFF_ROPEG);
    const float* aqn = p.in[7] + layer * 64; const float* akn = p.in[8] + layer * 64;
    for (int it = gw; it < (MT * 12) / 64; it += NGW) {
        const int item = it * 64 + lane; const int row = item / 12, s = item % 12;
        int col; bool isq, norm; const float* nw = aqn;
        if (s < 4) { col = C_QA + 64 * s; isq = true; norm = true; }
        else if (s < 6) { col = C_KA + 64 * (s - 4); isq = false; norm = true; nw = akn; }
        else if (s < 10) { col = C_QB + 64 * (s - 6); isq = true; norm = false; }
        else { col = C_KB + 64 * (s - 10); isq = false; norm = false; }
        bf16_t* ptr = P + (size_t)row * PW + col;
        u32x4 w[8];
#pragma unroll
        for (int q = 0; q < 8; ++q) w[q] = *(const u32x4*)(ptr + 8 * q);
        float x[64];
#pragma unroll
        for (int q = 0; q < 8; ++q) { x[8 * q + 0] = bflo(w[q].x); x[8 * q + 1] = bfhi(w[q].x); x[8 * q + 2] = bflo(w[q].y); x[8 * q + 3] = bfhi(w[q].y);
            x[8 * q + 4] = bflo(w[q].z); x[8 * q + 5] = bfhi(w[q].z); x[8 * q + 6] = bflo(w[q].w); x[8 * q + 7] = bfhi(w[q].w); }
        if (norm) { float ss = 0.f;
#pragma unroll
            for (int e = 0; e < 64; ++e) ss += x[e] * x[e];
            const float r = rsqrtf(ss * (1.0f / 64.0f) + LN_EPS);
#pragma unroll
            for (int e = 0; e < 64; ++e) x[e] *= r * nw[e]; }
        if (row < ML) { const int t = row & (SEQ - 1); const float2* ra = ropeg + (t >> 6) * 16; const float2* rb = ropeg + (t & 63) * 16;
#pragma unroll
            for (int e = 0; e < 16; ++e) { const float2 a = ra[e], bq = rb[e];
                const float y0 = x[e] * a.x - x[16 + e] * a.y, y1 = x[16 + e] * a.x + x[e] * a.y, y2 = x[32 + e] * bq.x - x[48 + e] * bq.y, y3 = x[48 + e] * bq.x + x[32 + e] * bq.y;
                x[e] = y0; x[16 + e] = y1; x[32 + e] = y2; x[48 + e] = y3; } }
        const float qs = isq ? QSCALE : 1.0f;
#pragma unroll
        for (int q = 0; q < 8; ++q) { u32x4 o; o.x = pk2(x[8 * q] * qs, x[8 * q + 1] * qs); o.y = pk2(x[8 * q + 2] * qs, x[8 * q + 3] * qs); o.z = pk2(x[8 * q + 4] * qs, x[8 * q + 5] * qs); o.w = pk2(x[8 * q + 6] * qs, x[8 * q + 7] * qs);
            *(u32x4*)(ptr + 8 * q) = o; }
    }
    bf16_t* scr = (bf16_t*)lds + wave * 4608;
    for (int u = gw; u < 1056; u += NGW) {
        const int tile = u % 132, r = u / 132; const int kvh = r & 1, b = (r >> 1) & 1, which = r >> 2;
        const int row = tile < 128 ? b * SEQ + tile * 64 + lane : ML + b * LCTX + (tile - 128) * 64 + lane;
        const bf16_t* src = P + (size_t)row * PW + (which ? C_VB : C_VA) + 64 * kvh;
#pragma unroll
        for (int q = 0; q < 8; ++q) *(u32x4*)(scr + lane * 72 + 8 * q) = *(const u32x4*)(src + 8 * q);
        LDSW();
        bf16_t* dst = (bf16_t*)(p.ws + (which ? OFF_VBT : OFF_VAT)) + (size_t)((b * 2 + kvh) * 64 + lane) * KVT + tile * 64;
#pragma unroll
        for (int q = 0; q < 8; ++q) { u32x4 o;
            const int t0 = 16 * (q >> 1) + 4 * (q & 1), t1 = t0 + 8;
            o.x = (unsigned)scr[(t0 + 0) * 72 + lane] | ((unsigned)scr[(t0 + 1) * 72 + lane] << 16); o.y = (unsigned)scr[(t0 + 2) * 72 + lane] | ((unsigned)scr[(t0 + 3) * 72 + lane] << 16);
            o.z = (unsigned)scr[(t1 + 0) * 72 + lane] | ((unsigned)scr[(t1 + 1) * 72 + lane] << 16); o.w = (unsigned)scr[(t1 + 2) * 72 + lane] | ((unsigned)scr[(t1 + 3) * 72 + lane] << 16);
            *(u32x4*)(dst + 8 * q) = o; }
        LDSW();
    }
}

__device__ __forceinline__ int ret_row(int b, int j, int s) { return j < 2 ? ML + b * LCTX + j * 128 + s : b * SEQ + (j - 2) * 128 + s; }
__device__ __forceinline__ void ret_load_rot(const bf16_t* P, const float2* ropes, int b, int j, int s, int q4, int col, float (&lo)[8], float (&hi)[8]) {
    const bf16_t* pk = P + (size_t)ret_row(b, j, s) * PW + col;
    const u32x4 a = *(const u32x4*)(pk + 8 * q4), c = *(const u32x4*)(pk + 32 + 8 * q4);
    lo[0] = bflo(a.x); lo[1] = bfhi(a.x); lo[2] = bflo(a.y); lo[3] = bfhi(a.y); lo[4] = bflo(a.z); lo[5] = bfhi(a.z); lo[6] = bflo(a.w); lo[7] = bfhi(a.w);
    hi[0] = bflo(c.x); hi[1] = bfhi(c.x); hi[2] = bflo(c.y); hi[3] = bfhi(c.y); hi[4] = bflo(c.z); hi[5] = bfhi(c.z); hi[6] = bflo(c.w); hi[7] = bfhi(c.w);
    if (j >= 2) { const int t = (j - 2) * 128 + s;
#pragma unroll
        for (int e = 0; e < 8; ++e) { const float2 cs = ropes[t * 32 + 8 * q4 + e]; const float y1 = lo[e] * cs.x - hi[e] * cs.y, y2 = hi[e] * cs.x + lo[e] * cs.y; lo[e] = y1; hi[e] = y2; } }
}
__device__ __forceinline__ void ret_load_vt(const bf16_t* P, bf16_t* VT, int b, int h, int j, int s, int q4) {
    const bf16_t* pv = P + (size_t)ret_row(b, j, s) * PW + C_RV + 64 * h + 16 * q4;
    const u32x4 a = *(const u32x4*)pv, c = *(const u32x4*)(pv + 8);
    bf16_t* d = VT + (16 * q4) * 136 + s;
    d[0 * 136] = (bf16_t)a.x; d[1 * 136] = (bf16_t)(a.x >> 16); d[2 * 136] = (bf16_t)a.y; d[3 * 136] = (bf16_t)(a.y >> 16);
    d[4 * 136] = (bf16_t)a.z; d[5 * 136] = (bf16_t)(a.z >> 16); d[6 * 136] = (bf16_t)a.w; d[7 * 136] = (bf16_t)(a.w >> 16);
    d[8 * 136] = (bf16_t)c.x; d[9 * 136] = (bf16_t)(c.x >> 16); d[10 * 136] = (bf16_t)c.y; d[11 * 136] = (bf16_t)(c.y >> 16);
    d[12 * 136] = (bf16_t)c.z; d[13 * 136] = (bf16_t)(c.z >> 16); d[14 * 136] = (bf16_t)c.w; d[15 * 136] = (bf16_t)(c.w >> 16);
}
__device__ __forceinline__ void ph_ret_local(const Params& p, int layer, unsigned char* lds, int tid, int bid, int G) {
    const bf16_t* P = (const bf16_t*)(p.ws + OFF_P); const float2* ropes = (const float2*)(p.ws + OFF_ROPES); float* Sloc = (float*)(p.ws + OFF_SLOC);
    bf16_t* KTf = (bf16_t*)lds; bf16_t* KTb = KTf + 64 * 136; bf16_t* VT = KTb + 64 * 136;
    const int lane = tid & 63, wave = tid >> 6, l31 = lane & 31, hi = lane >> 5, s = tid >> 2, q4 = tid & 3;
    for (int u = bid; u < 8 * NCH; u += G) {
        const int j = u % NCH, bh = u / NCH, b = bh >> 2, h = bh & 3;
        const float lgf = logsig(p.in[11][layer * 8 + h]), lgb = logsig(p.in[11][layer * 8 + 4 + h]);
        float lo[8], hi8[8]; ret_load_rot(P, ropes, b, j, s, q4, C_RK + 64 * h, lo, hi8);
        const float wf = expf(lgf * (float)(127 - s)) * 0.125f, wb = expf(lgb * (float)s) * 0.125f;
#pragma unroll
        for (int e = 0; e < 8; ++e) { const int d = 8 * q4 + e;
            KTf[d * 136 + s] = (bf16_t)f2bf(lo[e] * wf); KTf[(d + 32) * 136 + s] = (bf16_t)f2bf(hi8[e] * wf);
            KTb[d * 136 + s] = (bf16_t)f2bf(lo[e] * wb); KTb[(d + 32) * 136 + s] = (bf16_t)f2bf(hi8[e] * wb); }
        ret_load_vt(P, VT, b, h, j, s, q4);
        __syncthreads();
        const int dir = wave & 1, mb = (wave >> 1) & 1, nb = wave >> 2;
        const bf16_t* KT = dir ? KTb : KTf;
        f32x16 acc;
#pragma unroll
        for (int r = 0; r < 16; ++r) acc[r] = 0.f;
#pragma unroll
        for (int c = 0; c < 8; ++c) { const bf16x8 a = *(const bf16x8*)(VT + (32 * mb + l31) * 136 + 16 * c + 8 * hi); const bf16x8 bb = *(const bf16x8*)(KT + (32 * nb + l31) * 136 + 16 * c + 8 * hi);
            acc = MFMA32(a, bb, acc); }
        float* dst = Sloc + ((size_t)((bh * 2 + dir) * NCH + j)) * 4096 + 32 * nb + l31;
#pragma unroll
        for (int r = 0; r < 16; ++r) dst[(32 * mb + crow(r, hi)) * 64] = acc[r];
        __syncthreads();
    }
}
__device__ __forceinline__ void ph_ret_scan(const Params& p, int layer, int gtid, int NT) {
    const float* Sloc = (const float*)(p.ws + OFF_SLOC); bf16_t* St = (bf16_t*)(p.ws + OFF_ST);
    for (int e = gtid; e < 16 * 4096; e += NT) {
        const int seq = e >> 12, el = e & 4095, dir = seq & 1, h = (seq >> 1) & 3;
        const float g = expf(logsig(p.in[11][layer * 8 + dir * 4 + h]) * 128.0f);
        const float* sl = Sloc + (size_t)seq * NCH * 4096 + el; bf16_t* st = St + (size_t)seq * NCH * 4096 + el;
        float S = 0.f;
        if (dir == 0) {
#pragma unroll 11
            for (int j = 0; j < NCH; ++j) { st[(size_t)j * 4096] = (bf16_t)f2bf(S); S = S * g + sl[(size_t)j * 4096]; } }
        else { st[4096] = (bf16_t)f2bf(S); S = S * g + sl[4096]; st[0] = (bf16_t)f2bf(S); S = S * g + sl[0];
#pragma unroll 8
            for (int j = NCH - 1; j >= 2; --j) { st[(size_t)j * 4096] = (bf16_t)f2bf(S); S = S * g + sl[(size_t)j * 4096]; } }
    }
}
__device__ __forceinline__ void ret_rot_regs(const u32x4& a, const u32x4& c, const float2* ropes, int j, int s, int q4, float (&lo)[8], float (&hi)[8]) {
    lo[0] = bflo(a.x); lo[1] = bfhi(a.x); lo[2] = bflo(a.y); lo[3] = bfhi(a.y); lo[4] = bflo(a.z); lo[5] = bfhi(a.z); lo[6] = bflo(a.w); lo[7] = bfhi(a.w);
    hi[0] = bflo(c.x); hi[1] = bfhi(c.x); hi[2] = bflo(c.y); hi[3] = bfhi(c.y); hi[4] = bflo(c.z); hi[5] = bfhi(c.z); hi[6] = bflo(c.w); hi[7] = bfhi(c.w);
    if (j >= 2) { const int t = (j - 2) * 128 + s;
#pragma unroll
        for (int e = 0; e < 8; ++e) { const float2 cs = ropes[t * 32 + 8 * q4 + e]; const float y1 = lo[e] * cs.x - hi[e] * cs.y, y2 = hi[e] * cs.x + lo[e] * cs.y; lo[e] = y1; hi[e] = y2; } }
}
__device__ __forceinline__ void ph_ret_out(const Params& p, int layer, unsigned char* lds, int tid, int bid, int G) {
    const bf16_t* P = (const bf16_t*)(p.ws + OFF_P); const float2* ropes = (const float2*)(p.ws + OFF_ROPES); const bf16_t* St = (const bf16_t*)(p.ws + OFF_ST);
    bf16_t* MIX = (bf16_t*)(p.ws + OFF_MIX); const float* gnw = p.in[12] + layer * 256;
    bf16_t* Qs = (bf16_t*)lds; bf16_t* Ks = Qs + 128 * 72; bf16_t* VT = Ks + 128 * 72; float* red = (float*)(VT + 64 * 136);
    const int lane = tid & 63, wave = tid >> 6, l31 = lane & 31, hi = lane >> 5, s = tid >> 2, q4 = tid & 3;
    const int jlo = layer == 0 ? 0 : 2, nj = NCH - jlo, total = 8 * nj;
    u32x4 qa, qc, ka, kc, va, vc;
#define R3_LOAD(uu) do { const int j_ = jlo + (uu) % nj, bh_ = (uu) / nj; const bf16_t* pr_ = P + (size_t)ret_row(bh_ >> 2, j_, s) * PW + 64 * (bh_ & 3); \
        qa = *(const u32x4*)(pr_ + C_RQ + 8 * q4); qc = *(const u32x4*)(pr_ + C_RQ + 32 + 8 * q4); ka = *(const u32x4*)(pr_ + C_RK + 8 * q4); kc = *(const u32x4*)(pr_ + C_RK + 32 + 8 * q4); \
        va = *(const u32x4*)(pr_ + C_RV + 16 * q4); vc = *(const u32x4*)(pr_ + C_RV + 16 * q4 + 8); } while (0)
    if (bid < total) R3_LOAD(bid);
    for (int u = bid; u < total; u += G) {
        const int j = jlo + u % nj, bh = u / nj, b = bh >> 2, h = bh & 3;
        const float lgf = logsig(p.in[11][layer * 8 + h]), lgb = logsig(p.in[11][layer * 8 + 4 + h]);
        { float lo[8], hi8[8]; ret_rot_regs(qa, qc, ropes, j, s, q4, lo, hi8);
          *(bf16x8*)(Qs + s * 72 + 8 * q4) = pack8(lo[0], lo[1], lo[2], lo[3], lo[4], lo[5], lo[6], lo[7]);
          *(bf16x8*)(Qs + s * 72 + 32 + 8 * q4) = pack8(hi8[0], hi8[1], hi8[2], hi8[3], hi8[4], hi8[5], hi8[6], hi8[7]);
          ret_rot_regs(ka, kc, ropes, j, s, q4, lo, hi8);
          *(bf16x8*)(Ks + s * 72 + 8 * q4) = pack8(lo[0] * 0.125f, lo[1] * 0.125f, lo[2] * 0.125f, lo[3] * 0.125f, lo[4] * 0.125f, lo[5] * 0.125f, lo[6] * 0.125f, lo[7] * 0.125f);
          *(bf16x8*)(Ks + s * 72 + 32 + 8 * q4) = pack8(hi8[0] * 0.125f, hi8[1] * 0.125f, hi8[2] * 0.125f, hi8[3] * 0.125f, hi8[4] * 0.125f, hi8[5] * 0.125f, hi8[6] * 0.125f, hi8[7] * 0.125f); }
        { bf16_t* d = VT + (16 * q4) * 136 + s;
          d[0 * 136] = (bf16_t)va.x; d[1 * 136] = (bf16_t)(va.x >> 16); d[2 * 136] = (bf16_t)va.y; d[3 * 136] = (bf16_t)(va.y >> 16);
          d[4 * 136] = (bf16_t)va.z; d[5 * 136] = (bf16_t)(va.z >> 16); d[6 * 136] = (bf16_t)va.w; d[7 * 136] = (bf16_t)(va.w >> 16);
          d[8 * 136] = (bf16_t)vc.x; d[9 * 136] = (bf16_t)(vc.x >> 16); d[10 * 136] = (bf16_t)vc.y; d[11 * 136] = (bf16_t)(vc.y >> 16);
          d[12 * 136] = (bf16_t)vc.z; d[13 * 136] = (bf16_t)(vc.z >> 16); d[14 * 136] = (bf16_t)vc.w; d[15 * 136] = (bf16_t)(vc.w >> 16); }
        if (u + G < total) R3_LOAD(u + G);
        const int rb = wave & 3, dh = wave >> 2, iq = 32 * rb + l31;
        const size_t row = (size_t)ret_row(b, j, iq);
        bf16x8 sff[4], sbf[4]; u32x2 gwv[4];
        { const bf16_t* stf = St + ((size_t)((bh * 2 + 0) * NCH + j)) * 4096 + (32 * dh + l31) * 64 + 8 * hi;
          const bf16_t* stb = St + ((size_t)((bh * 2 + 1) * NCH + j)) * 4096 + (32 * dh + l31) * 64 + 8 * hi;
#pragma unroll
          for (int c = 0; c < 4; ++c) { sff[c] = *(const bf16x8*)(stf + 16 * c); sbf[c] = *(const bf16x8*)(stb + 16 * c); }
#pragma unroll
          for (int g = 0; g < 4; ++g) gwv[g] = *(const u32x2*)(P + row * PW + C_RG + 64 * h + 32 * dh + 8 * g + 4 * hi); }
        __syncthreads();
        bf16x8 qf[4];
#pragma unroll
        for (int c = 0; c < 4; ++c) qf[c] = *(const bf16x8*)(Qs + iq * 72 + 16 * c + 8 * hi);
        const float lgf2 = lgf * LOG2E, lgb2 = lgb * LOG2E;
        f32x16 o;
#pragma unroll
        for (int r = 0; r < 16; ++r) o[r] = 0.f;
#pragma unroll 1
        for (int sb = 0; sb < 4; ++sb) {
            f32x16 sa;
#pragma unroll
            for (int r = 0; r < 16; ++r) sa[r] = 0.f;
#pragma unroll
            for (int c = 0; c < 4; ++c) { const bf16x8 kf = *(const bf16x8*)(Ks + (32 * sb + l31) * 72 + 16 * c + 8 * hi); sa = MFMA32(kf, qf[c], sa); }
#pragma unroll
            for (int r = 0; r < 16; ++r) { const int dl = iq - (32 * sb + crow(r, hi));
                const float w = dl > 0 ? exp2f(lgf2 * (float)dl) : (dl < 0 ? exp2f(lgb2 * (float)(-dl)) : 2.0f); sa[r] *= w; }
#pragma unroll
            for (int c2 = 0; c2 < 2; ++c2) {
                const bf16x8 pa = pack8(sa[8 * c2 + 0], sa[8 * c2 + 1], sa[8 * c2 + 2], sa[8 * c2 + 3], sa[8 * c2 + 4], sa[8 * c2 + 5], sa[8 * c2 + 6], sa[8 * c2 + 7]);
                const bf16_t* vp = VT + (32 * dh + l31) * 136 + 32 * sb + 16 * c2 + 4 * hi;
                const bf16x8 vf = join8(*(const u32x2*)vp, *(const u32x2*)(vp + 8));
                o = MFMA32(vf, pa, o); }
        }
        f32x16 uf, ub;
#pragma unroll
        for (int r = 0; r < 16; ++r) { uf[r] = 0.f; ub[r] = 0.f; }
#pragma unroll
        for (int c = 0; c < 4; ++c) { uf = MFMA32(sff[c], qf[c], uf); ub = MFMA32(sbf[c], qf[c], ub); }
        const float xf = exp2f(lgf2 * (float)(iq + 1)), xb = exp2f(lgb2 * (float)(128 - iq));
        float sm = 0.f, sq = 0.f;
#pragma unroll
        for (int r = 0; r < 16; ++r) { o[r] += xf * uf[r] + xb * ub[r]; sm += o[r]; sq += o[r] * o[r]; }
        sm += __shfl_xor(sm, 32); sq += __shfl_xor(sq, 32);
        if (hi == 0) { red[(iq * 2 + dh) * 2 + 0] = sm; red[(iq * 2 + dh) * 2 + 1] = sq; }
        __syncthreads();
        const float tsum = red[(iq * 2 + 0) * 2 + 0] + red[(iq * 2 + 1) * 2 + 0], tsq = red[(iq * 2 + 0) * 2 + 1] + red[(iq * 2 + 1) * 2 + 1];
        const float mean = tsum * (1.0f / 64.0f), var = tsq * (1.0f / 64.0f) - mean * mean, rstd = rsqrtf(fmaxf(var, 0.f) + LN_EPS);
#pragma unroll
        for (int g = 0; g < 4; ++g) { const int d = 32 * dh + 8 * g + 4 * hi;
            const u32x2 gw = gwv[g]; const f32x4 nw = *(const f32x4*)(gnw + 64 * h + d);
            const float g0 = bflo(gw.x), g1 = bfhi(gw.x), g2 = bflo(gw.y), g3 = bfhi(gw.y);
            const float y0 = (o[4 * g + 0] - mean) * rstd * nw.x * (g0 / (1.0f + __expf(-g0))), y1 = (o[4 * g + 1] - mean) * rstd * nw.y * (g1 / (1.0f + __expf(-g1)));
            const float y2 = (o[4 * g + 2] - mean) * rstd * nw.z * (g2 / (1.0f + __expf(-g2))), y3 = (o[4 * g + 3] - mean) * rstd * nw.w * (g3 / (1.0f + __expf(-g3)));
            u32x2 w; w.x = pk2(y0, y1); w.y = pk2(y2, y3); *(u32x2*)(MIX + row * DM + 768 + 64 * h + d) = w; }
        __syncthreads();
    }
#undef R3_LOAD
}

__device__ __forceinline__ bf16x8 gather8(const bf16_t* base, size_t stride) {
    u32x4 o; o.x = (unsigned)base[0] | ((unsigned)base[stride] << 16); o.y = (unsigned)base[2 * stride] | ((unsigned)base[3 * stride] << 16);
    o.z = (unsigned)base[4 * stride] | ((unsigned)base[5 * stride] << 16); o.w = (unsigned)base[6 * stride] | ((unsigned)base[7 * stride] << 16); return __builtin_bit_cast(bf16x8, o);
}
__device__ __forceinline__ bf16x8 neg8(bf16x8 v) { u32x4 o = __builtin_bit_cast(u32x4, v); o.x ^= 0x80008000u; o.y ^= 0x80008000u; o.z ^= 0x80008000u; o.w ^= 0x80008000u; return __builtin_bit_cast(bf16x8, o); }
__device__ __forceinline__ void ph_four_a(const Params& p, unsigned char* lds, int gw, int NGW, int lane, int wave) {
    const bf16_t* P = (const bf16_t*)(p.ws + OFF_P); bf16_t* TB = (bf16_t*)(p.ws + OFF_TB); const float2* tw = (const float2*)(p.ws + OFF_TW);
    const bf16_t* F_r = (const bf16_t*)(p.ws + OFF_F128R); const bf16_t* F_i = (const bf16_t*)(p.ws + OFF_F128I);
    const int l31 = lane & 31, hi = lane >> 5, wv = __builtin_amdgcn_readfirstlane(wave);
    const bf16_t* ys = (const bf16_t*)lds + wv * 8192;
    for (int u = gw; u < 2048; u += NGW) {
        const int mh = u & 1, nb = (u >> 1) & 7, l2 = (u >> 4) & 63, b = u >> 10;
        { const bf16_t* src = P + (size_t)(b * SEQ + 64 * (lane >> 2) + l2) * PW + C_FR + 32 * nb + 8 * (lane & 3);
#pragma unroll
          for (int q = 0; q < 16; ++q)
              __builtin_amdgcn_global_load_lds((const unsigned*)(src + (size_t)(64 * 16 * (q & 7)) * PW + 256 * (q >> 3)), (LAS unsigned*)((LAS unsigned char*)lds + wv * 16384 + q * 1024), 16, 0, 0); }
        f32x16 tr[2], ti[2];
#pragma unroll
        for (int m = 0; m < 2; ++m)
#pragma unroll
            for (int r = 0; r < 16; ++r) { tr[m][r] = 0.f; ti[m][r] = 0.f; }
        asm volatile("s_waitcnt vmcnt(0)" ::: "memory");
#pragma unroll 4
        for (int c = 0; c < 8; ++c) {
            const bf16_t* yb = ys + (16 * c + 8 * hi) * 32 + l31;
            const bf16x8 yr = gather8(yb, 32), yi = gather8(yb + 4096, 32), nyi = neg8(yi);
#pragma unroll
            for (int m = 0; m < 2; ++m) { const int k1 = 32 * (2 * mh + m) + l31;
                const bf16x8 fr = *(const bf16x8*)(F_r + k1 * 128 + 16 * c + 8 * hi), fi = *(const bf16x8*)(F_i + k1 * 128 + 16 * c + 8 * hi);
                tr[m] = MFMA32(fr, yr, tr[m]); tr[m] = MFMA32(fi, nyi, tr[m]); ti[m] = MFMA32(fr, yi, ti[m]); ti[m] = MFMA32(fi, yr, ti[m]); }
        }
        LDSW();
#pragma unroll
        for (int m = 0; m < 2; ++m)
#pragma unroll
            for (int r = 0; r < 16; ++r) { const int k1 = 32 * (2 * mh + m) + crow(r, hi); const float2 w = tw[l2 * k1];
                const float a = tr[m][r] * w.x + ti[m][r] * w.y, bb = ti[m][r] * w.x - tr[m][r] * w.y;
                bf16_t* dst = TB + ((size_t)((b * 128 + k1) * 64 + l2)) * 512 + 32 * nb + l31; dst[0] = (bf16_t)f2bf(a); dst[256] = (bf16_t)f2bf(bb); }
    }
}
__device__ __forceinline__ void ph_four_b(const Params& p, unsigned char* lds, int gw, int NGW, int lane, int wave) {
    const bf16_t* TB = (const bf16_t*)(p.ws + OFF_TB); bf16_t* MIX = (bf16_t*)(p.ws + OFF_MIX);
    const bf16_t* C64 = (const bf16_t*)(p.ws + OFF_C64); const bf16_t* S64 = (const bf16_t*)(p.ws + OFF_S64);
    const int l31 = lane & 31, hi = lane >> 5, wv = __builtin_amdgcn_readfirstlane(wave);
    const bf16_t* xs = (const bf16_t*)lds + wv * 4096;
    for (int u = gw; u < 2048; u += NGW) {
        const int nb = u & 7, k1 = (u >> 3) & 127, b = u >> 10;
        const bf16_t* src = TB + ((size_t)((b * 128 + k1) * 64 + (lane >> 2))) * 512 + 32 * nb + 8 * (lane & 3);
#pragma unroll
        for (int q = 0; q < 8; ++q)
            __builtin_amdgcn_global_load_lds((const unsigned*)(src + (size_t)(16 * (q & 3)) * 512 + 256 * (q >> 2)), (LAS unsigned*)((LAS unsigned char*)lds + wv * 8192 + q * 1024), 16, 0, 0);
        f32x16 acc[2];
#pragma unroll
        for (int m = 0; m < 2; ++m)
#pragma unroll
            for (int r = 0; r < 16; ++r) acc[m][r] = 0.f;
        asm volatile("s_waitcnt vmcnt(0)" ::: "memory");
#pragma unroll
        for (int c = 0; c < 4; ++c) {
            const bf16_t* xb = xs + (16 * c + 8 * hi) * 32 + l31;
            const bf16x8 xr = gather8(xb, 32), xi = gather8(xb + 2048, 32);
#pragma unroll
            for (int m = 0; m < 2; ++m) { const bf16x8 cf = *(const bf16x8*)(C64 + (32 * m + l31) * 64 + 16 * c + 8 * hi), sf = *(const bf16x8*)(S64 + (32 * m + l31) * 64 + 16 * c + 8 * hi);
                acc[m] = MFMA32(cf, xr, acc[m]); acc[m] = MFMA32(sf, xi, acc[m]); }
        }
        LDSW();
#pragma unroll
        for (int m = 0; m < 2; ++m)
#pragma unroll
            for (int r = 0; r < 16; ++r) { const int lp = k1 + 128 * (32 * m + crow(r, hi));
                MIX[(size_t)(b * SEQ + lp) * DM + 512 + 32 * nb + l31] = (bf16_t)f2bf(acc[m][r] * 0.011048543456039806f); }
    }
}
__device__ __forceinline__ void ph_four_ctx(const Params& p, unsigned char* lds, int bid, int G, int lane, int wave) {
    const bf16_t* P = (const bf16_t*)(p.ws + OFF_P); bf16_t* MIX = (bf16_t*)(p.ws + OFF_MIX);
    const bf16_t* C256 = (const bf16_t*)(p.ws + OFF_C256); const bf16_t* S256 = (const bf16_t*)(p.ws + OFF_S256);
    const int l31 = lane & 31, hi = lane >> 5;
    if (__builtin_amdgcn_readfirstlane(wave) != 0) return;
    const bf16_t* ys = (const bf16_t*)lds;
    for (int u = bid; u < 128; u += G) {
        const int nb = u & 7, mb = (u >> 3) & 7, b = u >> 6;
        { const bf16_t* src = P + (size_t)(ML + b * LCTX + (lane >> 2)) * PW + C_FR + 32 * nb + 8 * (lane & 3);
#pragma unroll
          for (int q = 0; q < 32; ++q)
              __builtin_amdgcn_global_load_lds((const unsigned*)(src + (size_t)(16 * (q & 15)) * PW + 256 * (q >> 4)), (LAS unsigned*)((LAS unsigned char*)lds + q * 1024), 16, 0, 0); }
        f32x16 acc;
#pragma unroll
        for (int r = 0; r < 16; ++r) acc[r] = 0.f;
        asm volatile("s_waitcnt vmcnt(0)" ::: "memory");
#pragma unroll 4
        for (int c = 0; c < 16; ++c) {
            const bf16_t* yb = ys + (16 * c + 8 * hi) * 32 + l31;
            const bf16x8 yr = gather8(yb, 32), yi = gather8(yb + 8192, 32);
            const bf16x8 cf = *(const bf16x8*)(C256 + (32 * mb + l31) * 256 + 16 * c + 8 * hi), sf = *(const bf16x8*)(S256 + (32 * mb + l31) * 256 + 16 * c + 8 * hi);
            acc = MFMA32(cf, yr, acc); acc = MFMA32(sf, yi, acc);
        }
        LDSW();
#pragma unroll
        for (int r = 0; r < 16; ++r) MIX[(size_t)(ML + b * LCTX + 32 * mb + crow(r, hi)) * DM + 512 + 32 * nb + l31] = (bf16_t)f2bf(acc[r] * 0.0625f);
    }
}

#ifdef SELFCHECK
constexpr size_t OFF_FLAGS = 200 * KiB;
__device__ __forceinline__ unsigned hash32(unsigned x) { x ^= x >> 16; x *= 0x7feb352du; x ^= x >> 15; x *= 0x846ca68bu; x ^= x >> 16; return x; }
__device__ __forceinline__ void ph_selfcheck(const Params& p, int layer, int gw, int NGW, int lane) {
    const bf16_t* P = (const bf16_t*)(p.ws + OFF_P); const bf16_t* MIX = (const bf16_t*)(p.ws + OFF_MIX); unsigned* flags = (unsigned*)(p.ws + OFF_FLAGS);
    const float2* ropes = (const float2*)(p.ws + OFF_ROPES);
    for (int smp = gw; smp < 4096; smp += NGW) {
        const unsigned hsh = hash32(0x9e3779b9u * (unsigned)smp + 12345u);
        const int kind = smp & 3, b = (hsh >> 3) & 1, h = (hsh >> 4) & 3; const bool cx = (smp & 4) != 0;
        const int t = cx ? ((hsh >> 8) & 255) : ((hsh >> 8) & 8191);
        const int row = cx ? ML + b * LCTX + t : b * SEQ + t; const int d = lane;
        float ref = 0.f, got = 0.f;
        if (kind < 2) {
            const int isB = kind, kvh = h >> 1;
            const bf16_t* q = P + (size_t)row * PW + (isB ? C_QB : C_QA) + 64 * h;
            const int kcol = (isB ? C_KB : C_KA) + 64 * kvh, vcol = (isB ? C_VB : C_VA) + 64 * kvh;
            float mx = -1e30f;
            for (int pass = 0; pass < 2; ++pass) {
                float acc = 0.f, den = 0.f;
                for (int s = cx ? SEQ : 0; s < KVT; ++s) {
                    if (isB && s < SEQ) { int dd = s - t; dd = dd < 0 ? -dd : dd; if (dd > 128) continue; }
                    const int krow = s < SEQ ? b * SEQ + s : ML + b * LCTX + (s - SEQ);
                    const bf16_t* k = P + (size_t)krow * PW + kcol;
                    float sc = 0.f;
                    for (int e = 0; e < 64; ++e) sc += bf2f(q[e]) * bf2f(k[e]);
                    if (pass == 0) mx = fmaxf(mx, sc);
                    else { const float pr = exp2f(sc - mx); den += pr; acc += pr * bf2f(P[(size_t)krow * PW + vcol + d]); }
                }
                if (pass == 1) { if (isB) den += exp2f(p.in[9][layer * 4 + h] * LOG2E - mx); ref = acc / den; }
            }
            got = bf2f(MIX[(size_t)row * DM + (isB ? 256 : 0) + 64 * h + d]);
        } else if (kind == 2) {
            const int col = 64 * h + d; float acc = 0.f;
            if (!cx) { for (int l = 0; l < SEQ; ++l) { const int m = (l * t) & 8191; const float a = (float)m * (1.0f / 4096.0f);
                acc += cospif(a) * bf2f(P[(size_t)(b * SEQ + l) * PW + C_FR + col]) + sinpif(a) * bf2f(P[(size_t)(b * SEQ + l) * PW + C_FI + col]); }
              ref = acc * 0.011048543456039806f; }
            else { for (int l = 0; l < LCTX; ++l) { const int m = (l * t) & 255; const float a = (float)m * (1.0f / 128.0f);
                acc += cospif(a) * bf2f(P[(size_t)(ML + b * LCTX + l) * PW + C_FR + col]) + sinpif(a) * bf2f(P[(size_t)(ML + b * LCTX + l) * PW + C_FI + col]); }
              ref = acc * 0.0625f; }
            got = bf2f(MIX[(size_t)row * DM + 512 + col]);
        } else {
            const float lgf = logsig(p.in[11][layer * 8 + h]), lgb = logsig(p.in[11][layer * 8 + 4 + h]);
            float qv[64];
#pragma unroll
            for (int e = 0; e < 32; ++e) { const float x1 = bf2f(P[(size_t)row * PW + C_RQ + 64 * h + e]), x2 = bf2f(P[(size_t)row * PW + C_RQ + 64 * h + 32 + e]); const float2 cs = cx ? make_float2(1.f, 0.f) : ropes[t * 32 + e];
                qv[e] = x1 * cs.x - x2 * cs.y; qv[32 + e] = x2 * cs.x + x1 * cs.y; }
            float acc = 0.f;
            for (int s = cx ? SEQ : 0; s < KVT; ++s) {
                const int krow = s < SEQ ? b * SEQ + s : ML + b * LCTX + (s - SEQ);
                const bf16_t* k = P + (size_t)krow * PW + C_RK + 64 * h;
                float sc = 0.f;
#pragma unroll
                for (int e = 0; e < 32; ++e) { float x1 = bf2f(k[e]), x2 = bf2f(k[32 + e]);
                    if (s < SEQ) { const float2 cs = ropes[s * 32 + e]; const float y1 = x1 * cs.x - x2 * cs.y, y2 = x2 * cs.x + x1 * cs.y; x1 = y1; x2 = y2; }
                    sc += qv[e] * x1 + qv[32 + e] * x2; }
                sc *= 0.125f;
                float w;
                if (s < SEQ) { w = 0.f; if (s <= t) w += expf(lgf * (float)(t - s)); if (s >= t) w += expf(lgb * (float)(s - t)); }
                else if (!cx) { const int j = s - SEQ; w = expf(lgf * (float)(t + 256 - j)) + expf(lgb * (float)(8192 - t + j)); }
                else { const int j = s - SEQ; w = 0.f; if (j <= t) w += expf(lgf * (float)(t - j)); if (j >= t) w += expf(lgb * (float)(j - t)); }
                acc += w * sc * bf2f(P[(size_t)krow * PW + C_RV + 64 * h + d]);
            }
            const float mean = wave_sum(acc) * (1.0f / 64.0f); const float dv = acc - mean; const float var = wave_sum(dv * dv) * (1.0f / 64.0f);
            const float g = bf2f(P[(size_t)row * PW + C_RG + 64 * h + d]);
            ref = dv * rsqrtf(var + LN_EPS) * p.in[12][layer * 256 + 64 * h + d] * (g / (1.0f + expf(-g)));
            got = bf2f(MIX[(size_t)row * DM + 768 + 64 * h + d]);
        }
        const float e2 = wave_sum((ref - got) * (ref - got)), r2 = wave_sum(ref * ref);
        if (lane == 0 && !(e2 <= 0.0025f * r2 + 1e-12f)) atomicOr(flags, 1u << kind);
    }
}
#endif
#ifndef DBL
#define DBL 0
#endif
#define REP(k) for (int rep_ = 0; rep_ < 1 + ((DBL >> (k)) & 1); ++rep_)

template <bool masked, bool SAFE>
__device__ __forceinline__ bool attn_unit(const Params& p, int layer, unsigned char* lds, int tid, int b, int h, int qblk, int isB, int isctx) {
    const bf16_t* P = (const bf16_t*)(p.ws + OFF_P); bf16_t* MIX = (bf16_t*)(p.ws + OFF_MIX);
    bf16_t* Kt = (bf16_t*)lds;
    bf16_t* Vt = Kt + 4 * 4096;
    const int lane = tid & 63, wave = tid >> 6, l31 = lane & 31, hi = lane >> 5;
    const int kvh = h >> 1;
    const int qrow0 = isctx ? ML + b * LCTX : b * SEQ + 256 * qblk;
    int t_lo = 0, nlat = 128;
    if (isctx) nlat = 0; else if (isB) { t_lo = 4 * qblk - 2; if (t_lo < 0) t_lo = 0; int t_hi = 4 * qblk + 6; if (t_hi > 128) t_hi = 128; nlat = t_hi - t_lo; }
    const int ntile = nlat + 4;
    const int qcol = (isB ? C_QB : C_QA) + 64 * h, kcol = (isB ? C_KB : C_KA) + 64 * kvh;
    const bf16_t* VTg = (const bf16_t*)(p.ws + (isB ? OFF_VBT : OFF_VAT)) + (size_t)((b * 2 + kvh) * 64) * KVT;
    bf16x8 qf[4];
    { const bf16_t* qp = P + (size_t)(qrow0 + 32 * wave + l31) * PW + qcol + 8 * hi;
#pragma unroll
      for (int c = 0; c < 4; ++c) qf[c] = *(const bf16x8*)(qp + 16 * c); }
    const int qpos = 256 * qblk + 32 * wave + l31, qp0 = 256 * qblk + 32 * wave;
    f32x16 o0, o1;
#pragma unroll
    for (int r = 0; r < 16; ++r) { o0[r] = 0.f; o1[r] = 0.f; }
    float m = -1e30f, l = 0.f;
    f32x16 negm;
#pragma unroll
    for (int r = 0; r < 16; ++r) negm[r] = 0.f;
    bool first = true;
    const int wv = __builtin_amdgcn_readfirstlane(wave), dr = 8 * wv + (lane >> 3), dc = (lane & 7) ^ ((dr >> 1) & 7);
    const int sw = (l31 >> 1) & 7;
#define SWZ(idx) (8 * ((((idx) | hi)) ^ sw))
#define ATT_TILE(i) ((i) < nlat ? t_lo + (i) : 128 + (i) - nlat)
#define ATT_DMA(i, buf) do { const int t_ = ATT_TILE(i); const int krow_ = t_ < 128 ? b * SEQ + 64 * t_ + dr : ML + b * LCTX + 64 * (t_ - 128) + dr; \
    __builtin_amdgcn_global_load_lds((const unsigned*)(P + (size_t)krow_ * PW + kcol + 8 * dc), (LAS unsigned*)((LAS unsigned char*)lds + (buf) * 8192 + wv * 1024), 16, 0, 0); \
    __builtin_amdgcn_global_load_lds((const unsigned*)(VTg + (size_t)dr * KVT + 64 * t_ + 8 * dc), (LAS unsigned*)((LAS unsigned char*)lds + 32768 + (buf) * 8192 + wv * 1024), 16, 0, 0); } while (0)
    ATT_DMA(0, 0); ATT_DMA(1, 1);
    __syncthreads();
    for (int ip = 0; ip < ntile; ip += 2) {
      const int stage = (ip >> 1) & 1;
      if (ip + 2 < ntile) { ATT_DMA(ip + 2, (stage ^ 1) * 2); ATT_DMA(ip + 3, (stage ^ 1) * 2 + 1); }
#pragma unroll 1
      for (int sub = 0; sub < 2; ++sub) {
        const int i = ip + sub; const int buf = stage * 2 + sub;
        const int t = ATT_TILE(i);
        const bool lat = t < 128;
        const bool active = !(isB && lat) || (64 * t + 63 >= qp0 - 128 && 64 * t <= qp0 + 31 + 128);
        if (active) {
            const bf16_t* kb = Kt + buf * 4096 + l31 * 64;
            f32x16 s0, s1;
#define ATT_SCORES() do { s0 = MFMA32(*(const bf16x8*)(kb + SWZ(0)), qf[0], negm); s1 = MFMA32(*(const bf16x8*)(kb + 2048 + SWZ(0)), qf[0], negm); \
                _Pragma("unroll") for (int c = 1; c < 4; ++c) { s0 = MFMA32(*(const bf16x8*)(kb + SWZ(2 * c)), qf[c], s0); s1 = MFMA32(*(const bf16x8*)(kb + 2048 + SWZ(2 * c)), qf[c], s1); } } while (0)
#define ATT_MASK() do { if (masked && lat) { _Pragma("unroll") for (int r = 0; r < 16; ++r) { const int kp = 64 * t + crow(r, hi); int d0 = kp - qpos; d0 = d0 < 0 ? -d0 : d0; int d1 = kp + 32 - qpos; d1 = d1 < 0 ? -d1 : d1; \
                if (d0 > 128) s0[r] = -1e30f; if (d1 > 128) s1[r] = -1e30f; } } } while (0)
            ATT_SCORES();
            const bf16_t* vb = Vt + buf * 4096 + l31 * 64;
            const bf16x8 vf00 = *(const bf16x8*)(vb + SWZ(0)), vf01 = *(const bf16x8*)(vb + SWZ(4)), vf02 = *(const bf16x8*)(vb + SWZ(2)), vf03 = *(const bf16x8*)(vb + SWZ(6));
            const bf16x8 vf10 = *(const bf16x8*)(vb + 2048 + SWZ(0)), vf11 = *(const bf16x8*)(vb + 2048 + SWZ(4)), vf12 = *(const bf16x8*)(vb + 2048 + SWZ(2)), vf13 = *(const bf16x8*)(vb + 2048 + SWZ(6));
            __builtin_amdgcn_sched_barrier(0);
            ATT_MASK();
            {
                if (first) { first = false;
                    float mx = fmaxf(s0[0], s1[0]);
#pragma unroll
                    for (int r = 1; r < 16; ++r) mx = fmaxf(mx, fmaxf(s0[r], s1[r]));
                    m = xhalf_max(mx); if (masked) m = m < -1e29f ? 0.f : m;
#pragma unroll
                    for (int r = 0; r < 16; ++r) { s0[r] -= m; s1[r] -= m; negm[r] = -m; } }
                float ps = 0.f, ps1 = 0.f;
#pragma unroll
                for (int r = 0; r < 16; ++r) { s0[r] = __builtin_amdgcn_exp2f(s0[r]); s1[r] = __builtin_amdgcn_exp2f(s1[r]); ps += s0[r]; ps += s1[r]; }
                (void)ps1;
                if (SAFE && __any(!(ps <= 4096.0f))) {
                    ATT_SCORES(); ATT_MASK();
                    float mx = fmaxf(s0[0], s1[0]);
#pragma unroll
                    for (int r = 1; r < 16; ++r) mx = fmaxf(mx, fmaxf(s0[r], s1[r]));
                    mx = xhalf_max(mx);
                    const float dl = fmaxf(mx, 0.f), sc = __builtin_amdgcn_exp2f(-dl); m += dl; l *= sc; ps = 0.f;
#pragma unroll
                    for (int r = 0; r < 16; ++r) { o0[r] *= sc; o1[r] *= sc; negm[r] = -m; s0[r] = __builtin_amdgcn_exp2f(s0[r] - dl); s1[r] = __builtin_amdgcn_exp2f(s1[r] - dl); ps += s0[r] + s1[r]; }
                }
                l += ps;
            }
#undef ATT_MASK
#undef ATT_SCORES
            {   const bf16x8 pa00 = pack8(s0[0], s0[1], s0[2], s0[3], s0[4], s0[5], s0[6], s0[7]), pa10 = pack8(s1[0], s1[1], s1[2], s1[3], s1[4], s1[5], s1[6], s1[7]);
                const bf16x8 pa01 = pack8(s0[8], s0[9], s0[10], s0[11], s0[12], s0[13], s0[14], s0[15]), pa11 = pack8(s1[8], s1[9], s1[10], s1[11], s1[12], s1[13], s1[14], s1[15]);
                o0 = MFMA32(vf00, pa00, o0); o1 = MFMA32(vf10, pa00, o1);
                o0 = MFMA32(vf01, pa10, o0); o1 = MFMA32(vf11, pa10, o1);
                o0 = MFMA32(vf02, pa01, o0); o1 = MFMA32(vf12, pa01, o1);
                o0 = MFMA32(vf03, pa11, o0); o1 = MFMA32(vf13, pa11, o1);
            }
        }
      }
      __syncthreads();
    }
#undef ATT_TILE
#undef ATT_DMA
#undef SWZ
    l = xhalf_sum(l);
    const bool bad = !SAFE && __syncthreads_or(!(l < 1e30f) ? 1 : 0) != 0;
    if (bad) return true;
    if (isB) l += exp2f(p.in[9][layer * 4 + h] * LOG2E - m);
    const float inv = 1.0f / l;
    bf16_t* op = MIX + (size_t)(qrow0 + 32 * wave + l31) * DM + (isB ? 256 : 0) + 64 * h + 4 * hi;
#pragma unroll
    for (int g = 0; g < 4; ++g) { u32x2 w; w.x = pk2(o0[4 * g] * inv, o0[4 * g + 1] * inv); w.y = pk2(o0[4 * g + 2] * inv, o0[4 * g + 3] * inv); *(u32x2*)(op + 8 * g) = w;
        u32x2 w1; w1.x = pk2(o1[4 * g] * inv, o1[4 * g + 1] * inv); w1.y = pk2(o1[4 * g + 2] * inv, o1[4 * g + 3] * inv); *(u32x2*)(op + 32 + 8 * g) = w1; }
    return false;
}
__device__ __forceinline__ void ph_attn(const Params& p, int layer, unsigned char* lds, int tid, int bid, int G) {
    const int total = layer == 0 ? 528 : 512;
    for (int u = bid; u < total; u += G) {
        int b, h, qblk, isB, isctx;
        if (u < 512) { const int v = u & 255, grp = v & 3, idx = v >> 2; isB = u >> 8; isctx = 0; b = grp >> 1; h = (grp & 1) * 2 + (idx >> 5); qblk = idx & 31; }
        else { const int v = u - 512; isB = v >> 3; isctx = 1; b = (v >> 2) & 1; h = v & 3; qblk = 0; }
        if (isB && !isctx) { if (attn_unit<true, false>(p, layer, lds, tid, b, h, qblk, isB, isctx)) attn_unit<true, true>(p, layer, lds, tid, b, h, qblk, isB, isctx); }
        else { if (attn_unit<false, false>(p, layer, lds, tid, b, h, qblk, isB, isctx)) attn_unit<false, true>(p, layer, lds, tid, b, h, qblk, isB, isctx); }
    }
}

__device__ __forceinline__ void ph_ctx_gemm(const bf16_t* A, const bf16_t* Bt, bf16_t* O, int K, unsigned char* lds, int tid, int bid, int G) {
    const int lane = tid & 63, wave = tid >> 6, l31 = lane & 31, hi = lane >> 5, ks = wave & 3, Kq = K >> 2;
    float* red = (float*)lds;
    for (int tp = bid; tp < 256; tp += G) {
        const int tile = 2 * tp + (wave >> 2), mb = tile >> 5, nb = tile & 31;
        const bf16_t* ap = A + (size_t)(ML + 32 * mb + l31) * K + ks * Kq + 8 * hi; const bf16_t* bp = Bt + (size_t)(32 * nb + l31) * K + ks * Kq + 8 * hi;
        f32x16 acc;
#pragma unroll
        for (int r = 0; r < 16; ++r) acc[r] = 0.f;
#pragma unroll 8
        for (int c = 0; c < Kq / 16; ++c) acc = MFMA32(*(const bf16x8*)(ap + 16 * c), *(const bf16x8*)(bp + 16 * c), acc);
#pragma unroll
        for (int r = 0; r < 16; ++r) red[(wave * 16 + r) * 64 + lane] = acc[r];
        __syncthreads();
        if (ks == 0) {
#pragma unroll
            for (int r = 0; r < 16; ++r) { const float v = ((red[(wave * 16 + r) * 64 + lane] + red[((wave + 1) * 16 + r) * 64 + lane]) + red[((wave + 2) * 16 + r) * 64 + lane]) + red[((wave + 3) * 16 + r) * 64 + lane];
                O[(size_t)(ML + 32 * mb + crow(r, hi)) * DM + 32 * nb + l31] = (bf16_t)f2bf(v); } }
        __syncthreads();
    }
}

__global__ void __launch_bounds__(512, 2) fwd_megakernel(Params p_arg) {
    extern __shared__ __attribute__((aligned(16))) unsigned char lds[];
    cg::grid_group grid = cg::this_grid();
    const int n_steps = p_arg.n_steps;
    volatile LAS unsigned* bst = (volatile LAS unsigned*)((LAS unsigned char*)lds + 140000);
    if (threadIdx.x < 2) bst[threadIdx.x] = 0u;
    __syncthreads();
    const XcdBarrier xbar = xcd_barrier_post((unsigned*)(p_arg.ws + OFF_BAR), bst);
#define GRID_SYNC() do { if (n_steps < 0) grid.sync(); else xcd_barrier(xbar); } while (0)
#pragma unroll 1
    for (int step = 0; step < n_steps; ++step) {
        const __attribute__((address_space(4))) Params* pp = (const __attribute__((address_space(4))) Params*)__builtin_amdgcn_kernarg_segment_ptr();
        asm volatile("" : "+s"(pp));
#if defined(__HIP_DEVICE_COMPILE__)
        const Params p = *pp;
#else
        const Params p = p_arg;
#endif
        int bid = blockIdx.x; asm volatile("" : "+s"(bid));
        const int G = gridDim.x, NGW = G * 8, NT = G * 512;
        unsigned char* ws = p.ws;
        const int layer = step < 2 ? 0 : (step - 2) / 9, ph = step < 2 ? step : 2 + (step - 2) % 9;
        const bool last = layer == 1;
        const int mrows = last ? ML : MT;
        int gk = 0;
        const bf16_t* gA = nullptr; const bf16_t* gB = nullptr; bf16_t* gO = nullptr; int gM = 0, gN = 0, gK = 0;
#define IDS int t_ = threadIdx.x; asm volatile("" : "+v"(t_)); const int tid = t_, lane = t_ & 63, wave = __builtin_amdgcn_readfirstlane(t_ >> 6), gw = bid * 8 + wave, gtid = bid * 512 + t_; (void)tid; (void)lane; (void)wave; (void)gw; (void)gtid
        switch (ph) {
        case 0:
#ifdef SELFCHECK
            { IDS; if (gtid == 0) *(unsigned*)(ws + OFF_FLAGS) = 0u; }
#endif
            { IDS; ph_tables(ws, gtid, NT); }
            REP(7) { { IDS; ph_mod(p.in[1], p.in[3], p.in[4], p.in[5], (float*)(ws + OFF_MOD), lds, tid, bid, G); } __syncthreads(); { IDS; ph_weights(p, 0, lds, tid, bid, G, 48); } __syncthreads(); } break;
        case 1: REP(6) { IDS; ph_h0(p, gw, NGW, lane); } break;
        case 2: gk = 1; gA = (const bf16_t*)(ws + OFF_H); gB = (const bf16_t*)(ws + OFF_WIN); gO = (bf16_t*)(ws + OFF_P); gM = MT; gN = PW; gK = DM; break;
        case 3: { IDS; ph_prep(p, layer, lds, gw, NGW, lane, wave); } __syncthreads(); REP(2) { IDS; ph_ret_local(p, layer, lds, tid, bid, G); } REP(3) { { IDS; ph_four_a(p, lds, gw, NGW, lane, wave); } if (!last) { __syncthreads(); { IDS; ph_four_ctx(p, lds, bid, G, lane, wave); } } } break;
        case 4: REP(9) { IDS; ph_ret_scan(p, layer, gtid, NT); } REP(0) { IDS; ph_attn(p, layer, lds, tid, bid, G); } REP(4) { IDS; ph_four_b(p, lds, gw, NGW, lane, wave); } break;
        case 5: REP(5) { IDS; ph_ret_out(p, layer, lds, tid, bid, G); }
#ifdef SELFCHECK
            if (layer == 0) { GRID_SYNC(); { IDS; ph_selfcheck(p, layer, gw, NGW, lane); } }
#endif
            break;
        case 6: gk = 1; gA = (const bf16_t*)(ws + OFF_MIX); gB = (const bf16_t*)(ws + OFF_WOUT); gO = (bf16_t*)(ws + OFF_P); gM = ML; gN = DM; gK = DM; break;
        case 7: { IDS; ph_rowpass(p, layer, 0, mrows, true, gw, NGW, lane); } break;
        case 8: gk = 2; gA = (const bf16_t*)(ws + OFF_H); gB = (const bf16_t*)(ws + OFF_WGU); gO = (bf16_t*)(ws + OFF_P); gM = mrows; gN = 2 * FF; gK = DM; break;
        case 9: gk = 1; gA = (const bf16_t*)(ws + OFF_P); gB = (const bf16_t*)(ws + OFF_WDN); gO = (bf16_t*)(ws + OFF_Y2); gM = ML; gN = DM; gK = FF; break;
        default: { IDS; ph_rowpass(p, layer, 1, mrows, !last, gw, NGW, lane); } if (!last) { IDS; ph_weights(p, 1, lds, tid, bid, G); } break;
        }
        if (gk == 1) REP(1) { pg8::Gemm g{gA, gB, gM, gN, gK}; pg8::StaticOrder S; S.init(gM, gN, G, bid);
            pg8::EpiPlain E{gO, gN};
            pg8::gemm_phase<pg8::EpiPlain, pg8::StaticOrder, true, true>((PG8_LAS unsigned char*)lds, g, S, E);
            if (!last && gN == DM) { IDS; ph_ctx_gemm(gA, gB, gO, gK, lds, tid, bid, G); } }
        else if (gk == 2) REP(1) { pg8::Gemm g{gA, gB, gM, gN, gK}; pg8::StaticOrder S; S.init(gM, gN, G, bid);
            pg8::EpiSwiglu E{gO, FF};
            pg8::gemm_phase<pg8::EpiSwiglu, pg8::StaticOrder, true, true>((PG8_LAS unsigned char*)lds, g, S, E); }
        if (step + 1 < n_steps) GRID_SYNC();
        REP(8) { if (rep_ == 1) GRID_SYNC(); }
    }
}

extern "C" void kernel_launch(void* const* d_in, const int* in_sizes, int n_in, void* d_out, int out_size, void* d_ws, size_t ws_size, hipStream_t stream) {
    static int grid = 0;
    if (grid == 0) {
        if (n_in != 20 || out_size != ML * DM || ws_size < WS_NEED) { fprintf(stderr, "kernel_launch: unexpected shapes (n_in %d, out %d, ws %zu)\n", n_in, out_size, ws_size); grid = -1; return; }
        int dev = 0, cus = 0, per_cu = 0;
        hipGetDevice(&dev); hipDeviceGetAttribute(&cus, hipDeviceAttributeMultiprocessorCount, dev);
        if (hipFuncSetAttribute((const void*)fwd_megakernel, hipFuncAttributeMaxDynamicSharedMemorySize, LDS_BYTES) != hipSuccess) { fprintf(stderr, "kernel_launch: hipFuncSetAttribute failed\n"); grid = -1; return; }
        if (hipOccupancyMaxActiveBlocksPerMultiprocessor(&per_cu, (const void*)fwd_megakernel, 512, LDS_BYTES) != hipSuccess || per_cu < 1) { fprintf(stderr, "kernel_launch: occupancy query says %d\n", per_cu); per_cu = 1; }
        (void)hipGetLastError();
        grid = cus;
    }
    if (grid < 0) return;
    Params p{};
    p.n_steps = 20; p.pad = 0;
    for (int i = 0; i < 20; ++i) p.in[i] = (const float*)d_in[i];
    p.out = (float*)d_out; p.ws = (unsigned char*)d_ws;
    if (hipMemsetAsync((char*)d_ws + OFF_BAR, 0, 16384, stream) != hipSuccess) { fprintf(stderr, "kernel_launch: memset failed\n"); return; }
    void* args[] = {&p};
    hipError_t e = hipLaunchCooperativeKernel((const void*)fwd_megakernel, dim3(grid), dim3(512), args, LDS_BYTES, stream);
    if (e != hipSuccess) fprintf(stderr, "cooperative launch failed: %s (grid %d)\n", hipGetErrorString(e), grid);
}
```
